# Optimizing an MI355X kernel written in HIP

```python
import math
import jax, jax.numpy as jnp
from jax import lax
import numpy as np

D_MODEL = 1024
BATCH = 4
SEQ = 8192
DEPTH = 4

HEAD_DIM = 64
NSA_HEADS = 8
NSA_GROUPS = 2
NSA_HPG = NSA_HEADS // NSA_GROUPS
CMP_LEN = 32
CMP_STRIDE = 16
CMP_HIDDEN = 256
SEL_BLK = 64
N_SEL = 16
WINDOW = 512
DSA_HEADS = 8
DSA_KV_RANK = 128
IDX_HEADS = 8
IDX_DIM = 64
DSA_TOPK = 256
DIFF_HEADS = 8
DIFF_DIM = 64
D_FF = 4 * D_MODEL
NUM_BUCKETS = 32
MAX_DISTANCE = 128
REL_HEADS = NSA_HEADS + DSA_HEADS
QBLK = 128
N_EVEN = (DEPTH + 1) // 2
N_ODD = DEPTH // 2
ALPHA = (2 * DEPTH) ** 0.25
BETA = (8 * DEPTH) ** -0.25
NEG_INF = -1e30
BIG = 1e9
EPS = 1e-5
NSA_Q = NSA_HEADS * HEAD_DIM
NSA_KV = 2 * NSA_GROUPS * HEAD_DIM
NSA_GATE = NSA_HEADS * 3
DSA_Q = DSA_HEADS * HEAD_DIM
EVEN_SIZES = (NSA_Q, NSA_KV, NSA_KV, NSA_KV, NSA_GATE, DSA_Q, DSA_KV_RANK, IDX_HEADS * IDX_DIM, IDX_DIM, IDX_HEADS)
EVEN_IN = sum(EVEN_SIZES)
EVEN_OUT = NSA_Q + DSA_HEADS * HEAD_DIM
ODD_IN = 3 * DIFF_HEADS * 2 * DIFF_DIM
ODD_OUT = DIFF_HEADS * 2 * DIFF_DIM

kernel_name = "hybrid_nsa_dsa_diff_deepnorm_trunk"


def _split(x, sizes):
    offs = np.cumsum(sizes)[:-1].tolist()
    return jnp.split(x, offs, axis=-1)


def layer_norm(x, g, b):
    xf = x.astype(jnp.float32)
    mu = jnp.mean(xf, axis=-1, keepdims=True)
    var = jnp.mean(jnp.square(xf - mu), axis=-1, keepdims=True)
    return ((xf - mu) * lax.rsqrt(var + EPS) * g + b).astype(x.dtype)


def rms_norm(x, g):
    xf = x.astype(jnp.float32)
    return (xf * lax.rsqrt(jnp.mean(jnp.square(xf), axis=-1, keepdims=True) + EPS) * g).astype(x.dtype)


def masked_softmax(logits, mask):
    z = jnp.where(mask, logits.astype(jnp.float32), NEG_INF)
    z = z - jnp.max(z, axis=-1, keepdims=True)
    e = jnp.where(mask, jnp.exp(z), 0.0)
    return e / jnp.maximum(jnp.sum(e, axis=-1, keepdims=True), 1e-30)


def t5_bucket(dist):
    n = jnp.maximum(dist, 0)
    exact = NUM_BUCKETS // 2
    nf = jnp.maximum(n, 1).astype(jnp.float32)
    large = exact + (jnp.log(nf / exact) / math.log(MAX_DISTANCE / exact) * (NUM_BUCKETS - exact)).astype(jnp.int32)
    return jnp.where(n < exact, n, jnp.minimum(large, NUM_BUCKETS - 1))


def sweep_query_blocks(fn, B, S):
    out = lax.map(fn, jnp.arange(S // QBLK))
    return jnp.moveaxis(out, 0, 1).reshape(B, S, -1)


def nsa_compress(k_raw, pe, w1, w2):
    B, S, G, Dh = k_raw.shape
    nc = (S - CMP_LEN) // CMP_STRIDE + 1
    idx = np.arange(nc)[:, None] * CMP_STRIDE + np.arange(CMP_LEN)[None, :]
    blk = k_raw[:, idx] + pe[:, None, :]
    blk = blk.transpose(0, 1, 3, 2, 4).reshape(B, nc, G, CMP_LEN * Dh)
    return jax.nn.gelu(blk @ w1) @ w2


def nsa_attention(q, kvc, kvs, kvw, gate_logits, pe_k, pe_v, w1_k, w2_k, w1_v, w2_v, bias_tab):
    B, S = q.shape[:2]
    G, HPG, Dh = NSA_GROUPS, NSA_HPG, HEAD_DIM
    q = q.reshape(B, S, G, HPG, Dh)
    kc_raw, vc_raw = [a.reshape(B, S, G, Dh) for a in jnp.split(kvc, 2, axis=-1)]
    kc = nsa_compress(kc_raw, pe_k, w1_k, w2_k)
    vc = nsa_compress(vc_raw, pe_v, w1_v, w2_v)
    ks, vs = [a.reshape(B, S, G, Dh).transpose(0, 2, 1, 3) for a in jnp.split(kvs, 2, axis=-1)]
    kw, vw = [jnp.pad(a.reshape(B, S, G, Dh), ((0, 0), (WINDOW, 0), (0, 0), (0, 0))) for a in jnp.split(kvw, 2, axis=-1)]
    gates = jax.nn.sigmoid(gate_logits.astype(jnp.float32)).astype(q.dtype).reshape(B, S, G, HPG, 3)
    nc = kc.shape[1]
    nb = S // SEL_BLK
    n_sel = min(N_SEL, nb)
    cs = np.arange(nc) * CMP_STRIDE
    ss = np.arange(nb) * SEL_BLK
    overlap = np.clip(np.minimum(cs[:, None] + CMP_LEN, ss[None, :] + SEL_BLK) - np.maximum(cs[:, None], ss[None, :]), 0, None)
    imp = jnp.asarray(overlap / CMP_STRIDE, dtype=jnp.float32)
    cmp_end = jnp.asarray(cs + CMP_LEN - 1, dtype=jnp.int32)
    tab = bias_tab.reshape(NUM_BUCKETS, G, HPG)
    scale = Dh ** -0.5
    bi = jnp.arange(B)[:, None, None, None]
    gi = jnp.arange(G)[None, :, None, None]
    jblk = jnp.arange(nb)

    def block(qb):
        q0 = qb * QBLK
        t = q0 + jnp.arange(QBLK)
        qq = lax.dynamic_slice_in_dim(q, q0, QBLK, axis=1)
        gg = lax.dynamic_slice_in_dim(gates, q0, QBLK, axis=1)
        dc = t[:, None] - cmp_end[None, :]
        bias_c = tab[t5_bucket(dc)].transpose(2, 3, 0, 1)
        lc = jnp.einsum('bqghd,bngd->bghqn', qq, kc) * scale + bias_c
        pc = masked_softmax(lc, dc >= 0)
        oc = jnp.einsum('bghqn,bngd->bqghd', pc.astype(vc.dtype), vc)
        score = jnp.einsum('bghqn,nj->bgqj', pc, imp)
        cb = (t // SEL_BLK)[:, None]
        allowed = jblk[None, :] * SEL_BLK <= t[:, None]
        forced = (jblk[None, :] == 0) | (jblk[None, :] == cb) | (jblk[None, :] == cb - 1)
        score = jnp.where(forced, BIG, jnp.where(allowed, score, -BIG))
        _, sel = lax.top_k(score, n_sel)
        tok = (sel[..., None] * SEL_BLK + jnp.arange(SEL_BLK)).reshape(B, G, QBLK, n_sel * SEL_BLK)
        k_sel = ks[bi, gi, tok]
        v_sel = vs[bi, gi, tok]
        dist = t[None, None, :, None] - tok
        bias_s = tab[t5_bucket(dist), gi].transpose(0, 1, 4, 2, 3)
        ls = jnp.einsum('bqghd,bgqtd->bghqt', qq, k_sel) * scale + bias_s
        ps = masked_softmax(ls, (dist >= 0)[:, :, None])
        o_s = jnp.einsum('bghqt,bgqtd->bqghd', ps.astype(v_sel.dtype), v_sel)
        kwb = lax.dynamic_slice_in_dim(kw, q0, WINDOW + QBLK, axis=1)
        vwb = lax.dynamic_slice_in_dim(vw, q0, WINDOW + QBLK, axis=1)
        s = q0 - WINDOW + jnp.arange(WINDOW + QBLK)
        dw = t[:, None] - s[None, :]
        mask_w = (dw >= 0) & (dw < WINDOW) & (s[None, :] >= 0)
        bias_w = tab[t5_bucket(dw)].transpose(2, 3, 0, 1)
        lw = jnp.einsum('bqghd,bsgd->bghqs', qq, kwb) * scale + bias_w
        pw = masked_softmax(lw, mask_w)
        o_w = jnp.einsum('bghqs,bsgd->bqghd', pw.astype(vwb.dtype), vwb)
        out = gg[..., 0:1] * oc + gg[..., 1:2] * o_s + gg[..., 2:3] * o_w
        return out.reshape(B, QBLK, G * HPG * Dh)

    return sweep_query_blocks(block, B, S)


def dsa_attention(q, kv_lat, iq, ik, iw, kv_norm, w_uk, w_uv, bias_tab):
    B, S = q.shape[:2]
    ckv = rms_norm(kv_lat, kv_norm)
    q_lat = jnp.einsum('bshd,rhd->bshr', q, w_uk)
    iq = iq.reshape(B, S, IDX_HEADS, IDX_DIM)
    iw = iw * (IDX_HEADS ** -0.5 * IDX_DIM ** -0.5)
    topk = min(DSA_TOPK, S // 4)
    scale = HEAD_DIM ** -0.5
    bi = jnp.arange(B)[:, None, None]
    spos = jnp.arange(S)

    def block(qb):
        q0 = qb * QBLK
        t = q0 + jnp.arange(QBLK)
        iqb = lax.dynamic_slice_in_dim(iq, q0, QBLK, axis=1)
        iwb = lax.dynamic_slice_in_dim(iw, q0, QBLK, axis=1)
        qlb = lax.dynamic_slice_in_dim(q_lat, q0, QBLK, axis=1)
        rel = jax.nn.relu(jnp.einsum('bqjd,bsd->bqjs', iqb, ik))
        isc = jnp.einsum('bqj,bqjs->bqs', iwb, rel).astype(jnp.float32)
        isc = jnp.where(spos[None, None, :] <= t[None, :, None], isc, NEG_INF)
        _, idx = lax.top_k(isc, topk)
        c_sel = ckv[bi, idx]
        dist = t[None, :, None] - idx
        bias = bias_tab[t5_bucket(dist)].transpose(0, 3, 1, 2)
        logits = jnp.einsum('bqhr,bqkr->bhqk', qlb, c_sel) * scale + bias
        p = masked_softmax(logits, (dist >= 0)[:, None])
        o_lat = jnp.einsum('bhqk,bqkr->bqhr', p.astype(c_sel.dtype), c_sel)
        o = jnp.einsum('bqhr,rhd->bqhd', o_lat, w_uv)
        return o.reshape(B, QBLK, DSA_HEADS * HEAD_DIM)

    return sweep_query_blocks(block, B, S)


def even_mixer(h, w_in, w_out, pe_k, pe_v, w1_k, w2_k, w1_v, w2_v, kv_norm, w_uk, w_uv, rel_bias):
    B, S, _ = h.shape
    nsa_q, kvc, kvs, kvw, gate, dsa_q, dsa_kv, idx_q, idx_k, idx_w = _split(h @ w_in, EVEN_SIZES)
    o_a = nsa_attention(nsa_q, kvc, kvs, kvw, gate, pe_k, pe_v, w1_k, w2_k, w1_v, w2_v, rel_bias[:, :NSA_HEADS])
    o_b = dsa_attention(dsa_q.reshape(B, S, DSA_HEADS, HEAD_DIM), dsa_kv, idx_q, idx_k, idx_w, kv_norm, w_uk, w_uv, rel_bias[:, NSA_HEADS:])
    return jnp.concatenate([o_a, o_b], axis=-1) @ w_out


def diff_mixer(h, w_in, w_out, lam, subln, rel_bias, lambda_init):
    B, S, _ = h.shape
    q, k, v = jnp.split(h @ w_in, 3, axis=-1)
    q = q.reshape(B, S, DIFF_HEADS, 2, DIFF_DIM)
    k = k.reshape(B, S, DIFF_HEADS, 2, DIFF_DIM)
    v = v.reshape(B, S, DIFF_HEADS, 2 * DIFF_DIM)
    lamf = lam.astype(jnp.float32)
    lam_full = jnp.exp(jnp.sum(lamf[0] * lamf[1])) - jnp.exp(jnp.sum(lamf[2] * lamf[3])) + lambda_init
    tab = rel_bias.reshape(NUM_BUCKETS, DIFF_HEADS, 2)
    scale = DIFF_DIM ** -0.5
    spos = jnp.arange(S)

    def block(qb):
        q0 = qb * QBLK
        t = q0 + jnp.arange(QBLK)
        qq = lax.dynamic_slice_in_dim(q, q0, QBLK, axis=1)
        dist = t[:, None] - spos[None, :]
        bias = tab[t5_bucket(dist)].transpose(2, 3, 0, 1)
        logits = jnp.einsum('bqhmd,bshmd->bhmqs', qq, k) * scale + bias
        p = masked_softmax(logits, dist >= 0)
        pd = p[:, :, 0] - lam_full * p[:, :, 1]
        o = jnp.einsum('bhqs,bshe->bqhe', pd.astype(v.dtype), v)
        o = rms_norm(o, subln) * (1.0 - lambda_init)
        return o.reshape(B, QBLK, DIFF_HEADS * 2 * DIFF_DIM)

    return sweep_query_blocks(block, B, S) @ w_out


def sq_relu_mlp(h, w1, w2):
    return jnp.square(jax.nn.relu(h @ w1)) @ w2


def modulate(x, shift, scale):
    return x * (1.0 + scale[:, None, :]) + shift[:, None, :]


def setup_inputs(seed: int = 0) -> dict:
    key = jax.random.key(seed)
    ks = jax.random.split(key, 26)
    f32 = jnp.float32

    def nrm(k, shape, fan_in, s=1.0):
        return jax.random.normal(k, shape, f32) * (s * fan_in ** -0.5)

    D = D_MODEL
    return {
        "x": jax.random.normal(ks[0], (BATCH, SEQ, D), f32),
        "c": jax.random.normal(ks[1], (BATCH, D), f32),
        "rel_bias": 0.5 * jax.random.normal(ks[2], (NUM_BUCKETS, REL_HEADS), f32),
        "ada_w": nrm(ks[3], (DEPTH, D, 6 * D), D, 0.2),
        "ada_b": 0.01 * jax.random.normal(ks[4], (DEPTH, 6 * D), f32),
        "ln_g": 1.0 + 0.02 * jax.random.normal(ks[5], (DEPTH, 2, D), f32),
        "ln_b": 0.02 * jax.random.normal(ks[6], (DEPTH, 2, D), f32),
        "ev_w_in": nrm(ks[7], (N_EVEN, D, EVEN_IN), D),
        "ev_w_out": nrm(ks[8], (N_EVEN, EVEN_OUT, D), EVEN_OUT, BETA),
        "nsa_pe_k": 0.5 * jax.random.normal(ks[9], (N_EVEN, CMP_LEN, HEAD_DIM), f32),
        "nsa_pe_v": 0.5 * jax.random.normal(ks[10], (N_EVEN, CMP_LEN, HEAD_DIM), f32),
        "nsa_w1_k": nrm(ks[11], (N_EVEN, CMP_LEN * HEAD_DIM, CMP_HIDDEN), CMP_LEN * HEAD_DIM),
        "nsa_w2_k": nrm(ks[12], (N_EVEN, CMP_HIDDEN, HEAD_DIM), CMP_HIDDEN),
        "nsa_w1_v": nrm(ks[13], (N_EVEN, CMP_LEN * HEAD_DIM, CMP_HIDDEN), CMP_LEN * HEAD_DIM),
        "nsa_w2_v": nrm(ks[14], (N_EVEN, CMP_HIDDEN, HEAD_DIM), CMP_HIDDEN),
        "dsa_kv_norm": 1.0 + 0.02 * jax.random.normal(ks[15], (N_EVEN, DSA_KV_RANK), f32),
        "dsa_w_uk": nrm(ks[16], (N_EVEN, DSA_KV_RANK, DSA_HEADS, HEAD_DIM), DSA_KV_RANK),
        "dsa_w_uv": nrm(ks[17], (N_EVEN, DSA_KV_RANK, DSA_HEADS, HEAD_DIM), DSA_KV_RANK),
        "od_w_in": nrm(ks[18], (N_ODD, D, ODD_IN), D),
        "od_w_out": nrm(ks[19], (N_ODD, ODD_OUT, D), ODD_OUT, BETA),
        "diff_lam": 0.1 * jax.random.normal(ks[20], (N_ODD, 4, DIFF_DIM), f32),
        "diff_subln": 1.0 + 0.02 * jax.random.normal(ks[21], (N_ODD, 2 * DIFF_DIM), f32),
        "mlp_w1": nrm(ks[22], (DEPTH, D, D_FF), D),
        "mlp_w2": nrm(ks[23], (DEPTH, D_FF, D), D_FF, BETA),
    }


def reference(x, c, rel_bias, ada_w, ada_b, ln_g, ln_b, ev_w_in, ev_w_out, nsa_pe_k, nsa_pe_v, nsa_w1_k, nsa_w2_k, nsa_w1_v, nsa_w2_v, dsa_kv_norm, dsa_w_uk, dsa_w_uv, od_w_in, od_w_out, diff_lam, diff_subln, mlp_w1, mlp_w2):
    c_act = jax.nn.silu(c)
    for l in range(DEPTH):
        ada = c_act @ ada_w[l] + ada_b[l]
        sh1, sc1, g1, sh2, sc2, g2 = jnp.split(ada, 6, axis=-1)
        h = modulate(x, sh1, sc1)
        i = l // 2
        if l % 2 == 0:
            y = even_mixer(h, ev_w_in[i], ev_w_out[i], nsa_pe_k[i], nsa_pe_v[i], nsa_w1_k[i], nsa_w2_k[i], nsa_w1_v[i], nsa_w2_v[i], dsa_kv_norm[i], dsa_w_uk[i], dsa_w_uv[i], rel_bias)
        else:
            lambda_init = 0.8 - 0.6 * math.exp(-0.3 * l)
            y = diff_mixer(h, od_w_in[i], od_w_out[i], diff_lam[i], diff_subln[i], rel_bias, lambda_init)
        x = layer_norm(ALPHA * x + (1.0 + g1[:, None, :]) * y, ln_g[l, 0], ln_b[l, 0])
        h = modulate(x, sh2, sc2)
        y = sq_relu_mlp(h, mlp_w1[l], mlp_w2[l])
        x = layer_norm(ALPHA * x + (1.0 + g2[:, None, :]) * y, ln_g[l, 1], ln_b[l, 1])
    return x
```

```cpp
#include <hip/hip_runtime.h>
#include <hip/hip_bf16.h>
#include <hip/hip_cooperative_groups.h>
#include <cstdio>
namespace cg = cooperative_groups;

#define DI __device__ __forceinline__
#define NTHREADS 512
#ifndef REP_C
#define REP_C 1
#endif
#ifndef REP_SYNC
#define REP_SYNC 0
#endif
#ifndef REP_GEMM
#define REP_GEMM 1
#endif
#ifndef REP_DIFF
#define REP_DIFF 1
#endif
#ifndef REP_NSA
#define REP_NSA 1
#endif
#ifndef REP_IDX
#define REP_IDX 1
#endif
#define LDS_BYTES (144 * 1024)

typedef unsigned short bf16_t;
typedef __attribute__((ext_vector_type(8))) short bf16x8;
typedef __attribute__((ext_vector_type(16))) float f32x16;
typedef __attribute__((ext_vector_type(4))) float f32x4;
typedef __attribute__((ext_vector_type(2))) float f32x2;
typedef __attribute__((ext_vector_type(2))) __bf16 bfx2;
typedef __attribute__((ext_vector_type(4))) unsigned u32x4;
typedef __attribute__((ext_vector_type(2))) unsigned u32x2;

#define MFMA32(a, b, c) __builtin_amdgcn_mfma_f32_32x32x16_bf16((a), (b), (c), 0, 0, 0)
#define MFMA16(a, b, c) __builtin_amdgcn_mfma_f32_16x16x32_bf16((a), (b), (c), 0, 0, 0)

constexpr int SEQ = 8192, NB = 4, DM = 1024, NTOK = NB * SEQ, DFF = 4096;
constexpr int EIN = 2528, OIN = 3072;
constexpr float ALPHA_C = 1.681792830507429f;
constexpr float LOG2E = 1.4426950408889634f;
constexpr float C1 = 0.125f * LOG2E;
constexpr float NEGB = -1e30f;
constexpr int C_NQ = 0, C_KC = 512, C_VC = 640, C_KS = 768, C_VS = 896, C_KW = 1024, C_VW = 1152, C_GATE = 1280, C_DQ = 1304, C_DKV = 1816, C_IQ = 1944, C_IK = 2456, C_IW = 2520;

constexpr size_t MiB = 1024 * 1024;
constexpr size_t OFF_HB = 0;
constexpr size_t OFF_AO = 64 * MiB;
constexpr size_t OFF_U = 128 * MiB;
constexpr size_t OFF_WT = 384 * MiB;
constexpr size_t OFF_MISC = 416 * MiB;
constexpr size_t OFF_BAR = 436 * MiB;
constexpr size_t WS_NEED = 440 * MiB;
constexpr size_t U_PROJ = 0;
constexpr size_t U_VST = 158 * MiB;
constexpr size_t U_VWT = 166 * MiB;
constexpr size_t U_QLAT = 174 * MiB;
constexpr size_t U_IDX = 238 * MiB;
constexpr size_t U_QK = 0;
constexpr size_t U_VT = 128 * MiB;
constexpr size_t WT_IN = 0, WT_OUT = 6 * MiB, WT_M1 = 8 * MiB, WT_M2 = 16 * MiB, WT_CW1 = 24 * MiB, WT_CW2 = 26 * MiB, WT_UK = 27 * MiB, WT_UV = 28 * MiB;
constexpr size_t MS_ADAP = 0;
constexpr size_t MS_ADA = 4 * MiB;
constexpr size_t MS_CB = 5 * MiB;
constexpr size_t MS_KC = 6 * MiB;
constexpr size_t MS_VCT = 7 * MiB;
constexpr size_t MS_HID = 8 * MiB;

struct Params {
  const float* in[24];
  float* out;
  unsigned char* ws;
  int pad0, pad1;
};

typedef const __attribute__((address_space(4))) Params* KParamPtr;
__device__ __forceinline__ KParamPtr kparams() { unsigned long long v = (unsigned long long)__builtin_amdgcn_kernarg_segment_ptr(); asm volatile("" : "+s"(v)); return (KParamPtr)v; }
__device__ const unsigned char kBucket[128] = {0, 1, 2, 3, 4, 5, 6, 7, 8, 9, 10, 11, 12, 13, 14, 15, 16, 16, 16, 17, 17, 18, 18, 18, 19, 19, 19, 20, 20, 20, 20, 21, 21, 21, 21, 22, 22, 22, 22, 22, 23, 23, 23, 23, 23, 23, 24, 24, 24, 24, 24, 24, 25, 25, 25, 25, 25, 25, 25, 26, 26, 26, 26, 26, 26, 26, 26, 27, 27, 27, 27, 27, 27, 27, 27, 27, 27, 28, 28, 28, 28, 28, 28, 28, 28, 28, 28, 29, 29, 29, 29, 29, 29, 29, 29, 29, 29, 29, 29, 30, 30, 30, 30, 30, 30, 30, 30, 30, 30, 30, 30, 30, 30, 31, 31, 31, 31, 31, 31, 31, 31, 31, 31, 31, 31, 31, 31, 31};

DI unsigned pk2(float a, float b) { f32x2 v = {a, b}; bfx2 r = __builtin_convertvector(v, bfx2); return __builtin_bit_cast(unsigned, r); }
DI bf16_t f2bf(float a) { return (bf16_t)(pk2(a, 0.f) & 0xffffu); }
DI float bf2f(bf16_t v) { return __uint_as_float(((unsigned)v) << 16); }
DI u32x2 pk4(float a, float b, float c, float d) { u32x2 r; r.x = pk2(a, b); r.y = pk2(c, d); return r; }
DI int opq(int x) { asm volatile("" : "+v"(x)); return x; }
DI float opqf(float x) { asm volatile("" : "+v"(x)); return x; }
template <class T> DI T* opqp(T* p) { unsigned long long v = (unsigned long long)p; asm volatile("" : "+s"(v)); return (T*)v; }
DI int tid_of(int wave_s) { unsigned z = 0; asm volatile("" : "+s"(z)); int l = __builtin_amdgcn_mbcnt_hi(~0u, __builtin_amdgcn_mbcnt_lo(~0u, z)); return wave_s * 64 + l; }
DI float ex2(float x) { return __builtin_amdgcn_exp2f(x); }
DI float bperm_f(int srclane, float v) { return __int_as_float(__builtin_amdgcn_ds_bpermute(srclane << 2, __float_as_int(v))); }
DI int bperm_i(int srclane, int v) { return __builtin_amdgcn_ds_bpermute(srclane << 2, v); }
#define SHXF(v, m) bperm_f(lane ^ (m), (v))
#define SHXI(v, m) bperm_i(lane ^ (m), (v))
DI float red_max32(float x) { auto r = __builtin_amdgcn_permlane32_swap(__float_as_uint(x), __float_as_uint(x), false, false); return fmaxf(__uint_as_float(r[0]), __uint_as_float(r[1])); }
DI float red_max16(float x) { auto r = __builtin_amdgcn_permlane16_swap(__float_as_uint(x), __float_as_uint(x), false, false); return fmaxf(__uint_as_float(r[0]), __uint_as_float(r[1])); }
DI float red_sum32(float x) { auto r = __builtin_amdgcn_permlane32_swap(__float_as_uint(x), __float_as_uint(x), false, false); return __uint_as_float(r[0]) + __uint_as_float(r[1]); }
DI float red_sum16(float x) { auto r = __builtin_amdgcn_permlane16_swap(__float_as_uint(x), __float_as_uint(x), false, false); return __uint_as_float(r[0]) + __uint_as_float(r[1]); }
DI float wave_sum(float v, int lane) {
#pragma unroll
  for (int o = 32; o >= 1; o >>= 1) v += SHXF(v, o);
  return v;
}
DI int pi_row(int r) { return (r & 0x13) | ((r & 4) << 1) | ((r & 8) >> 1); }
DI bf16x8 pack8(const f32x16& x, int s8) {
  u32x4 u; u.x = pk2(x[8 * s8 + 0], x[8 * s8 + 1]); u.y = pk2(x[8 * s8 + 2], x[8 * s8 + 3]); u.z = pk2(x[8 * s8 + 4], x[8 * s8 + 5]); u.w = pk2(x[8 * s8 + 6], x[8 * s8 + 7]);
  return __builtin_bit_cast(bf16x8, u);
}
DI bf16x8 ldg8(const bf16_t* p) { return *(const bf16x8*)p; }
#define GLOAD16(dst, ptr) asm volatile("global_load_dwordx4 %0, %1, off" : "=&v"(dst) : "v"(ptr) : "memory")
DI void lds_barrier() { asm volatile("s_waitcnt lgkmcnt(0)\n\ts_barrier" ::: "memory"); }
DI void vm_wait0() { asm volatile("s_waitcnt vmcnt(0)" ::: "memory"); }
DI bf16x8 zero8() { u32x4 u = {0u, 0u, 0u, 0u}; return __builtin_bit_cast(bf16x8, u); }
DI f32x16 zero16() { f32x16 z;
#pragma unroll
  for (int i = 0; i < 16; ++i) z[i] = 0.f;
  return z; }
DI float sigmoidf_(float x) { return 1.f / (1.f + __expf(-x)); }
DI float gelu_tanh(float x) { float u = 0.7978845608028654f * (x + 0.044715f * x * x * x); float e = __expf(2.f * u); float th = 1.f - 2.f / (e + 1.f); return 0.5f * x * (1.f + th); }

constexpr int LROW = 72;
constexpr int LDS_TAB = 0;
constexpr int LDS_WORK = 8192;

struct APlain { const bf16_t* A; int lda; DI const bf16_t* base() const { return A; } DI unsigned rowoff(int m) const { return (unsigned)(m * lda); } DI unsigned koff(int k) const { return (unsigned)k; } };
struct ACmp {
  const bf16_t* proj; int col0;
  DI const bf16_t* base() const { return proj; }
  DI unsigned rowoff(int m) const { int combo = m >> 9, n = m & 511, b = combo >> 1, g = combo & 1; return (unsigned)((b * SEQ + 16 * n) * EIN + col0 + g * 64); }
  DI unsigned koff(int k) const { return (unsigned)((k >> 6) * EIN + (k & 63)); }
};

typedef __attribute__((address_space(3))) unsigned lds_u32_t;
DI void dma16(const void* g, unsigned char* l) { __builtin_amdgcn_global_load_lds((const unsigned*)g, (lds_u32_t*)(unsigned)(size_t)l, 16, 0, 0); }
constexpr int GST = 65536;
template <class AF, class EF>
DI void gemm_run(unsigned char* lds, int wv, const AF& af, const bf16_t* __restrict__ Bt, int ldb, int M, int N, int K, const EF& ef, int blk_off) {
  unsigned char* sBase = lds + LDS_WORK;
  const int tid = tid_of(wv), lane = tid & 63, wave = tid >> 6;
  const int wn = wave & 3, wm = wave >> 2;
  const int l15 = lane & 15, q4 = lane >> 4;
  const int mtiles = M >> 8, ntiles = (N + 255) >> 8, ntl = mtiles * ntiles;
  const int G = gridDim.x;
  int first = ((int)blockIdx.x - (blk_off % G) + G) % G;
  const int nk = K >> 6;
  const bool xmap = (blk_off == 0) && ((mtiles & 7) == 0) && ((G & 7) == 0);
  int tstep = G;
  if (xmap) { first = (int)blockIdx.x >> 3; tstep = G >> 3; }
  const int ntl_eff = xmap ? (ntl >> 3) : ntl;
  const int crow = tid >> 3;
  const int cch = ((tid & 7) ^ ((tid >> 4) & 7)) * 8;
  const int swz = l15 >> 1;
  for (int tile_ = first; tile_ < ntl_eff; tile_ += tstep) {
    int nt, mt;
    if (xmap) { nt = tile_ % ntiles; mt = (tile_ / ntiles) * 8 + ((int)blockIdx.x & 7); }
    else { nt = tile_ % ntiles; mt = tile_ / ntiles; }
    const int m0 = mt << 8, n0 = nt << 8;
    f32x4 acc[4][8];
#pragma unroll
    for (int i = 0; i < 4; ++i)
#pragma unroll
      for (int j = 0; j < 8; ++j) acc[i][j] = (f32x4){0.f, 0.f, 0.f, 0.f};
    unsigned aoff[4], boff[4];
    const bf16_t* Ab = af.base();
#pragma unroll
    for (int i = 0; i < 4; ++i) {
      int row = crow + 64 * i;
      aoff[i] = af.rowoff(m0 + row);
      int n = n0 + row; n = n < N ? n : N - 1;
      boff[i] = (unsigned)(n * ldb + cch);
    }
    __syncthreads();
#pragma unroll
    for (int i = 0; i < 4; ++i) {
      dma16(Ab + aoff[i] + af.koff(cch), sBase + 32768 + (i * 512 + tid) * 16);
      dma16(Bt + boff[i], sBase + (i * 512 + tid) * 16);
    }
    vm_wait0();
    __syncthreads();
#pragma unroll 1
    for (int kt = 0; kt < nk; ++kt) {
      unsigned char* cur = sBase + (kt & 1) * GST;
      if (kt + 1 < nk) {
        unsigned char* nxt = sBase + ((kt + 1) & 1) * GST;
        const int k0 = (kt + 1) << 6;
#pragma unroll
        for (int i = 0; i < 4; ++i) {
          dma16(Ab + aoff[i] + af.koff(k0 + cch), nxt + 32768 + (i * 512 + tid) * 16);
          dma16(Bt + boff[i] + (unsigned)k0, nxt + (i * 512 + tid) * 16);
        }
      }
#pragma unroll
      for (int ks = 0; ks < 2; ++ks) {
        bf16x8 wf[4], xf[8];
#pragma unroll
        for (int i = 0; i < 4; ++i) wf[i] = *(const bf16x8*)(cur + (wn * 64 + i * 16 + l15) * 128 + (((ks * 4 + q4) ^ swz) * 16));
#pragma unroll
        for (int j = 0; j < 8; ++j) xf[j] = *(const bf16x8*)(cur + 32768 + (wm * 128 + j * 16 + l15) * 128 + (((ks * 4 + q4) ^ swz) * 16));
#pragma unroll
        for (int i = 0; i < 4; ++i)
#pragma unroll
          for (int j = 0; j < 8; ++j) acc[i][j] = MFMA16(wf[i], xf[j], acc[i][j]);
      }
      vm_wait0();
      __syncthreads();
    }
#pragma unroll
    for (int i = 0; i < 4; ++i)
#pragma unroll
      for (int j = 0; j < 8; ++j) {
        int n = n0 + wn * 64 + i * 16 + 4 * q4;
        int m = m0 + wm * 128 + j * 16 + l15;
        if (n < N) ef.store(m, n, acc[i][j][0], acc[i][j][1], acc[i][j][2], acc[i][j][3]);
      }
  }
}

struct EpiRow { bf16_t* C; int ldc; DI void store(int m, int n, float a, float b, float c, float d) const { *(u32x2*)(C + (size_t)m * ldc + n) = pk4(a, b, c, d); } };
struct EpiSqRelu { bf16_t* C; DI void store(int m, int n, float a, float b, float c, float d) const {
    a = fmaxf(a, 0.f); b = fmaxf(b, 0.f); c = fmaxf(c, 0.f); d = fmaxf(d, 0.f);
    *(u32x2*)(C + (size_t)m * DFF + n) = pk4(a * a, b * b, c * c, d * d); } };
struct EpiResid { const float* xin; float* out; const float* gate;
  DI void store(int m, int n, float a, float b, float c, float d) const {
    int bb = m >> 13;
    float4 x = *(const float4*)(xin + (size_t)m * DM + n);
    float4 g = *(const float4*)(gate + bb * 6144 + n);
    const float one = opqf(1.0f);
    float4 r; r.x = ALPHA_C * x.x + (one + g.x) * a; r.y = ALPHA_C * x.y + (one + g.y) * b; r.z = ALPHA_C * x.z + (one + g.z) * c; r.w = ALPHA_C * x.w + (one + g.w) * d;
    *(float4*)(out + (size_t)m * DM + n) = r; } };
struct EpiEvenProj { bf16_t* proj; bf16_t* vsT; bf16_t* vwT;
  DI void store(int m, int n, float a, float b, float c, float d) const {
    int bb = m >> 13, s = m & (SEQ - 1);
    if (n >= C_VS && n < C_KW) { int e = n - C_VS; bf16_t* p = vsT + ((size_t)(bb * 128 + e)) * SEQ + s; p[0] = f2bf(a); p[SEQ] = f2bf(b); p[2 * SEQ] = f2bf(c); p[3 * SEQ] = f2bf(d); }
    else if (n >= C_VW && n < C_GATE) { int e = n - C_VW; bf16_t* p = vwT + ((size_t)(bb * 128 + e)) * SEQ + s; p[0] = f2bf(a); p[SEQ] = f2bf(b); p[2 * SEQ] = f2bf(c); p[3 * SEQ] = f2bf(d); }
    else *(u32x2*)(proj + (size_t)m * EIN + n) = pk4(a, b, c, d); } };
struct EpiOddProj { bf16_t* qk; bf16_t* vT;
  DI void store(int m, int n, float a, float b, float c, float d) const {
    if (n < 2048) *(u32x2*)(qk + (size_t)m * 2048 + n) = pk4(a, b, c, d);
    else { int bb = m >> 13, s = m & (SEQ - 1); int e = n - 2048; bf16_t* p = vT + ((size_t)(bb * 1024 + e)) * SEQ + s; p[0] = f2bf(a); p[SEQ] = f2bf(b); p[2 * SEQ] = f2bf(c); p[3 * SEQ] = f2bf(d); } } };
struct EpiCmp1 { const float* bias; bf16_t* hid;
  DI void store(int m, int n, float a, float b, float c, float d) const {
    float4 bv = *(const float4*)(bias + n);
    *(u32x2*)(hid + (size_t)m * 256 + n) = pk4(gelu_tanh(a + bv.x), gelu_tanh(b + bv.y), gelu_tanh(c + bv.z), gelu_tanh(d + bv.w)); } };
struct EpiCmp2 { bf16_t* kc; bf16_t* vcT; int kv; DI void store(int m, int n, float a, float b, float c, float d) const {
    int combo = m >> 9, nn = m & 511;
    if (nn == 511) { a = b = c = d = 0.f; }
    if (kv == 0) *(u32x2*)(kc + (size_t)m * 64 + n) = pk4(a, b, c, d);
    else { bf16_t* p = vcT + ((size_t)(combo * 64 + n)) * 512 + nn; p[0] = f2bf(a); p[512] = f2bf(b); p[1024] = f2bf(c); p[1536] = f2bf(d); } } };

DI void tr_convert(unsigned char* lds, int wv, const float* __restrict__ src, int K, int N, bf16_t* __restrict__ dst, int& tb) {
  bf16_t* sT = (bf16_t*)(lds + LDS_WORK);
  const int tid = tid_of(wv), G = gridDim.x;
  const int nkt = K >> 6, nnt = (N + 63) >> 6, ntl = nkt * nnt;
  int first = ((int)blockIdx.x - (tb % G) + G) % G;
  for (int tl = first; tl < ntl; tl += G) {
    const int k0 = (tl / nnt) << 6, n0 = (tl % nnt) << 6;
    const int kk = tid >> 4, n4 = (tid & 15) * 4;
    __syncthreads();
#pragma unroll
    for (int i = 0; i < 2; ++i) {
      int k = kk + 32 * i;
      float4 v = make_float4(0.f, 0.f, 0.f, 0.f);
      if (n0 + n4 < N) v = *(const float4*)(src + (size_t)(k0 + k) * N + n0 + n4);
      sT[(n4 + 0) * LROW + k] = f2bf(v.x); sT[(n4 + 1) * LROW + k] = f2bf(v.y); sT[(n4 + 2) * LROW + k] = f2bf(v.z); sT[(n4 + 3) * LROW + k] = f2bf(v.w);
    }
    __syncthreads();
    const int n = tid >> 3, k8 = (tid & 7) * 8;
    if (n0 + n < N) *(u32x4*)(dst + (size_t)(n0 + n) * K + k0 + k8) = *(const u32x4*)(sT + n * LROW + k8);
  }
  tb += ntl;
}

DI void wprep_phase(unsigned char* lds, KParamPtr P, int wv, int l) {
  unsigned char* wsq = opqp(P->ws);
  bf16_t* WT = (bf16_t*)(wsq + OFF_WT);
  int tb = 0;
  const int i2 = l >> 1;
  tr_convert(lds, wv, P->in[22] + (size_t)l * DM * DFF, DM, DFF, (bf16_t*)((unsigned char*)WT + WT_M1), tb);
  tr_convert(lds, wv, P->in[23] + (size_t)l * DFF * DM, DFF, DM, (bf16_t*)((unsigned char*)WT + WT_M2), tb);
  if ((l & 1) == 0) {
    tr_convert(lds, wv, P->in[7] + (size_t)i2 * DM * EIN, DM, EIN, (bf16_t*)((unsigned char*)WT + WT_IN), tb);
    tr_convert(lds, wv, P->in[8] + (size_t)i2 * DM * DM, DM, DM, (bf16_t*)((unsigned char*)WT + WT_OUT), tb);
    tr_convert(lds, wv, P->in[11] + (size_t)i2 * 2048 * 256, 2048, 256, (bf16_t*)((unsigned char*)WT + WT_CW1), tb);
    tr_convert(lds, wv, P->in[13] + (size_t)i2 * 2048 * 256, 2048, 256, (bf16_t*)((unsigned char*)WT + WT_CW1) + 256 * 2048, tb);
    tr_convert(lds, wv, P->in[12] + (size_t)i2 * 256 * 64, 256, 64, (bf16_t*)((unsigned char*)WT + WT_CW2), tb);
    tr_convert(lds, wv, P->in[14] + (size_t)i2 * 256 * 64, 256, 64, (bf16_t*)((unsigned char*)WT + WT_CW2) + 64 * 256, tb);
    tr_convert(lds, wv, P->in[17] + (size_t)i2 * 128 * 512, 128, 512, (bf16_t*)((unsigned char*)WT + WT_UV), tb);
    {
      const float* src = P->in[16] + (size_t)i2 * 128 * 512; bf16_t* dst = (bf16_t*)((unsigned char*)WT + WT_UK);
      for (int i = (blockIdx.x * NTHREADS + tid_of(wv)) * 4; i < 128 * 512; i += gridDim.x * NTHREADS * 4) {
        float4 v = *(const float4*)(src + i); *(u32x2*)(dst + i) = pk4(v.x, v.y, v.z, v.w);
      }
    }
    {
      float* red = (float*)(lds + LDS_WORK + 16384);
      float* cb = (float*)(wsq + OFF_MISC + MS_CB);
      const int tid_ = tid_of(wv); const int lane = tid_ & 63, wave = tid_ >> 6;
      for (int it = (int)gridDim.x - 1 - (int)blockIdx.x; it < 8; it += gridDim.x) {
        const int kv = it >> 2, n0 = (it & 3) * 64;
        const float* pe = P->in[kv ? 10 : 9] + (size_t)i2 * 2048;
        const float* w1 = P->in[kv ? 13 : 11] + (size_t)i2 * 2048 * 256;
        float a = 0.f;
        for (int k = wave * 256; k < wave * 256 + 256; ++k) a += pe[k] * w1[(size_t)k * 256 + n0 + lane];
        __syncthreads();
        red[wave * 64 + lane] = a;
        __syncthreads();
        if (wave == 0) { float s = 0.f; for (int w = 0; w < 8; ++w) s += red[w * 64 + lane]; cb[kv * 256 + n0 + lane] = s; }
      }
    }
  } else {
    tr_convert(lds, wv, P->in[18] + (size_t)i2 * DM * OIN, DM, OIN, (bf16_t*)((unsigned char*)WT + WT_IN), tb);
    tr_convert(lds, wv, P->in[19] + (size_t)i2 * DM * DM, DM, DM, (bf16_t*)((unsigned char*)WT + WT_OUT), tb);
  }
}

DI void ada_partial_phase(unsigned char* lds, KParamPtr P, int wv) {
  unsigned char* wsq = opqp(P->ws);
  float* cact = (float*)(lds + LDS_WORK);
  float* part = (float*)(wsq + OFF_MISC + MS_ADAP);
  const int tid = tid_of(wv);
  __syncthreads();
  for (int i = tid; i < 4096; i += NTHREADS) { float v = P->in[1][i]; cact[i] = v / (1.f + __expf(-v)); }
  __syncthreads();
  for (int it = blockIdx.x; it < 384; it += gridDim.x) {
    const int kc = it & 7, jc = (it >> 3) % 12, l = it / 96;
    const int j = jc * 512 + tid;
    const float* w = P->in[3] + ((size_t)l * 1024 + kc * 128) * 6144 + j;
    float a0 = 0.f, a1 = 0.f, a2 = 0.f, a3 = 0.f;
#pragma unroll 8
    for (int k = 0; k < 128; ++k) {
      float wgt = w[(size_t)k * 6144];
      int kk = kc * 128 + k;
      a0 += cact[kk] * wgt; a1 += cact[1024 + kk] * wgt; a2 += cact[2048 + kk] * wgt; a3 += cact[3072 + kk] * wgt;
    }
    float* o = part + ((size_t)(kc * 4 + l) * 4) * 6144 + j;
    o[0] = a0; o[6144] = a1; o[2 * 6144] = a2; o[3 * 6144] = a3;
  }
}
DI void ada_reduce_phase(KParamPtr P, int wv) {
  unsigned char* wsq = opqp(P->ws);
  const float* part = (const float*)(wsq + OFF_MISC + MS_ADAP);
  float* ada = (float*)(wsq + OFF_MISC + MS_ADA);
  for (int i = blockIdx.x * NTHREADS + tid_of(wv); i < 4 * 4 * 6144; i += gridDim.x * NTHREADS) {
    int l = i / (4 * 6144), j = i % 6144;
    float s = P->in[4][l * 6144 + j];
#pragma unroll
    for (int kc = 0; kc < 8; ++kc) s += part[(size_t)kc * 4 * 4 * 6144 + i];
    ada[i] = s;
  }
}

DI void ln_mod_phase(KParamPtr P, int wv, const float* src, float* xdst, const float* lng, const float* lnb, const float* sh, const float* sc, bool do_ln, bool write_hb) {
  unsigned char* wsq = opqp(P->ws);
  bf16_t* hb = (bf16_t*)(wsq + OFF_HB);
  const int tid_ = tid_of(wv); const int lane = tid_ & 63, wave = tid_ >> 6;
  const int nw = gridDim.x * 8, gw = blockIdx.x * 8 + wave;
  const int rpw = (NTOK + nw - 1) / nw;
  int r0 = gw * rpw, r1 = r0 + rpw; if (r1 > NTOK) r1 = NTOK;
  float4 g4[4], b4[4], sh4[4], sc4[4];
#pragma unroll
  for (int i = 0; i < 4; ++i) { int c = lane * 4 + 256 * i; if (do_ln) { g4[i] = *(const float4*)(lng + c); b4[i] = *(const float4*)(lnb + c); } }
  int curb = -1;
  const float one = opqf(1.0f);
  for (int row = r0; row < r1; ++row) {
    const int bb = row >> 13;
    if (bb != curb && write_hb) {
      curb = bb;
#pragma unroll
      for (int i = 0; i < 4; ++i) { int c = lane * 4 + 256 * i; sh4[i] = *(const float4*)(sh + bb * 6144 + c); sc4[i] = *(const float4*)(sc + bb * 6144 + c); }
    }
    float4 v[4];
#pragma unroll
    for (int i = 0; i < 4; ++i) v[i] = *(const float4*)(src + (size_t)row * DM + lane * 4 + 256 * i);
    if (do_ln) {
      float s = 0.f;
#pragma unroll
      for (int i = 0; i < 4; ++i) s += v[i].x + v[i].y + v[i].z + v[i].w;
      const float mu = wave_sum(s, lane) * (1.f / 1024.f);
      float q = 0.f;
#pragma unroll
      for (int i = 0; i < 4; ++i) { v[i].x -= mu; v[i].y -= mu; v[i].z -= mu; v[i].w -= mu; q += v[i].x * v[i].x + v[i].y * v[i].y + v[i].z * v[i].z + v[i].w * v[i].w; }
      const float rstd = rsqrtf(wave_sum(q, lane) * (1.f / 1024.f) + 1e-5f);
#pragma unroll
      for (int i = 0; i < 4; ++i) {
        v[i].x = v[i].x * rstd * g4[i].x + b4[i].x; v[i].y = v[i].y * rstd * g4[i].y + b4[i].y; v[i].z = v[i].z * rstd * g4[i].z + b4[i].z; v[i].w = v[i].w * rstd * g4[i].w + b4[i].w;
        *(float4*)(xdst + (size_t)row * DM + lane * 4 + 256 * i) = v[i];
      }
    }
    if (write_hb) {
#pragma unroll
      for (int i = 0; i < 4; ++i) {
        *(u32x2*)(hb + (size_t)row * DM + lane * 4 + 256 * i) = pk4(v[i].x * (one + sc4[i].x) + sh4[i].x, v[i].y * (one + sc4[i].y) + sh4[i].y, v[i].z * (one + sc4[i].z) + sh4[i].z, v[i].w * (one + sc4[i].w) + sh4[i].w);
      }
    }
  }
}

DI void diff_attn_phase(unsigned char* lds, KParamPtr P, int wv, int l) {
  unsigned char* wsq = opqp(P->ws);
  const float* tab = (const float*)(lds + LDS_TAB);
  bf16_t* sK = (bf16_t*)(lds + LDS_WORK);
  bf16_t* sV = sK + 64 * LROW;
  const bf16_t* qk = (const bf16_t*)(wsq + OFF_U + U_QK);
  const bf16_t* vT = (const bf16_t*)(wsq + OFF_U + U_VT);
  bf16_t* ao = (bf16_t*)(wsq + OFF_AO);
  const int i2 = l >> 1;
  const int tid = tid_of(wv), lane = tid & 63, wave = tid >> 6, l31 = lane & 31, hh = lane >> 5;
  const float lambda_init = 0.8f - 0.6f * __expf(-0.3f * (float)l);
  float lam_full;
  {
    const float* lam = P->in[20] + (size_t)i2 * 256;
    float s1 = 0.f, s2 = 0.f;
    for (int d = 0; d < 64; ++d) { s1 += lam[d] * lam[64 + d]; s2 += lam[128 + d] * lam[192 + d]; }
    lam_full = __expf(s1) - __expf(s2) + lambda_init;
  }
  const float* subln = P->in[21] + (size_t)i2 * 128;
  const int pr = pi_row(l31);
  for (int it = blockIdx.x; it < 1024; it += gridDim.x) {
    const int rr = it >> 8, kk = it & 255, bh = (kk & 7) * 4 + rr, jq = kk >> 3;
    const int qt = (rr & 1) ? 31 - jq : jq;
    const int b = bh >> 3, h = bh & 7;
    const int Q0 = qt * 256, q0w = Q0 + wave * 32, t = q0w + l31;
    const int nkt = 4 * (qt + 1);
    unsigned* O1L = (unsigned*)(lds + LDS_WORK + 32768) + tid;
#pragma unroll 1
    for (int pass = 0; pass < 2; ++pass) {
      const int col = h * 2 + pass;
      bf16x8 qf[4];
      const bf16_t* qp = qk + (size_t)(b * SEQ + t) * 2048 + h * 128 + pass * 64 + hh * 8;
#pragma unroll
      for (int ks = 0; ks < 4; ++ks) qf[ks] = ldg8(qp + ks * 16);
      f32x16 O[4];
#pragma unroll
      for (int e = 0; e < 4; ++e) O[e] = zero16();
      float m_run = NEGB, l_run = 0.f;
      const float bfar = tab[col * 128 + 127];
      const unsigned kgo = (unsigned)((b * SEQ + (tid >> 3)) * 2048 + 1024 + h * 128 + pass * 64 + (tid & 7) * 8);
      const unsigned vgo = (unsigned)(((b * 8 + h) * 128 + (tid >> 3)) * SEQ + (tid & 7) * 8);
      u32x4 rk = *(const u32x4*)(qk + kgo), rv0 = *(const u32x4*)(vT + vgo), rv1 = *(const u32x4*)(vT + vgo + 64 * SEQ);
      __syncthreads();
      *(u32x4*)(sK + (tid >> 3) * LROW + (tid & 7) * 8) = rk;
      *(u32x4*)(sV + (tid >> 3) * LROW + (tid & 7) * 8) = rv0;
      *(u32x4*)(sV + ((tid >> 3) + 64) * LROW + (tid & 7) * 8) = rv1;
      __syncthreads();
#pragma unroll 1
      for (int kt = 0; kt < nkt; ++kt) {
        if (kt + 1 < nkt) {
          const int kn = kt + 1;
          GLOAD16(rk, qk + kgo + (unsigned)(kn * 64 * 2048));
          GLOAD16(rv0, vT + vgo + (unsigned)(kn * 64));
          GLOAD16(rv1, vT + vgo + (unsigned)(kn * 64 + 64 * SEQ));
        }
#pragma unroll
        for (int sub = 0; sub < 2; ++sub) {
          const int s0 = kt * 64 + sub * 32;
          if (s0 <= q0w + 31) {
            f32x16 s = zero16();
            bf16x8 kf[4], vf[8];
#pragma unroll
            for (int ks = 0; ks < 4; ++ks) kf[ks] = *(const bf16x8*)(sK + (sub * 32 + pr) * LROW + ks * 16 + hh * 8);
#pragma unroll
            for (int st = 0; st < 2; ++st)
#pragma unroll
              for (int e = 0; e < 4; ++e) vf[st * 4 + e] = *(const bf16x8*)(sV + (e * 32 + l31) * LROW + sub * 32 + st * 16 + hh * 8);
            __builtin_amdgcn_sched_barrier(0);
#pragma unroll
            for (int ks = 0; ks < 4; ++ks) s = MFMA32(kf[ks], qf[ks], s);
            float mloc = NEGB;
            const bool far = (q0w - (s0 + 31) >= 127);
            if (far) {
#pragma unroll
              for (int i = 0; i < 16; ++i) mloc = fmaxf(mloc, s[i]);
              mloc = fmaf(mloc, C1, bfar);
            } else {
#pragma unroll
              for (int i = 0; i < 16; ++i) {
                int key = s0 + (i & 7) + 8 * hh + 16 * (i >> 3);
                int dist = t - key; int dd = dist < 0 ? 0 : (dist > 127 ? 127 : dist);
                const float tb = tab[col * 128 + dd];
                float z = fmaf(s[i], C1, tb); z = dist < 0 ? NEGB : z;
                s[i] = z; mloc = fmaxf(mloc, z);
              }
            }
            mloc = red_max32(mloc);
            const float m_new = (mloc > m_run + 16.f) ? mloc : m_run;
            const float alpha = ex2(m_run - m_new);
            float ls = 0.f;
            if (far) {
              const float boff_ = bfar - m_new;
#pragma unroll
              for (int i = 0; i < 16; ++i) { float p = ex2(fmaf(s[i], C1, boff_)); s[i] = p; ls += p; }
            } else {
#pragma unroll
              for (int i = 0; i < 16; ++i) { float p = ex2(s[i] - m_new); s[i] = p; ls += p; }
            }
            l_run = l_run * alpha + ls; m_run = m_new;
            if (__any(alpha != 1.0f)) {
#pragma unroll
              for (int e = 0; e < 4; ++e)
#pragma unroll
                for (int i = 0; i < 16; ++i) O[e][i] *= alpha;
            }
#pragma unroll
            for (int st = 0; st < 2; ++st) {
              bf16x8 pf = pack8(s, st);
#pragma unroll
              for (int e = 0; e < 4; ++e) O[e] = MFMA32(vf[st * 4 + e], pf, O[e]);
            }
          }
        }
        __syncthreads();
        vm_wait0();
        if (kt + 1 < nkt) {
          *(u32x4*)(sK + (tid >> 3) * LROW + (tid & 7) * 8) = rk;
          *(u32x4*)(sV + (tid >> 3) * LROW + (tid & 7) * 8) = rv0;
          *(u32x4*)(sV + ((tid >> 3) + 64) * LROW + (tid & 7) * 8) = rv1;
        }
        __syncthreads();
      }
      const float lt = red_sum32(l_run);
      const float inv = 1.f / lt;
      if (pass == 0) {
#pragma unroll
        for (int e = 0; e < 4; ++e)
#pragma unroll
          for (int i = 0; i < 8; ++i) O1L[(e * 8 + i) * 512] = pk2(O[e][2 * i] * inv, O[e][2 * i + 1] * inv);
      } else {
        float ss = 0.f;
#pragma unroll
        for (int e = 0; e < 4; ++e)
#pragma unroll
          for (int i = 0; i < 16; ++i) {
            const unsigned pw = O1L[(e * 8 + (i >> 1)) * 512];
            float o1 = (i & 1) ? __uint_as_float(pw & 0xffff0000u) : __uint_as_float(pw << 16);
            float o = o1 - lam_full * (O[e][i] * inv); O[e][i] = o; ss += o * o; }
        ss = red_sum32(ss);
        const float rs = rsqrtf(ss * (1.f / 128.f) + 1e-5f) * (1.f - lambda_init);
        bf16_t* op = ao + (size_t)(b * SEQ + t) * DM + h * 128;
#pragma unroll
        for (int e = 0; e < 4; ++e)
#pragma unroll
          for (int g = 0; g < 4; ++g) {
            int ee = e * 32 + 8 * g + 4 * hh;
            float4 sl = *(const float4*)(subln + ee);
            *(u32x2*)(op + ee) = pk4(O[e][4 * g] * rs * sl.x, O[e][4 * g + 1] * rs * sl.y, O[e][4 * g + 2] * rs * sl.z, O[e][4 * g + 3] * rs * sl.w);
          }
      }
    }
  }
}

DI void cmp_z(f32x16& s, int kt, int t, int t0, int hh, const float* tabh, float& mloc) {
  const int nb = kt * 32;
  if (t0 - (16 * (nb + 31) + 31) >= 127) {
    const float bf = tabh[127];
#pragma unroll
    for (int i = 0; i < 16; ++i) { float z = fmaf(s[i], C1, bf); s[i] = z; mloc = fmaxf(mloc, z); }
  } else {
#pragma unroll
    for (int i = 0; i < 16; ++i) {
      int n = nb + (i & 7) + 8 * hh + 16 * (i >> 3);
      int dc = t - (16 * n + 31); int dd = dc < 0 ? 0 : (dc > 127 ? 127 : dc);
      float z = dc < 0 ? NEGB : fmaf(s[i], C1, tabh[dd]);
      s[i] = z; mloc = fmaxf(mloc, z);
    }
  }
}

DI void nsa_phase(unsigned char* lds, KParamPtr P, int wv) {
  unsigned char* wsq = opqp(P->ws);
  const float* tab = (const float*)(lds + LDS_TAB);
  const int tid = tid_of(wv), lane = tid & 63, wave = tid >> 6, l31 = lane & 31, hh = lane >> 5;
  unsigned char* selL = lds + LDS_WORK + wave * 512;
  float* scw = (float*)(lds + LDS_WORK + 4096 + wave * 16384);
  const bf16_t* proj = (const bf16_t*)(wsq + OFF_U + U_PROJ);
  const bf16_t* vsT = (const bf16_t*)(wsq + OFF_U + U_VST);
  const bf16_t* vwT = (const bf16_t*)(wsq + OFF_U + U_VWT);
  const bf16_t* kc = (const bf16_t*)(wsq + OFF_MISC + MS_KC);
  const bf16_t* vcT = (const bf16_t*)(wsq + OFF_MISC + MS_VCT);
  float* part = (float*)(wsq + OFF_HB);
  bf16_t* ao = (bf16_t*)(wsq + OFF_AO);
  const int nw = gridDim.x * 8, gw = blockIdx.x * 8 + wave;
  const int pr = pi_row(l31);
  for (int it = gw; it < 2048; it += nw) {
    const int blk_ = it >> 3, combo_ = blk_ & 7;
    const int b = combo_ >> 1, g = combo_ & 1, tile = ((blk_ >> 3) << 3) + (it & 7), t0 = tile * 32, t = t0 + l31;
    const size_t tok = (size_t)b * SEQ + t;
    const bf16_t* kcb = kc + (size_t)((b * 2 + g) * 512) * 64;
    const bf16_t* vcb = vcT + (size_t)((b * 2 + g) * 64) * 512;
#pragma unroll 1
    for (int x = 0; x < 64; ++x) scw[x * 64 + lane] = 0.f;
    const int nkt = (2 * tile + 1 + 31) >> 5;
#pragma unroll 1
    for (int hp = 0; hp < 4; ++hp) {
      const int head = g * 4 + hp;
      const float* tabh = tab + head * 128;
      bf16x8 qf[4];
#pragma unroll
      for (int ks = 0; ks < 4; ++ks) qf[ks] = ldg8(proj + tok * EIN + C_NQ + head * 64 + ks * 16 + hh * 8);
      float m = NEGB, l = 0.f;
      bf16x8 kf[4];
      const unsigned kco = (unsigned)(pr * 64 + hh * 8);
#pragma unroll
      for (int ks = 0; ks < 4; ++ks) kf[ks] = ldg8(kcb + kco + ks * 16);
#pragma unroll 1
      for (int kt = 0; kt < nkt; ++kt) {
        f32x16 s = zero16();
#pragma unroll
        for (int ks = 0; ks < 4; ++ks) s = MFMA32(kf[ks], qf[ks], s);
        {
          const int kn = kt + 1 < nkt ? kt + 1 : kt;
#pragma unroll
          for (int ks = 0; ks < 4; ++ks) kf[ks] = ldg8(kcb + kco + (unsigned)(kn * 32 * 64 + ks * 16));
        }
        float mloc = NEGB;
        cmp_z(s, kt, t, t0, hh, tabh, mloc);
        mloc = red_max32(mloc);
        const float mn = fmaxf(m, mloc);
        float ls = 0.f;
#pragma unroll
        for (int i = 0; i < 16; ++i) ls += (s[i] > -1e29f) ? ex2(s[i] - mn) : 0.f;
        l = l * ex2(m - mn) + ls; m = mn;
      }
      const float lt = red_sum32(l);
      const float inv = lt > 0.f ? 1.f / lt : 0.f;
      f32x16 O[2]; O[0] = zero16(); O[1] = zero16();
      float carry = 0.f;
#pragma unroll
      for (int ks = 0; ks < 4; ++ks) kf[ks] = ldg8(kcb + kco + ks * 16);
#pragma unroll 1
      for (int kt = 0; kt < nkt; ++kt) {
        {
          bf16x8 vf[4];
#pragma unroll
          for (int st = 0; st < 2; ++st)
#pragma unroll
            for (int et = 0; et < 2; ++et) vf[st * 2 + et] = ldg8(vcb + (unsigned)((et * 32 + l31) * 512 + kt * 32 + st * 16 + hh * 8));
          f32x16 s = zero16();
#pragma unroll
          for (int ks = 0; ks < 4; ++ks) s = MFMA32(kf[ks], qf[ks], s);
          {
            const int kn = kt + 1 < nkt ? kt + 1 : kt;
#pragma unroll
            for (int ks = 0; ks < 4; ++ks) kf[ks] = ldg8(kcb + kco + (unsigned)(kn * 32 * 64 + ks * 16));
          }
          float mloc = NEGB;
          cmp_z(s, kt, t, t0, hh, tabh, mloc);
#pragma unroll
          for (int i = 0; i < 16; ++i) s[i] = (s[i] > -1e29f) ? ex2(s[i] - m) * inv : 0.f;
          const float G00 = s[0] + s[1] + s[2] + s[3], G01 = s[4] + s[5] + s[6] + s[7];
          const float G10 = s[8] + s[9] + s[10] + s[11], G11 = s[12] + s[13] + s[14] + s[15];
          const float pe0 = SHXF(s[7], 32), pe1 = SHXF(s[15], 32);
          const float X0 = hh ? pe0 : carry;
          const float X1 = hh ? pe1 : pe0;
          float* sp = scw + (8 * kt + 2 * hh) * 32 + l31;
          sp[0] += 2.f * G00 - s[3] + X0;
          sp[32] += 2.f * G01 - s[7] + s[3];
          sp[4 * 32] += 2.f * G10 - s[11] + X1;
          sp[5 * 32] += 2.f * G11 - s[15] + s[11];
          carry = pe1;
#pragma unroll
          for (int st = 0; st < 2; ++st) {
            bf16x8 pf = pack8(s, st);
#pragma unroll
            for (int et = 0; et < 2; ++et) O[et] = MFMA32(vf[st * 2 + et], pf, O[et]);
          }
        }
      }
      const float g0 = sigmoidf_(bf2f(proj[tok * EIN + C_GATE + head * 3 + 0]));
      float* pp = part + (tok * 8 + head) * 64;
#pragma unroll
      for (int et = 0; et < 2; ++et)
#pragma unroll
        for (int gq = 0; gq < 4; ++gq) {
          float4 r; r.x = g0 * O[et][4 * gq]; r.y = g0 * O[et][4 * gq + 1]; r.z = g0 * O[et][4 * gq + 2]; r.w = g0 * O[et][4 * gq + 3];
          *(float4*)(pp + et * 32 + 8 * gq + 4 * hh) = r;
        }
    }
    {
      const int cb = t >> 6;
#pragma unroll 1
      for (int r = 0; r < 64; ++r) {
        const int j = 4 * (r >> 1) + (r & 1) + 2 * hh;
        const bool forced = (j == 0) | (j == cb) | (j == cb - 1);
        const float v = scw[j * 32 + l31];
        scw[j * 32 + l31] = forced ? 1e9f : (j <= cb ? v : -1e9f);
      }
      unsigned mk0 = 0u, mk1 = 0u, mk2 = 0u, mk3 = 0u;
#pragma unroll 1
      for (int rd = 0; rd < 16; ++rd) {
        float bv = -INFINITY; int bj = 255;
#pragma unroll 4
        for (int r = 0; r < 64; ++r) {
          const int j = 4 * (r >> 1) + (r & 1) + 2 * hh;
          const float v = scw[j * 32 + l31];
          if (v > bv) { bv = v; bj = j; }
        }
        const float ov = SHXF(bv, 32); const int oj = SHXI(bj, 32);
        const bool other = (ov > bv) || (ov == bv && oj < bj);
        const int wj = other ? oj : bj;
        if (((wj >> 1) & 1) == hh) scw[wj * 32 + l31] = -3e38f;
        const unsigned bit = 1u << (wj & 31); const int wd = wj >> 5;
        mk0 |= wd == 0 ? bit : 0u; mk1 |= wd == 1 ? bit : 0u; mk2 |= wd == 2 ? bit : 0u; mk3 |= wd == 3 ? bit : 0u;
      }
      if (hh == 0) *(u32x4*)(selL + l31 * 16) = (u32x4){mk0, mk1, mk2, mk3};
    }
    {
      const int s_lo = t0 >= 512 ? t0 - 512 : 0;
      const int nwt = (t0 + 32 - s_lo) >> 5;
#pragma unroll 1
      for (int hp = 0; hp < 4; ++hp) {
        const int head = g * 4 + hp;
        const float* tabh = tab + head * 128;
        bf16x8 qf[4];
#pragma unroll
        for (int ks = 0; ks < 4; ++ks) qf[ks] = ldg8(proj + tok * EIN + C_NQ + head * 64 + ks * 16 + hh * 8);
        f32x16 O[2]; O[0] = zero16(); O[1] = zero16();
        float m = NEGB, l = 0.f;
        bf16x8 kf[4];
        const unsigned kwo = (unsigned)((b * SEQ + s_lo + pr) * EIN + C_KW + g * 64 + hh * 8);
        const unsigned vwo = (unsigned)(((b * 2 + g) * 64 + l31) * SEQ + s_lo + hh * 8);
#pragma unroll
        for (int ks = 0; ks < 4; ++ks) kf[ks] = ldg8(proj + kwo + ks * 16);
#pragma unroll 1
        for (int wt = 0; wt < nwt; ++wt) {
          const int s0 = s_lo + wt * 32;
          bf16x8 vf[4];
#pragma unroll
          for (int st = 0; st < 2; ++st)
#pragma unroll
            for (int et = 0; et < 2; ++et) vf[st * 2 + et] = ldg8(vwT + vwo + (unsigned)(et * 32 * SEQ + wt * 32 + st * 16));
          f32x16 s = zero16();
#pragma unroll
          for (int ks = 0; ks < 4; ++ks) s = MFMA32(kf[ks], qf[ks], s);
          {
            const int wn_ = wt + 1 < nwt ? wt + 1 : wt;
#pragma unroll
            for (int ks = 0; ks < 4; ++ks) kf[ks] = ldg8(proj + kwo + (unsigned)(wn_ * 32 * EIN + ks * 16));
          }
          float mloc = NEGB;
          const bool full = (s0 + 31 <= t0) && (t0 + 31 - s0 < 512);
          if (full && (t0 - (s0 + 31) >= 127)) {
            const float bf = tabh[127];
#pragma unroll
            for (int i = 0; i < 16; ++i) { float z = fmaf(s[i], C1, bf); s[i] = z; mloc = fmaxf(mloc, z); }
          } else {
#pragma unroll
            for (int i = 0; i < 16; ++i) {
              int key = s0 + (i & 7) + 8 * hh + 16 * (i >> 3);
              int dw = t - key; int dd = dw < 0 ? 0 : (dw > 127 ? 127 : dw);
              float z = (dw >= 0 && dw < 512) ? fmaf(s[i], C1, tabh[dd]) : NEGB;
              s[i] = z; mloc = fmaxf(mloc, z);
            }
          }
          mloc = red_max32(mloc);
          const float mn = fmaxf(m, mloc);
          const float alpha = ex2(m - mn);
          float ls = 0.f;
#pragma unroll
          for (int i = 0; i < 16; ++i) { float p = (s[i] > -1e29f) ? ex2(s[i] - mn) : 0.f; s[i] = p; ls += p; }
          l = l * alpha + ls; m = mn;
#pragma unroll
          for (int et = 0; et < 2; ++et)
#pragma unroll
            for (int i = 0; i < 16; ++i) O[et][i] *= alpha;
#pragma unroll
          for (int st = 0; st < 2; ++st) {
            bf16x8 pf = pack8(s, st);
#pragma unroll
            for (int et = 0; et < 2; ++et) O[et] = MFMA32(vf[st * 2 + et], pf, O[et]);
          }
        }
        const float lt = red_sum32(l);
        const float g2 = sigmoidf_(bf2f(proj[tok * EIN + C_GATE + head * 3 + 2])) / lt;
        float* pp = part + (tok * 8 + head) * 64;
#pragma unroll
        for (int et = 0; et < 2; ++et)
#pragma unroll
          for (int gq = 0; gq < 4; ++gq) {
            float4 r = *(float4*)(pp + et * 32 + 8 * gq + 4 * hh);
            r.x += g2 * O[et][4 * gq]; r.y += g2 * O[et][4 * gq + 1]; r.z += g2 * O[et][4 * gq + 2]; r.w += g2 * O[et][4 * gq + 3];
            *(float4*)(pp + et * 32 + 8 * gq + 4 * hh) = r;
          }
      }
    }
    __threadfence();
    {
      const int col = lane & 15, q4 = lane >> 4;
      const int qq = col >> 2, hcol = g * 4 + (col & 3);
      const float* tabc = tab + hcol * 128;
      const int rk = 8 * (col >> 2) + (col & 3);
      const unsigned kbase = (unsigned)((b * SEQ + rk) * EIN + C_KS + g * 64 + q4 * 8);
      const unsigned vbase = (unsigned)(((b * 2 + g) * 64 + col) * SEQ + q4 * 8);
#pragma unroll 1
      for (int grp_ = 0; grp_ < 8 * REP_C; ++grp_) {
        const int grp = grp_ & 7;
        const int tq = t0 + grp * 4 + qq;
        const int tmin = t0 + grp * 4, tmax = tmin + 3;
        const size_t tokq = (size_t)b * SEQ + tq;
        const u32x4 mym = *(const u32x4*)(selL + (grp * 4 + qq) * 16);
        unsigned u0, u1, u2, u3;
        {
          const u32x4 a0 = *(const u32x4*)(selL + (grp * 4 + 0) * 16), a1 = *(const u32x4*)(selL + (grp * 4 + 1) * 16);
          const u32x4 a2 = *(const u32x4*)(selL + (grp * 4 + 2) * 16), a3 = *(const u32x4*)(selL + (grp * 4 + 3) * 16);
          const u32x4 uu = a0 | a1 | a2 | a3;
          u0 = __builtin_amdgcn_readfirstlane(uu.x); u1 = __builtin_amdgcn_readfirstlane(uu.y);
          u2 = __builtin_amdgcn_readfirstlane(uu.z); u3 = __builtin_amdgcn_readfirstlane(uu.w);
          const int cbm = tmax >> 6;
          if (cbm < 31) { u0 &= (2u << cbm) - 1u; u1 = 0u; u2 = 0u; u3 = 0u; }
          else if (cbm < 63) { u1 &= (2u << (cbm - 32)) - 1u; u2 = 0u; u3 = 0u; }
          else if (cbm < 95) { u2 &= (2u << (cbm - 64)) - 1u; u3 = 0u; }
          else if (cbm < 127) { u3 &= (2u << (cbm - 96)) - 1u; }
        }
        auto next_blk = [&]() -> int {
          if (u0) { int bq = __builtin_ctz(u0); u0 &= u0 - 1u; return bq; }
          if (u1) { int bq = __builtin_ctz(u1); u1 &= u1 - 1u; return 32 + bq; }
          if (u2) { int bq = __builtin_ctz(u2); u2 &= u2 - 1u; return 64 + bq; }
          if (u3) { int bq = __builtin_ctz(u3); u3 &= u3 - 1u; return 96 + bq; }
          return -1;
        };
        bf16x8 qf[2];
#pragma unroll
        for (int st = 0; st < 2; ++st) qf[st] = ldg8(proj + tokq * EIN + C_NQ + hcol * 64 + st * 32 + q4 * 8);
        f32x4 O[4];
#pragma unroll
        for (int e = 0; e < 4; ++e) O[e] = (f32x4){0.f, 0.f, 0.f, 0.f};
        float m = NEGB, l = 0.f;
        bf16x8 kf[8], vf[8];
        auto load_k = [&](int jb) {
          const unsigned ko = kbase + (unsigned)(jb * 64 * EIN);
#pragma unroll
          for (int hf = 0; hf < 2; ++hf)
#pragma unroll
            for (int tl = 0; tl < 2; ++tl) {
              kf[(hf * 2 + tl) * 2 + 0] = ldg8(proj + ko + (unsigned)((hf * 32 + 4 * tl) * EIN));
              kf[(hf * 2 + tl) * 2 + 1] = ldg8(proj + ko + (unsigned)((hf * 32 + 4 * tl) * EIN + 32));
            }
        };
        auto load_v = [&](int jb) {
          const unsigned vo = vbase + (unsigned)(jb * 64);
#pragma unroll
          for (int hf = 0; hf < 2; ++hf)
#pragma unroll
            for (int e = 0; e < 4; ++e) vf[hf * 4 + e] = ldg8(vsT + vo + (unsigned)(e * 16 * SEQ + hf * 32));
        };
        int jb = next_blk();
        if (jb >= 0) { load_k(jb); load_v(jb); }
        while (jb >= 0) {
          const int base = jb * 64;
          const unsigned mw = jb < 32 ? mym.x : (jb < 64 ? mym.y : (jb < 96 ? mym.z : mym.w));
          const bool member = (mw >> (jb & 31)) & 1u;
          f32x4 a[2][2];
#pragma unroll
          for (int hf = 0; hf < 2; ++hf)
#pragma unroll
            for (int tl = 0; tl < 2; ++tl) {
              f32x4 acc = (f32x4){0.f, 0.f, 0.f, 0.f};
              acc = MFMA16(kf[(hf * 2 + tl) * 2 + 0], qf[0], acc);
              acc = MFMA16(kf[(hf * 2 + tl) * 2 + 1], qf[1], acc);
              a[hf][tl] = acc;
            }
          const int jn = next_blk();
          if (jn >= 0) load_k(jn);
          float mloc = NEGB;
          if (tmin - (base + 63) >= 127) {
            const float bf = tabc[127];
#pragma unroll
            for (int hf = 0; hf < 2; ++hf)
#pragma unroll
              for (int tl = 0; tl < 2; ++tl)
#pragma unroll
                for (int j = 0; j < 4; ++j) { float z = member ? fmaf(a[hf][tl][j], C1, bf) : NEGB; a[hf][tl][j] = z; mloc = fmaxf(mloc, z); }
          } else {
#pragma unroll
            for (int hf = 0; hf < 2; ++hf)
#pragma unroll
              for (int tl = 0; tl < 2; ++tl)
#pragma unroll
                for (int j = 0; j < 4; ++j) {
                  int key = base + hf * 32 + 8 * q4 + 4 * tl + j;
                  int dist = tq - key; int dd = dist < 0 ? 0 : (dist > 127 ? 127 : dist);
                  float z = (dist < 0 || !member) ? NEGB : fmaf(a[hf][tl][j], C1, tabc[dd]);
                  a[hf][tl][j] = z; mloc = fmaxf(mloc, z);
                }
          }
          mloc = red_max16(mloc);
          mloc = red_max32(mloc);
          const float mn = fmaxf(m, mloc);
          const float alpha = ex2(m - mn);
          float ls = 0.f;
#pragma unroll
          for (int hf = 0; hf < 2; ++hf)
#pragma unroll
            for (int tl = 0; tl < 2; ++tl)
#pragma unroll
              for (int j = 0; j < 4; ++j) { float p = (a[hf][tl][j] > -1e29f) ? ex2(a[hf][tl][j] - mn) : 0.f; a[hf][tl][j] = p; ls += p; }
          l = l * alpha + ls; m = mn;
#pragma unroll
          for (int e = 0; e < 4; ++e) O[e] *= alpha;
#pragma unroll
          for (int hf = 0; hf < 2; ++hf) {
            u32x4 u; u.x = pk2(a[hf][0][0], a[hf][0][1]); u.y = pk2(a[hf][0][2], a[hf][0][3]); u.z = pk2(a[hf][1][0], a[hf][1][1]); u.w = pk2(a[hf][1][2], a[hf][1][3]);
            const bf16x8 pf = __builtin_bit_cast(bf16x8, u);
#pragma unroll
            for (int e = 0; e < 4; ++e) O[e] = MFMA16(vf[hf * 4 + e], pf, O[e]);
          }
          if (jn >= 0) load_v(jn);
          jb = jn;
        }
        l = red_sum16(l);
        l = red_sum32(l);
        {
          const float g1 = sigmoidf_(bf2f(proj[tokq * EIN + C_GATE + hcol * 3 + 1])) / l;
          const float* pp = part + (tokq * 8 + hcol) * 64;
          bf16_t* op = ao + tokq * DM + hcol * 64;
#pragma unroll
          for (int e = 0; e < 4; ++e) {
            float4 pv = *(const float4*)(pp + e * 16 + 4 * q4);
            *(u32x2*)(op + e * 16 + 4 * q4) = pk4(pv.x + g1 * O[e][0], pv.y + g1 * O[e][1], pv.z + g1 * O[e][2], pv.w + g1 * O[e][3]);
          }
        }
      }
    }
  }
}

DI void ckv_norm_phase(KParamPtr P, int wv, int i2) {
  unsigned char* wsq = opqp(P->ws);
  const bf16_t* proj = (const bf16_t*)(wsq + OFF_U + U_PROJ);
  bf16_t* ckv = (bf16_t*)(wsq + OFF_MISC + 12 * MiB);
  const float* gn = P->in[15] + (size_t)i2 * 128;
  const int tid_ = tid_of(wv); const int lane = tid_ & 63, wave = tid_ >> 6;
  const int nw = gridDim.x * 8, gw = blockIdx.x * 8 + wave;
  const float g0 = gn[2 * lane], g1 = gn[2 * lane + 1];
  for (int tk = gw; tk < NTOK; tk += nw) {
    unsigned u = *(const unsigned*)(proj + (size_t)tk * EIN + C_DKV + 2 * lane);
    float a = __uint_as_float(u << 16), c = __uint_as_float(u & 0xffff0000u);
    float ss = wave_sum(a * a + c * c, lane);
    float rs = rsqrtf(ss * (1.f / 128.f) + 1e-5f);
    *(unsigned*)(ckv + (size_t)tk * 128 + 2 * lane) = pk2(a * rs * g0, c * rs * g1);
  }
}

DI unsigned fkey(float f) { unsigned u = __float_as_uint(f); return (u & 0x80000000u) ? ~u : (u | 0x80000000u); }

DI void dsa_index_phase(unsigned char* lds, KParamPtr P, int wv) {
  unsigned char* wsq = opqp(P->ws);
  float* sc = (float*)(lds + LDS_WORK);
  unsigned* hist = (unsigned*)(lds + LDS_WORK + 131072);
  const bf16_t* proj = (const bf16_t*)(wsq + OFF_U + U_PROJ);
  unsigned short* idx = (unsigned short*)(wsq + OFF_U + U_IDX);
  const int tid = tid_of(wv), lane = tid & 63, wave = tid >> 6, l31 = lane & 31, hh = lane >> 5;
  const int rhead = (l31 & 3) + 4 * ((l31 >> 3) & 1), ru = 2 * ((l31 >> 2) & 1) + (l31 >> 4);
  const unsigned long long lt_mask = (lane == 0) ? 0ull : (~0ull >> (64 - lane));
  __syncthreads();
  if (wave < 4) { const unsigned z0 = (unsigned)opq(0); unsigned* hz = hist + wave * 256 + lane * 4; hz[0] = z0; hz[1] = z0; hz[2] = z0; hz[3] = z0; }
  lds_barrier();
  for (int item = blockIdx.x; item < 8192; item += gridDim.x) {
    const int b = (item & 7) >> 1, t0 = (((item >> 3) << 1) + (item & 1)) * 4;
    const int ntile = (t0 + 4 + 31) >> 5;
    bf16x8 af[4];
    const bf16_t* iqp = proj + (size_t)(b * SEQ + t0 + ru) * EIN + C_IQ + rhead * 64 + hh * 8;
#pragma unroll
    for (int ks = 0; ks < 4; ++ks) af[ks] = ldg8(iqp + ks * 16);
    float w[16];
#pragma unroll
    for (int i = 0; i < 16; ++i) {
      const int uq = 2 * hh + (i >> 3), hd = (i & 3) + 4 * ((i >> 2) & 1);
      w[i] = bf2f(proj[(size_t)(b * SEQ + t0 + uq) * EIN + C_IW + hd]) * 0.04419417382415922f;
    }
#pragma unroll 1
    for (int kt0 = wave * 4; kt0 < ntile; kt0 += 32) {
      bf16x8 kf[4][4];
      const unsigned ko = (unsigned)((b * SEQ + kt0 * 32 + l31) * EIN + C_IK + hh * 8);
#pragma unroll
      for (int u = 0; u < 4; ++u)
#pragma unroll
        for (int ks = 0; ks < 4; ++ks) kf[u][ks] = ldg8(proj + ko + (unsigned)(u * 32 * EIN + ks * 16));
#pragma unroll
      for (int u = 0; u < 4; ++u) {
        f32x16 acc = zero16();
#pragma unroll
        for (int ks = 0; ks < 4; ++ks) acc = MFMA32(af[ks], kf[u][ks], acc);
        float s0 = 0.f, s1 = 0.f;
#pragma unroll
        for (int i = 0; i < 8; ++i) { s0 += w[i] * fmaxf(acc[i], 0.f); s1 += w[8 + i] * fmaxf(acc[8 + i], 0.f); }
        const int key = (kt0 + u) * 32 + l31;
        s0 += 0.f; s1 += 0.f;
        sc[(2 * hh) * 8192 + key] = s0;
        sc[(2 * hh + 1) * 8192 + key] = s1;
        if (key <= t0 + 2 * hh) atomicAdd(hist + (2 * hh) * 256 + (fkey(s0) >> 24), 1u);
        if (key <= t0 + 2 * hh + 1) atomicAdd(hist + (2 * hh + 1) * 256 + (fkey(s1) >> 24), 1u);
      }
    }
    const int qs = wave & 3, half = wave >> 2;
    const int n = t0 + qs + 1;
    const float* scq = sc + qs * 8192;
    unsigned short* out = idx + (size_t)(b * SEQ + t0 + qs) * 256;
    unsigned* H0 = hist + qs * 256;
    unsigned* H1 = hist + 1024 + qs * 256;
    const bool big = n > 256;
    if (!big && half == 0) { for (int i = lane; i < 256; i += 64) out[i] = (unsigned short)(i < n ? i : 0xFFFF); }
    lds_barrier();
    unsigned prefix = 0; int Kr = 256;
#pragma unroll 1
    for (int pass = 0; pass < 4; ++pass) {
      unsigned* Hc = (pass & 1) ? H1 : H0;
      unsigned* Hn = (pass & 1) ? H0 : H1;
      const int shift = 24 - 8 * pass;
      if (big && pass > 0) {
        f32x4 vnx = *(const f32x4*)(scq + half * 256 + lane * 4);
        for (int c = half; c * 256 < n; c += 2) {
          const int i0 = c * 256 + lane * 4;
          const f32x4 v = vnx;
          { const int cn = (c + 2) * 256 < n ? c + 2 : c; vnx = *(const f32x4*)(scq + cn * 256 + lane * 4); }
#pragma unroll
          for (int e = 0; e < 4; ++e) {
            const unsigned u = fkey(v[e]);
            const bool match = (i0 + e < n) && ((pass == 0) || ((u >> ((shift + 8) & 31)) == prefix));
            if (match) atomicAdd(Hc + ((u >> shift) & 255u), 1u);
          }
        }
      }
      lds_barrier();
      if (half == 0) { const unsigned z0 = (unsigned)opq(0); Hn[lane * 4] = z0; Hn[lane * 4 + 1] = z0; Hn[lane * 4 + 2] = z0; Hn[lane * 4 + 3] = z0; }
      if (big) {
        const u32x4 hv = *(const u32x4*)(Hc + lane * 4);
        const int sloc = (int)(hv.x + hv.y + hv.z + hv.w);
        int incl = sloc;
#pragma unroll
        for (int off = 1; off < 64; off <<= 1) { int v = bperm_i(lane + off, incl); if (lane + off < 64) incl += v; }
        int cum = incl - sloc;
        bool found = false; int d = 0, nK = 0;
#pragma unroll
        for (int bq = 3; bq >= 0; --bq) {
          const int hbq = (int)hv[bq];
          if (!found && cum < Kr && Kr <= cum + hbq) { found = true; d = lane * 4 + bq; nK = Kr - cum; }
          cum += hbq;
        }
        const unsigned long long mk = __ballot(found);
        const int src = __ffsll((long long)mk) - 1;
        d = bperm_i(src, d); Kr = bperm_i(src, nK);
        prefix = (prefix << 8) | (unsigned)d;
      }
      lds_barrier();
    }
    if (big && half == 0) {
      const unsigned T = prefix;
      int cg_ = 0, ce_ = 0;
      f32x4 vnx = *(const f32x4*)(scq + lane * 4);
      for (int c = 0; c * 256 < n; ++c) {
        const int i0 = c * 256 + lane * 4;
        const f32x4 v = vnx;
        { const int cn = (c + 1) * 256 < n ? c + 1 : c; vnx = *(const f32x4*)(scq + cn * 256 + lane * 4); }
        bool gt[4], eq[4]; unsigned long long mg[4], me[4];
#pragma unroll
        for (int e = 0; e < 4; ++e) {
          const unsigned u = fkey(v[e]);
          gt[e] = (i0 + e < n) && (u > T); eq[e] = (i0 + e < n) && (u == T);
          mg[e] = __ballot(gt[e]); me[e] = __ballot(eq[e]);
        }
        int pg = cg_;
#pragma unroll
        for (int e = 0; e < 4; ++e) {
          if (gt[e]) out[pg + __popcll(mg[e] & lt_mask)] = (unsigned short)(i0 + e);
          pg += __popcll(mg[e]);
        }
        cg_ = pg;
        if ((me[0] | me[1] | me[2] | me[3]) != 0ull) {
          int below = ce_;
#pragma unroll
          for (int e = 0; e < 4; ++e) below += __popcll(me[e] & lt_mask);
          int own = 0;
#pragma unroll
          for (int e = 0; e < 4; ++e) {
            const int rank = below + own;
            if (eq[e] && rank < Kr) out[(256 - Kr) + rank] = (unsigned short)(i0 + e);
            own += eq[e] ? 1 : 0;
          }
#pragma unroll
          for (int e = 0; e < 4; ++e) ce_ += __popcll(me[e]);
        }
      }
    }
    lds_barrier();
  }
}

DI void dsa_sparse_phase(unsigned char* lds, KParamPtr P, int wv) {
  unsigned char* wsq = opqp(P->ws);
  const float* tab = (const float*)(lds + LDS_TAB);
  const int tid = tid_of(wv), lane = tid & 63, wave = tid >> 6;
  bf16_t* gbuf = (bf16_t*)(lds + LDS_WORK + 4096 + wave * 9216);
  unsigned short* idL = (unsigned short*)(lds + LDS_WORK + 4096 + wave * 9216 + 8704);
  __syncthreads();
  bf16_t* qlat = (bf16_t*)(wsq + OFF_U + U_QLAT);
  const bf16_t* ckv = (const bf16_t*)(wsq + OFF_MISC + 12 * MiB);
  const unsigned short* idx = (const unsigned short*)(wsq + OFF_U + U_IDX);
  const int nw = gridDim.x * 8, gw = blockIdx.x * 8 + wave;
  const int col = lane & 15, q4 = lane >> 4;
  const float* tabc = tab + (8 + (col & 7)) * 128;
  const int rk = 8 * (col >> 2) + (col & 3);
  const int grow = lane >> 4, gc16 = lane & 15;
  auto qmap = [](int qi) -> int {
    const int w8 = qi & 7, blk = (qi >> 3) & 255, rnd = qi >> 11, x = blk & 7;
    return ((x >> 1) << 13) + ((((rnd * 32 + (blk >> 3)) << 1) + (x & 1)) << 3) + w8;
  };
  u32x2 idn = (gw < NTOK) ? *(const u32x2*)(idx + (size_t)qmap(gw) * 256 + lane * 4) : (u32x2){0u, 0u};
  for (int qi = gw; qi < NTOK; qi += nw) {
    const int q = qmap(qi);
    const int b = q >> 13, tq = q & (SEQ - 1);
    asm volatile("" ::: "memory");
    *(u32x2*)(idL + lane * 4) = idn;
    asm volatile("" ::: "memory");
    {
      const int qn = qmap(qi + nw < NTOK ? qi + nw : qi);
      idn = *(const u32x2*)(idx + (size_t)qn * 256 + lane * 4);
    }
    bf16x8 qf[4];
#pragma unroll
    for (int st = 0; st < 4; ++st) qf[st] = (col < 8) ? ldg8(qlat + (size_t)q * DM + col * 128 + st * 32 + q4 * 8) : zero8();
    f32x4 O[8];
#pragma unroll
    for (int e = 0; e < 8; ++e) O[e] = (f32x4){0.f, 0.f, 0.f, 0.f};
    float m = NEGB, l = 0.f;
    u32x4 gr[8];
    const unsigned cb = (unsigned)(b * SEQ) * 128u + (unsigned)gc16 * 8u;
#pragma unroll
    for (int i = 0; i < 8; ++i) {
      int id = idL[grow + 4 * i]; id = id > SEQ - 1 ? SEQ - 1 : id;
      gr[i] = *(const u32x4*)(ckv + cb + (unsigned)id * 128u);
    }
#pragma unroll 1
    for (int ch = 0; ch < 8; ++ch) {
#pragma unroll
      for (int i = 0; i < 8; ++i) *(u32x4*)(gbuf + (grow + 4 * i) * 136 + gc16 * 8) = gr[i];
      asm volatile("" ::: "memory");
      {
        const int cn = ch < 7 ? ch + 1 : ch;
#pragma unroll
        for (int i = 0; i < 8; ++i) {
          int id = idL[cn * 32 + grow + 4 * i]; id = id > SEQ - 1 ? SEQ - 1 : id;
          gr[i] = *(const u32x4*)(ckv + cb + (unsigned)id * 128u);
        }
      }
      f32x4 a[2];
#pragma unroll
      for (int tl = 0; tl < 2; ++tl) {
        f32x4 acc = (f32x4){0.f, 0.f, 0.f, 0.f};
#pragma unroll
        for (int st = 0; st < 4; ++st) acc = MFMA16(*(const bf16x8*)(gbuf + (rk + 4 * tl) * 136 + st * 32 + q4 * 8), qf[st], acc);
        a[tl] = acc;
      }
      float mloc = NEGB;
#pragma unroll
      for (int tl = 0; tl < 2; ++tl)
#pragma unroll
        for (int j = 0; j < 4; ++j) {
          const int id = idL[ch * 32 + 8 * q4 + 4 * tl + j];
          const int dist = tq - id; const int dd = dist < 0 ? 0 : (dist > 127 ? 127 : dist);
          const float tb = tabc[dd];
          float z = fmaf(a[tl][j], C1, tb); z = dist < 0 ? NEGB : z;
          a[tl][j] = z; mloc = fmaxf(mloc, z);
        }
      mloc = red_max16(mloc);
      mloc = red_max32(mloc);
      const float mn = fmaxf(m, mloc);
      const float alpha = ex2(m - mn);
      float ls = 0.f;
#pragma unroll
      for (int tl = 0; tl < 2; ++tl)
#pragma unroll
        for (int j = 0; j < 4; ++j) { float p = (a[tl][j] > -1e29f) ? ex2(a[tl][j] - mn) : 0.f; a[tl][j] = p; ls += p; }
      l = l * alpha + ls; m = mn;
#pragma unroll
      for (int e = 0; e < 8; ++e) O[e] *= alpha;
      u32x4 u; u.x = pk2(a[0][0], a[0][1]); u.y = pk2(a[0][2], a[0][3]); u.z = pk2(a[1][0], a[1][1]); u.w = pk2(a[1][2], a[1][3]);
      const bf16x8 pf = __builtin_bit_cast(bf16x8, u);
#pragma unroll
      for (int rt = 0; rt < 8; ++rt) {
        const bf16_t* gp = gbuf + (8 * q4) * 136 + rt * 16 + col;
        u32x4 v;
        v.x = (unsigned)gp[0] | ((unsigned)gp[136] << 16); v.y = (unsigned)gp[2 * 136] | ((unsigned)gp[3 * 136] << 16);
        v.z = (unsigned)gp[4 * 136] | ((unsigned)gp[5 * 136] << 16); v.w = (unsigned)gp[6 * 136] | ((unsigned)gp[7 * 136] << 16);
        O[rt] = MFMA16(__builtin_bit_cast(bf16x8, v), pf, O[rt]);
      }
      asm volatile("" ::: "memory");
    }
    l = red_sum16(l);
    l = red_sum32(l);
    if (col < 8) {
      const float inv = 1.f / l;
      bf16_t* op = qlat + (size_t)q * DM + col * 128;
#pragma unroll
      for (int rt = 0; rt < 8; ++rt) *(u32x2*)(op + rt * 16 + 4 * q4) = pk4(O[rt][0] * inv, O[rt][1] * inv, O[rt][2] * inv, O[rt][3] * inv);
    }
  }
}

DI void gbar(unsigned* cnt, unsigned& target, int tid) {
  asm volatile("s_waitcnt vmcnt(0)" ::: "memory");
  __syncthreads();
  target += gridDim.x;
  if (tid == 0) {
    __builtin_amdgcn_fence(__ATOMIC_RELEASE, "agent");
    asm volatile("s_waitcnt vmcnt(0)" ::: "memory");
    __hip_atomic_fetch_add(cnt, 1u, __ATOMIC_RELAXED, __HIP_MEMORY_SCOPE_AGENT);
    while (__hip_atomic_load(cnt, __ATOMIC_RELAXED, __HIP_MEMORY_SCOPE_AGENT) < target) __builtin_amdgcn_s_sleep(1);
    __builtin_amdgcn_fence(__ATOMIC_ACQUIRE, "agent");
    asm volatile("s_waitcnt vmcnt(0)" ::: "memory");
  }
  __syncthreads();
}

__global__ void __launch_bounds__(NTHREADS) mega(Params P0) {
  extern __shared__ __attribute__((aligned(16))) unsigned char lds[];
  cg::grid_group grid = cg::this_grid();
#define P kparams()
  const int wv = __builtin_amdgcn_readfirstlane((int)(threadIdx.x >> 6));
  const int tid = tid_of(wv);
  {
    float* tab = (float*)(lds + LDS_TAB);
    for (int i = tid; i < 16 * 128; i += NTHREADS) { int col = i >> 7, d = i & 127; tab[i] = P->in[2][(int)kBucket[d] * 16 + col] * LOG2E; }
    __syncthreads();
  }
  const float* ada = (const float*)(opqp(P->ws) + OFF_MISC + MS_ADA);

  unsigned* barp = (unsigned*)(opqp(P->ws) + OFF_BAR);
  unsigned bar_target = 0;
  ada_partial_phase(lds, P, wv);
  wprep_phase(lds, P, wv, 0);
  grid.sync();
  ada_reduce_phase(P, wv);
  gbar(barp, bar_target, tid_of(wv));
  for (int rp = 0; rp < REP_SYNC; ++rp) gbar(barp, bar_target, tid_of(wv));
  ln_mod_phase(P, wv, P->in[0], nullptr, nullptr, nullptr, ada, ada + 1024, false, true);
  gbar(barp, bar_target, tid_of(wv));

#pragma unroll 1
  for (int l = 0; l < 4; ++l) {
    const int i2 = l >> 1;
    unsigned char* ws = opqp(P->ws);
    bf16_t* hb = (bf16_t*)(ws + OFF_HB);
    bf16_t* ao = (bf16_t*)(ws + OFF_AO);
    unsigned char* U = ws + OFF_U;
    unsigned char* WT = ws + OFF_WT;
    const float* ada = (const float*)(ws + OFF_MISC + MS_ADA);
    const float* adal = ada + (size_t)l * 4 * 6144;
    const float* xin = (l == 0) ? P->in[0] : P->out;
    if ((l & 1) == 0) {
      bf16_t* proj = (bf16_t*)(U + U_PROJ);
      bf16_t* qlat = (bf16_t*)(U + U_QLAT);
      bf16_t* hid = (bf16_t*)(ws + OFF_MISC + MS_HID);
      const float* cbias = (const float*)(ws + OFF_MISC + MS_CB);
      for (int rp = 0; rp < REP_GEMM; ++rp) {
      gemm_run(lds, wv, APlain{hb, DM}, (const bf16_t*)(WT + WT_IN), DM, NTOK, EIN, DM, EpiEvenProj{proj, (bf16_t*)(U + U_VST), (bf16_t*)(U + U_VWT)}, 0);
      gbar(barp, bar_target, tid_of(wv)); }
#pragma unroll 1
      for (int kv = 0; kv < 2; ++kv)
        gemm_run(lds, wv, ACmp{proj, kv ? C_VC : C_KC}, (const bf16_t*)(WT + WT_CW1) + kv * 256 * 2048, 2048, 4096, 256, 2048, EpiCmp1{cbias + kv * 256, hid + kv * 4096 * 256}, 16 * kv);
#pragma unroll 1
      for (int h = 0; h < 8; ++h)
        gemm_run(lds, wv, APlain{proj + C_DQ + h * 64, EIN}, (const bf16_t*)(WT + WT_UK) + h * 64, 512, NTOK, 128, 64, EpiRow{qlat + h * 128, DM}, 32 + h * 128);
      ckv_norm_phase(P, wv, i2);
      gbar(barp, bar_target, tid_of(wv));
#pragma unroll 1
      for (int kv = 0; kv < 2; ++kv)
        gemm_run(lds, wv, APlain{hid + kv * 4096 * 256, 256}, (const bf16_t*)(WT + WT_CW2) + kv * 64 * 256, 256, 4096, 64, 256, EpiCmp2{(bf16_t*)(ws + OFF_MISC + MS_KC), (bf16_t*)(ws + OFF_MISC + MS_VCT), kv}, 16 * kv);
      for (int rp = 0; rp < REP_IDX; ++rp) dsa_index_phase(lds, P, wv);
      gbar(barp, bar_target, tid_of(wv));
      for (int rp = 0; rp < REP_NSA; ++rp) nsa_phase(lds, P, wv);
      dsa_sparse_phase(lds, P, wv);
      gbar(barp, bar_target, tid_of(wv));
#pragma unroll 1
      for (int h = 0; h < 8; ++h)
        gemm_run(lds, wv, APlain{qlat + h * 128, DM}, (const bf16_t*)(WT + WT_UV) + h * 64 * 128, 128, NTOK, 64, 128, EpiRow{ao + 512 + h * 64, DM}, h * 128);
      gbar(barp, bar_target, tid_of(wv));
    } else {
      for (int rp = 0; rp < REP_GEMM; ++rp) {
      gemm_run(lds, wv, APlain{hb, DM}, (const bf16_t*)(WT + WT_IN), DM, NTOK, OIN, DM, EpiOddProj{(bf16_t*)(U + U_QK), (bf16_t*)(U + U_VT)}, 0);
      gbar(barp, bar_target, tid_of(wv)); }
      for (int rp = 0; rp < REP_DIFF; ++rp) {
      diff_attn_phase(lds, P, wv, l);
      gbar(barp, bar_target, tid_of(wv)); }
    }
    gemm_run(lds, wv, APlain{ao, DM}, (const bf16_t*)(WT + WT_OUT), DM, NTOK, DM, DM, EpiResid{xin, P->out, adal + 2048}, 0);
    gbar(barp, bar_target, tid_of(wv));
    ln_mod_phase(P, wv, P->out, P->out, P->in[5] + (size_t)(l * 2) * DM, P->in[6] + (size_t)(l * 2) * DM, adal + 3072, adal + 4096, true, true);
    gbar(barp, bar_target, tid_of(wv));
    for (int rp = 0; rp < REP_GEMM; ++rp) {
    gemm_run(lds, wv, APlain{hb, DM}, (const bf16_t*)(WT + WT_M1), DM, NTOK, DFF, DM, EpiSqRelu{(bf16_t*)U}, 0);
    gbar(barp, bar_target, tid_of(wv)); }
    gemm_run(lds, wv, APlain{(const bf16_t*)U, DFF}, (const bf16_t*)(WT + WT_M2), DFF, NTOK, DM, DFF, EpiResid{P->out, P->out, adal + 5120}, 0);
    gbar(barp, bar_target, tid_of(wv));
    ln_mod_phase(P, wv, P->out, P->out, P->in[5] + (size_t)(l * 2 + 1) * DM, P->in[6] + (size_t)(l * 2 + 1) * DM, adal + 4 * 6144, adal + 4 * 6144 + 1024, true, l < 3);
    if (l < 3) { wprep_phase(lds, P, wv, l + 1); gbar(barp, bar_target, tid_of(wv)); }
  }
}

#undef P
extern "C" void kernel_launch(void* const* d_in, const int* in_sizes, int n_in, void* d_out, int out_size, void* d_ws, size_t ws_size, hipStream_t stream) {
  static int grid_blocks = 0;
  if (grid_blocks == 0) {
    int dev = 0, cus = 0, per_cu = 0;
    (void)hipGetDevice(&dev);
    (void)hipDeviceGetAttribute(&cus, hipDeviceAttributeMultiprocessorCount, dev);
    if (hipFuncSetAttribute((const void*)mega, hipFuncAttributeMaxDynamicSharedMemorySize, LDS_BYTES) != hipSuccess) fprintf(stderr, "setattr failed\n");
    (void)hipOccupancyMaxActiveBlocksPerMultiprocessor(&per_cu, (const void*)mega, NTHREADS, LDS_BYTES);
    fprintf(stderr, "cus %d per_cu %d ws_size %zu n_in %d\n", cus, per_cu, ws_size, n_in);
    if (per_cu < 1 || n_in != 24 || ws_size < WS_NEED + 8 * MiB) { fprintf(stderr, "cannot launch\n"); grid_blocks = -1; }
    else grid_blocks = cus;
  }
  if (grid_blocks < 0) return;
  Params p{};
  for (int i = 0; i < 24; ++i) p.in[i] = (const float*)d_in[i];
  p.out = (float*)d_out; p.ws = (unsigned char*)d_ws;
  void* args[] = {&p};
  if (hipMemsetAsync((unsigned char*)d_ws + OFF_BAR, 0, 256, stream) != hipSuccess) fprintf(stderr, "memset failed\n");
  hipError_t e = hipLaunchCooperativeKernel((const void*)mega, dim3(grid_blocks), dim3(NTHREADS), args, LDS_BYTES, stream);
  if (e != hipSuccess) fprintf(stderr, "coop launch failed: %s\n", hipGetErrorString(e));
}
```

```cpp
#include <hip/hip_runtime.h>
#include <hip/hip_bf16.h>
#include <hip/hip_cooperative_groups.h>
#include <cstdio>
namespace cg = cooperative_groups;

#define DI __device__ __forceinline__
#define NTHREADS 512
#ifndef REP_C
#define REP_C 1
#endif
#ifndef REP_SYNC
#define REP_SYNC 0
#endif
#ifndef REP_GEMM
#define REP_GEMM 1
#endif
#ifndef REP_DIFF
#define REP_DIFF 1
#endif
#ifndef REP_NSA
#define REP_NSA 1
#endif
#ifndef REP_IDX
#define REP_IDX 1
#endif
#define LDS_BYTES (144 * 1024)

typedef unsigned short bf16_t;
typedef __attribute__((ext_vector_type(8))) short bf16x8;
typedef __attribute__((ext_vector_type(16))) float f32x16;
typedef __attribute__((ext_vector_type(4))) float f32x4;
typedef __attribute__((ext_vector_type(2))) float f32x2;
typedef __attribute__((ext_vector_type(2))) __bf16 bfx2;
typedef __attribute__((ext_vector_type(4))) unsigned u32x4;
typedef __attribute__((ext_vector_type(2))) unsigned u32x2;

#define MFMA32(a, b, c) __builtin_amdgcn_mfma_f32_32x32x16_bf16((a), (b), (c), 0, 0, 0)
#define MFMA16(a, b, c) __builtin_amdgcn_mfma_f32_16x16x32_bf16((a), (b), (c), 0, 0, 0)

constexpr int SEQ = 8192, NB = 4, DM = 1024, NTOK = NB * SEQ, DFF = 4096;
constexpr int EIN = 2528, OIN = 3072;
constexpr float ALPHA_C = 1.681792830507429f;
constexpr float LOG2E = 1.4426950408889634f;
constexpr float C1 = 0.125f * LOG2E;
constexpr float NEGB = -1e30f;
constexpr int C_NQ = 0, C_KC = 512, C_VC = 640, C_KS = 768, C_VS = 896, C_KW = 1024, C_VW = 1152, C_GATE = 1280, C_DQ = 1304, C_DKV = 1816, C_IQ = 1944, C_IK = 2456, C_IW = 2520;

constexpr size_t MiB = 1024 * 1024;
constexpr size_t OFF_HB = 0;
constexpr size_t OFF_AO = 64 * MiB;
constexpr size_t OFF_U = 128 * MiB;
constexpr size_t OFF_WT = 384 * MiB;
constexpr size_t OFF_MISC = 416 * MiB;
constexpr size_t OFF_BAR = 436 * MiB;
constexpr size_t WS_NEED = 440 * MiB;
constexpr size_t U_PROJ = 0;
constexpr size_t U_VST = 158 * MiB;
constexpr size_t U_VWT = 166 * MiB;
constexpr size_t U_QLAT = 174 * MiB;
constexpr size_t U_IDX = 238 * MiB;
constexpr size_t U_QK = 0;
constexpr size_t U_VT = 128 * MiB;
constexpr size_t WT_IN = 0, WT_OUT = 6 * MiB, WT_M1 = 8 * MiB, WT_M2 = 16 * MiB, WT_CW1 = 24 * MiB, WT_CW2 = 26 * MiB, WT_UK = 27 * MiB, WT_UV = 28 * MiB;
constexpr size_t MS_ADAP = 0;
constexpr size_t MS_ADA = 4 * MiB;
constexpr size_t MS_CB = 5 * MiB;
constexpr size_t MS_KC = 6 * MiB;
constexpr size_t MS_VCT = 7 * MiB;
constexpr size_t MS_HID = 8 * MiB;

struct Params {
  const float* in[24];
  float* out;
  unsigned char* ws;
  int pad0, pad1;
};

typedef const __attribute__((address_space(4))) Params* KParamPtr;
__device__ __forceinline__ KParamPtr kparams() { unsigned long long v = (unsigned long long)__builtin_amdgcn_kernarg_segment_ptr(); asm volatile("" : "+s"(v)); return (KParamPtr)v; }
__device__ const unsigned char kBucket[128] = {0, 1, 2, 3, 4, 5, 6, 7, 8, 9, 10, 11, 12, 13, 14, 15, 16, 16, 16, 17, 17, 18, 18, 18, 19, 19, 19, 20, 20, 20, 20, 21, 21, 21, 21, 22, 22, 22, 22, 22, 23, 23, 23, 23, 23, 23, 24, 24, 24, 24, 24, 24, 25, 25, 25, 25, 25, 25, 25, 26, 26, 26, 26, 26, 26, 26, 26, 27, 27, 27, 27, 27, 27, 27, 27, 27, 27, 28, 28, 28, 28, 28, 28, 28, 28, 28, 28, 29, 29, 29, 29, 29, 29, 29, 29, 29, 29, 29, 29, 30, 30, 30, 30, 30, 30, 30, 30, 30, 30, 30, 30, 30, 30, 31, 31, 31, 31, 31, 31, 31, 31, 31, 31, 31, 31, 31, 31, 31};

DI unsigned pk2(float a, float b) { f32x2 v = {a, b}; bfx2 r = __builtin_convertvector(v, bfx2); return __builtin_bit_cast(unsigned, r); }
DI bf16_t f2bf(float a) { return (bf16_t)(pk2(a, 0.f) & 0xffffu); }
DI float bf2f(bf16_t v) { return __uint_as_float(((unsigned)v) << 16); }
DI u32x2 pk4(float a, float b, float c, float d) { u32x2 r; r.x = pk2(a, b); r.y = pk2(c, d); return r; }
DI int opq(int x) { asm volatile("" : "+v"(x)); return x; }
DI float opqf(float x) { asm volatile("" : "+v"(x)); return x; }
template <class T> DI T* opqp(T* p) { unsigned long long v = (unsigned long long)p; asm volatile("" : "+s"(v)); return (T*)v; }
DI int tid_of(int wave_s) { unsigned z = 0; asm volatile("" : "+s"(z)); int l = __builtin_amdgcn_mbcnt_hi(~0u, __builtin_amdgcn_mbcnt_lo(~0u, z)); return wave_s * 64 + l; }
DI float ex2(float x) { return __builtin_amdgcn_exp2f(x); }
DI float bperm_f(int srclane, float v) { return __int_as_float(__builtin_amdgcn_ds_bpermute(srclane << 2, __float_as_int(v))); }
DI int bperm_i(int srclane, int v) { return __builtin_amdgcn_ds_bpermute(srclane << 2, v); }
#define SHXF(v, m) bperm_f(lane ^ (m), (v))
#define SHXI(v, m) bperm_i(lane ^ (m), (v))
DI float red_max32(float x) { auto r = __builtin_amdgcn_permlane32_swap(__float_as_uint(x), __float_as_uint(x), false, false); return fmaxf(__uint_as_float(r[0]), __uint_as_float(r[1])); }
DI float red_max16(float x) { auto r = __builtin_amdgcn_permlane16_swap(__float_as_uint(x), __float_as_uint(x), false, false); return fmaxf(__uint_as_float(r[0]), __uint_as_float(r[1])); }
DI float red_sum32(float x) { auto r = __builtin_amdgcn_permlane32_swap(__float_as_uint(x), __float_as_uint(x), false, false); return __uint_as_float(r[0]) + __uint_as_float(r[1]); }
DI float red_sum16(float x) { auto r = __builtin_amdgcn_permlane16_swap(__float_as_uint(x), __float_as_uint(x), false, false); return __uint_as_float(r[0]) + __uint_as_float(r[1]); }
DI float wave_sum(float v, int lane) {
#pragma unroll
  for (int o = 32; o >= 1; o >>= 1) v += SHXF(v, o);
  return v;
}
DI int pi_row(int r) { return (r & 0x13) | ((r & 4) << 1) | ((r & 8) >> 1); }
DI bf16x8 pack8(const f32x16& x, int s8) {
  u32x4 u; u.x = pk2(x[8 * s8 + 0], x[8 * s8 + 1]); u.y = pk2(x[8 * s8 + 2], x[8 * s8 + 3]); u.z = pk2(x[8 * s8 + 4], x[8 * s8 + 5]); u.w = pk2(x[8 * s8 + 6], x[8 * s8 + 7]);
  return __builtin_bit_cast(bf16x8, u);
}
DI bf16x8 ldg8(const bf16_t* p) { return *(const bf16x8*)p; }
#define GLOAD16(dst, ptr) asm volatile("global_load_dwordx4 %0, %1, off" : "=&v"(dst) : "v"(ptr) : "memory")
DI void lds_barrier() { asm volatile("s_waitcnt lgkmcnt(0)\n\ts_barrier" ::: "memory"); }
DI void vm_wait0() { asm volatile("s_waitcnt vmcnt(0)" ::: "memory"); }
DI bf16x8 zero8() { u32x4 u = {0u, 0u, 0u, 0u}; return __builtin_bit_cast(bf16x8, u); }
DI f32x16 zero16() { f32x16 z;
#pragma unroll
  for (int i = 0; i < 16; ++i) z[i] = 0.f;
  return z; }
DI float sigmoidf_(float x) { return 1.f / (1.f + __expf(-x)); }
DI float gelu_tanh(float x) { float u = 0.7978845608028654f * (x + 0.044715f * x * x * x); float e = __expf(2.f * u); float th = 1.f - 2.f / (e + 1.f); return 0.5f * x * (1.f + th); }

constexpr int LROW = 72;
constexpr int LDS_TAB = 0;
constexpr int LDS_WORK = 8192;

struct APlain { const bf16_t* A; int lda; DI const bf16_t* base() const { return A; } DI unsigned rowoff(int m) const { return (unsigned)(m * lda); } DI unsigned koff(int k) const { return (unsigned)k; } };
struct ACmp {
  const bf16_t* proj; int col0;
  DI const bf16_t* base() const { return proj; }
  DI unsigned rowoff(int m) const { int combo = m >> 9, n = m & 511, b = combo >> 1, g = combo & 1; return (unsigned)((b * SEQ + 16 * n) * EIN + col0 + g * 64); }
  DI unsigned koff(int k) const { return (unsigned)((k >> 6) * EIN + (k & 63)); }
};

typedef __attribute__((address_space(3))) unsigned lds_u32_t;
DI void dma16(const void* g, unsigned char* l) { __builtin_amdgcn_global_load_lds((const unsigned*)g, (lds_u32_t*)(unsigned)(size_t)l, 16, 0, 0); }
constexpr int GST = 65536;
template <class AF, class EF>
DI void gemm_run(unsigned char* lds, int wv, const AF& af, const bf16_t* __restrict__ Bt, int ldb, int M, int N, int K, const EF& ef, int blk_off) {
  unsigned char* sBase = lds + LDS_WORK;
  const int tid = tid_of(wv), lane = tid & 63, wave = tid >> 6;
  const int wn = wave & 3, wm = wave >> 2;
  const int l15 = lane & 15, q4 = lane >> 4;
  const int mtiles = M >> 8, ntiles = (N + 255) >> 8, ntl = mtiles * ntiles;
  const int G = gridDim.x;
  int first = ((int)blockIdx.x - (blk_off % G) + G) % G;
  const int nk = K >> 6;
  const bool xmap = (blk_off == 0) && ((mtiles & 7) == 0) && ((G & 7) == 0);
  int tstep = G;
  if (xmap) { first = (int)blockIdx.x >> 3; tstep = G >> 3; }
  const int ntl_eff = xmap ? (ntl >> 3) : ntl;
  const int crow = tid >> 3;
  const int cch = ((tid & 7) ^ ((tid >> 4) & 7)) * 8;
  const int swz = l15 >> 1;
  for (int tile_ = first; tile_ < ntl_eff; tile_ += tstep) {
    int nt, mt;
    if (xmap) { nt = tile_ % ntiles; mt = (tile_ / ntiles) * 8 + ((int)blockIdx.x & 7); }
    else { nt = tile_ % ntiles; mt = tile_ / ntiles; }
    const int m0 = mt << 8, n0 = nt << 8;
    f32x4 acc[4][8];
#pragma unroll
    for (int i = 0; i < 4; ++i)
#pragma unroll
      for (int j = 0; j < 8; ++j) acc[i][j] = (f32x4){0.f, 0.f, 0.f, 0.f};
    unsigned aoff[4], boff[4];
    const bf16_t* Ab = af.base();
#pragma unroll
    for (int i = 0; i < 4; ++i) {
      int row = crow + 64 * i;
      aoff[i] = af.rowoff(m0 + row);
      int n = n0 + row; n = n < N ? n : N - 1;
      boff[i] = (unsigned)(n * ldb + cch);
    }
    __syncthreads();
#pragma unroll
    for (int i = 0; i < 4; ++i) {
      dma16(Ab + aoff[i] + af.koff(cch), sBase + 32768 + (i * 512 + tid) * 16);
      dma16(Bt + boff[i], sBase + (i * 512 + tid) * 16);
    }
    vm_wait0();
    __syncthreads();
#pragma unroll 1
    for (int kt = 0; kt < nk; ++kt) {
      unsigned char* cur = sBase + (kt & 1) * GST;
      if (kt + 1 < nk) {
        unsigned char* nxt = sBase + ((kt + 1) & 1) * GST;
        const int k0 = (kt + 1) << 6;
#pragma unroll
        for (int i = 0; i < 4; ++i) {
          dma16(Ab + aoff[i] + af.koff(k0 + cch), nxt + 32768 + (i * 512 + tid) * 16);
          dma16(Bt + boff[i] + (unsigned)k0, nxt + (i * 512 + tid) * 16);
        }
      }
#pragma unroll
      for (int ks = 0; ks < 2; ++ks) {
        bf16x8 wf[4], xf[8];
#pragma unroll
        for (int i = 0; i < 4; ++i) wf[i] = *(const bf16x8*)(cur + (wn * 64 + i * 16 + l15) * 128 + (((ks * 4 + q4) ^ swz) * 16));
#pragma unroll
        for (int j = 0; j < 8; ++j) xf[j] = *(const bf16x8*)(cur + 32768 + (wm * 128 + j * 16 + l15) * 128 + (((ks * 4 + q4) ^ swz) * 16));
#pragma unroll
        for (int i = 0; i < 4; ++i)
#pragma unroll
          for (int j = 0; j < 8; ++j) acc[i][j] = MFMA16(wf[i], xf[j], acc[i][j]);
      }
      vm_wait0();
      __syncthreads();
    }
#pragma unroll
    for (int i = 0; i < 4; ++i)
#pragma unroll
      for (int j = 0; j < 8; ++j) {
        int n = n0 + wn * 64 + i * 16 + 4 * q4;
        int m = m0 + wm * 128 + j * 16 + l15;
        if (n < N) ef.store(m, n, acc[i][j][0], acc[i][j][1], acc[i][j][2], acc[i][j][3]);
      }
  }
}

struct EpiRow { bf16_t* C; int ldc; DI void store(int m, int n, float a, float b, float c, float d) const { *(u32x2*)(C + (size_t)m * ldc + n) = pk4(a, b, c, d); } };
struct EpiSqRelu { bf16_t* C; DI void store(int m, int n, float a, float b, float c, float d) const {
    a = fmaxf(a, 0.f); b = fmaxf(b, 0.f); c = fmaxf(c, 0.f); d = fmaxf(d, 0.f);
    *(u32x2*)(C + (size_t)m * DFF + n) = pk4(a * a, b * b, c * c, d * d); } };
struct EpiResid { const float* xin; float* out; const float* gate;
  DI void store(int m, int n, float a, float b, float c, float d) const {
    int bb = m >> 13;
    float4 x = *(const float4*)(xin + (size_t)m * DM + n);
    float4 g = *(const float4*)(gate + bb * 6144 + n);
    const float one = opqf(1.0f);
    float4 r; r.x = ALPHA_C * x.x + (one + g.x) * a; r.y = ALPHA_C * x.y + (one + g.y) * b; r.z = ALPHA_C * x.z + (one + g.z) * c; r.w = ALPHA_C * x.w + (one + g.w) * d;
    *(float4*)(out + (size_t)m * DM + n) = r; } };
struct EpiEvenProj { bf16_t* proj; bf16_t* vsT; bf16_t* vwT;
  DI void store(int m, int n, float a, float b, float c, float d) const {
    int bb = m >> 13, s = m & (SEQ - 1);
    if (n >= C_VS && n < C_KW) { int e = n - C_VS; bf16_t* p = vsT + ((size_t)(bb * 128 + e)) * SEQ + s; p[0] = f2bf(a); p[SEQ] = f2bf(b); p[2 * SEQ] = f2bf(c); p[3 * SEQ] = f2bf(d); }
    else if (n >= C_VW && n < C_GATE) { int e = n - C_VW; bf16_t* p = vwT + ((size_t)(bb * 128 + e)) * SEQ + s; p[0] = f2bf(a); p[SEQ] = f2bf(b); p[2 * SEQ] = f2bf(c); p[3 * SEQ] = f2bf(d); }
    else *(u32x2*)(proj + (size_t)m * EIN + n) = pk4(a, b, c, d); } };
struct EpiOddProj { bf16_t* qk; bf16_t* vT;
  DI void store(int m, int n, float a, float b, float c, float d) const {
    if (n < 2048) *(u32x2*)(qk + (size_t)m * 2048 + n) = pk4(a, b, c, d);
    else { int bb = m >> 13, s = m & (SEQ - 1); int e = n - 2048; bf16_t* p = vT + ((size_t)(bb * 1024 + e)) * SEQ + s; p[0] = f2bf(a); p[SEQ] = f2bf(b); p[2 * SEQ] = f2bf(c); p[3 * SEQ] = f2bf(d); } } };
struct EpiCmp1 { const float* bias; bf16_t* hid;
  DI void store(int m, int n, float a, float b, float c, float d) const {
    float4 bv = *(const float4*)(bias + n);
    *(u32x2*)(hid + (size_t)m * 256 + n) = pk4(gelu_tanh(a + bv.x), gelu_tanh(b + bv.y), gelu_tanh(c + bv.z), gelu_tanh(d + bv.w)); } };
struct EpiCmp2 { bf16_t* kc; bf16_t* vcT; int kv; DI void store(int m, int n, float a, float b, float c, float d) const {
    int combo = m >> 9, nn = m & 511;
    if (nn == 511) { a = b = c = d = 0.f; }
    if (kv == 0) *(u32x2*)(kc + (size_t)m * 64 + n) = pk4(a, b, c, d);
    else { bf16_t* p = vcT + ((size_t)(combo * 64 + n)) * 512 + nn; p[0] = f2bf(a); p[512] = f2bf(b); p[1024] = f2bf(c); p[1536] = f2bf(d); } } };

DI void tr_convert(unsigned char* lds, int wv, const float* __restrict__ src, int K, int N, bf16_t* __restrict__ dst, int& tb) {
  bf16_t* sT = (bf16_t*)(lds + LDS_WORK);
  const int tid = tid_of(wv), G = gridDim.x;
  const int nkt = K >> 6, nnt = (N + 63) >> 6, ntl = nkt * nnt;
  int first = ((int)blockIdx.x - (tb % G) + G) % G;
  for (int tl = first; tl < ntl; tl += G) {
    const int k0 = (tl / nnt) << 6, n0 = (tl % nnt) << 6;
    const int kk = tid >> 4, n4 = (tid & 15) * 4;
    __syncthreads();
#pragma unroll
    for (int i = 0; i < 2; ++i) {
      int k = kk + 32 * i;
      float4 v = make_float4(0.f, 0.f, 0.f, 0.f);
      if (n0 + n4 < N) v = *(const float4*)(src + (size_t)(k0 + k) * N + n0 + n4);
      sT[(n4 + 0) * LROW + k] = f2bf(v.x); sT[(n4 + 1) * LROW + k] = f2bf(v.y); sT[(n4 + 2) * LROW + k] = f2bf(v.z); sT[(n4 + 3) * LROW + k] = f2bf(v.w);
    }
    __syncthreads();
    const int n = tid >> 3, k8 = (tid & 7) * 8;
    if (n0 + n < N) *(u32x4*)(dst + (size_t)(n0 + n) * K + k0 + k8) = *(const u32x4*)(sT + n * LROW + k8);
  }
  tb += ntl;
}

DI void wprep_phase(unsigned char* lds, KParamPtr P, int wv, int l) {
  unsigned char* wsq = opqp(P->ws);
  bf16_t* WT = (bf16_t*)(wsq + OFF_WT);
  int tb = 0;
  const int i2 = l >> 1;
  tr_convert(lds, wv, P->in[22] + (size_t)l * DM * DFF, DM, DFF, (bf16_t*)((unsigned char*)WT + WT_M1), tb);
  tr_convert(lds, wv, P->in[23] + (size_t)l * DFF * DM, DFF, DM, (bf16_t*)((unsigned char*)WT + WT_M2), tb);
  if ((l & 1) == 0) {
    tr_convert(lds, wv, P->in[7] + (size_t)i2 * DM * EIN, DM, EIN, (bf16_t*)((unsigned char*)WT + WT_IN), tb);
    tr_convert(lds, wv, P->in[8] + (size_t)i2 * DM * DM, DM, DM, (bf16_t*)((unsigned char*)WT + WT_OUT), tb);
    tr_convert(lds, wv, P->in[11] + (size_t)i2 * 2048 * 256, 2048, 256, (bf16_t*)((unsigned char*)WT + WT_CW1), tb);
    tr_convert(lds, wv, P->in[13] + (size_t)i2 * 2048 * 256, 2048, 256, (bf16_t*)((unsigned char*)WT + WT_CW1) + 256 * 2048, tb);
    tr_convert(lds, wv, P->in[12] + (size_t)i2 * 256 * 64, 256, 64, (bf16_t*)((unsigned char*)WT + WT_CW2), tb);
    tr_convert(lds, wv, P->in[14] + (size_t)i2 * 256 * 64, 256, 64, (bf16_t*)((unsigned char*)WT + WT_CW2) + 64 * 256, tb);
    tr_convert(lds, wv, P->in[17] + (size_t)i2 * 128 * 512, 128, 512, (bf16_t*)((unsigned char*)WT + WT_UV), tb);
    {
      const float* src = P->in[16] + (size_t)i2 * 128 * 512; bf16_t* dst = (bf16_t*)((unsigned char*)WT + WT_UK);
      for (int i = (blockIdx.x * NTHREADS + tid_of(wv)) * 4; i < 128 * 512; i += gridDim.x * NTHREADS * 4) {
        float4 v = *(const float4*)(src + i); *(u32x2*)(dst + i) = pk4(v.x, v.y, v.z, v.w);
      }
    }
    {
      float* red = (float*)(lds + LDS_WORK + 16384);
      float* cb = (float*)(wsq + OFF_MISC + MS_CB);
      const int tid_ = tid_of(wv); const int lane = tid_ & 63, wave = tid_ >> 6;
      for (int it = (int)gridDim.x - 1 - (int)blockIdx.x; it < 8; it += gridDim.x) {
        const int kv = it >> 2, n0 = (it & 3) * 64;
        const float* pe = P->in[kv ? 10 : 9] + (size_t)i2 * 2048;
        const float* w1 = P->in[kv ? 13 : 11] + (size_t)i2 * 2048 * 256;
        float a = 0.f;
        for (int k = wave * 256; k < wave * 256 + 256; ++k) a += pe[k] * w1[(size_t)k * 256 + n0 + lane];
        __syncthreads();
        red[wave * 64 + lane] = a;
        __syncthreads();
        if (wave == 0) { float s = 0.f; for (int w = 0; w < 8; ++w) s += red[w * 64 + lane]; cb[kv * 256 + n0 + lane] = s; }
      }
    }
  } else {
    tr_convert(lds, wv, P->in[18] + (size_t)i2 * DM * OIN, DM, OIN, (bf16_t*)((unsigned char*)WT + WT_IN), tb);
    tr_convert(lds, wv, P->in[19] + (size_t)i2 * DM * DM, DM, DM, (bf16_t*)((unsigned char*)WT + WT_OUT), tb);
  }
}

DI void ada_partial_phase(unsigned char* lds, KParamPtr P, int wv) {
  unsigned char* wsq = opqp(P->ws);
  float* cact = (float*)(lds + LDS_WORK);
  float* part = (float*)(wsq + OFF_MISC + MS_ADAP);
  const int tid = tid_of(wv);
  __syncthreads();
  for (int i = tid; i < 4096; i += NTHREADS) { float v = P->in[1][i]; cact[i] = v / (1.f + __expf(-v)); }
  __syncthreads();
  for (int it = blockIdx.x; it < 384; it += gridDim.x) {
    const int kc = it & 7, jc = (it >> 3) % 12, l = it / 96;
    const int j = jc * 512 + tid;
    const float* w = P->in[3] + ((size_t)l * 1024 + kc * 128) * 6144 + j;
    float a0 = 0.f, a1 = 0.f, a2 = 0.f, a3 = 0.f;
#pragma unroll 8
    for (int k = 0; k < 128; ++k) {
      float wgt = w[(size_t)k * 6144];
      int kk = kc * 128 + k;
      a0 += cact[kk] * wgt; a1 += cact[1024 + kk] * wgt; a2 += cact[2048 + kk] * wgt; a3 += cact[3072 + kk] * wgt;
    }
    float* o = part + ((size_t)(kc * 4 + l) * 4) * 6144 + j;
    o[0] = a0; o[6144] = a1; o[2 * 6144] = a2; o[3 * 6144] = a3;
  }
}
DI void ada_reduce_phase(KParamPtr P, int wv) {
  unsigned char* wsq = opqp(P->ws);
  const float* part = (const float*)(wsq + OFF_MISC + MS_ADAP);
  float* ada = (float*)(wsq + OFF_MISC + MS_ADA);
  for (int i = blockIdx.x * NTHREADS + tid_of(wv); i < 4 * 4 * 6144; i += gridDim.x * NTHREADS) {
    int l = i / (4 * 6144), j = i % 6144;
    float s = P->in[4][l * 6144 + j];
#pragma unroll
    for (int kc = 0; kc < 8; ++kc) s += part[(size_t)kc * 4 * 4 * 6144 + i];
    ada[i] = s;
  }
}

DI void ln_mod_phase(KParamPtr P, int wv, const float* src, float* xdst, const float* lng, const float* lnb, const float* sh, const float* sc, bool do_ln, bool write_hb) {
  unsigned char* wsq = opqp(P->ws);
  bf16_t* hb = (bf16_t*)(wsq + OFF_HB);
  const int tid_ = tid_of(wv); const int lane = tid_ & 63, wave = tid_ >> 6;
  const int nw = gridDim.x * 8, gw = blockIdx.x * 8 + wave;
  const int rpw = (NTOK + nw - 1) / nw;
  int r0 = gw * rpw, r1 = r0 + rpw; if (r1 > NTOK) r1 = NTOK;
  float4 g4[4], b4[4], sh4[4], sc4[4];
#pragma unroll
  for (int i = 0; i < 4; ++i) { int c = lane * 4 + 256 * i; if (do_ln) { g4[i] = *(const float4*)(lng + c); b4[i] = *(const float4*)(lnb + c); } }
  int curb = -1;
  const float one = opqf(1.0f);
  f32x4 vn[4];
  if (r0 < r1) {
#pragma unroll
    for (int i = 0; i < 4; ++i) vn[i] = *(const f32x4*)(src + (size_t)r0 * DM + lane * 4 + 256 * i);
  }
  for (int row = r0; row < r1; ++row) {
    const int bb = row >> 13;
    if (bb != curb && write_hb) {
      curb = bb;
#pragma unroll
      for (int i = 0; i < 4; ++i) { int c = lane * 4 + 256 * i; sh4[i] = *(const float4*)(sh + bb * 6144 + c); sc4[i] = *(const float4*)(sc + bb * 6144 + c); }
    }
    float4 v[4];
#pragma unroll
    for (int i = 0; i < 4; ++i) { v[i].x = vn[i][0]; v[i].y = vn[i][1]; v[i].z = vn[i][2]; v[i].w = vn[i][3]; }
    {
      const int rn = row + 1 < r1 ? row + 1 : row;
#pragma unroll
      for (int i = 0; i < 4; ++i) vn[i] = *(const f32x4*)(src + (size_t)rn * DM + lane * 4 + 256 * i);
    }
    if (do_ln) {
      float s = 0.f;
#pragma unroll
      for (int i = 0; i < 4; ++i) s += v[i].x + v[i].y + v[i].z + v[i].w;
      const float mu = wave_sum(s, lane) * (1.f / 1024.f);
      float q = 0.f;
#pragma unroll
      for (int i = 0; i < 4; ++i) { v[i].x -= mu; v[i].y -= mu; v[i].z -= mu; v[i].w -= mu; q += v[i].x * v[i].x + v[i].y * v[i].y + v[i].z * v[i].z + v[i].w * v[i].w; }
      const float rstd = rsqrtf(wave_sum(q, lane) * (1.f / 1024.f) + 1e-5f);
#pragma unroll
      for (int i = 0; i < 4; ++i) {
        v[i].x = v[i].x * rstd * g4[i].x + b4[i].x; v[i].y = v[i].y * rstd * g4[i].y + b4[i].y; v[i].z = v[i].z * rstd * g4[i].z + b4[i].z; v[i].w = v[i].w * rstd * g4[i].w + b4[i].w;
        *(float4*)(xdst + (size_t)row * DM + lane * 4 + 256 * i) = v[i];
      }
    }
    if (write_hb) {
#pragma unroll
      for (int i = 0; i < 4; ++i) {
        *(u32x2*)(hb + (size_t)row * DM + lane * 4 + 256 * i) = pk4(v[i].x * (one + sc4[i].x) + sh4[i].x, v[i].y * (one + sc4[i].y) + sh4[i].y, v[i].z * (one + sc4[i].z) + sh4[i].z, v[i].w * (one + sc4[i].w) + sh4[i].w);
      }
    }
  }
}

DI void diff_attn_phase(unsigned char* lds, KParamPtr P, int wv, int l) {
  unsigned char* wsq = opqp(P->ws);
  const float* tab = (const float*)(lds + LDS_TAB);
  bf16_t* sK = (bf16_t*)(lds + LDS_WORK);
  bf16_t* sV = sK + 64 * LROW;
  const bf16_t* qk = (const bf16_t*)(wsq + OFF_U + U_QK);
  const bf16_t* vT = (const bf16_t*)(wsq + OFF_U + U_VT);
  bf16_t* ao = (bf16_t*)(wsq + OFF_AO);
  const int i2 = l >> 1;
  const int tid = tid_of(wv), lane = tid & 63, wave = tid >> 6, l31 = lane & 31, hh = lane >> 5;
  const float lambda_init = 0.8f - 0.6f * __expf(-0.3f * (float)l);
  float lam_full;
  {
    const float* lam = P->in[20] + (size_t)i2 * 256;
    float s1 = 0.f, s2 = 0.f;
    for (int d = 0; d < 64; ++d) { s1 += lam[d] * lam[64 + d]; s2 += lam[128 + d] * lam[192 + d]; }
    lam_full = __expf(s1) - __expf(s2) + lambda_init;
  }
  const float* subln = P->in[21] + (size_t)i2 * 128;
  const int pr = pi_row(l31);
  for (int it = blockIdx.x; it < 1024; it += gridDim.x) {
    const int rr = it >> 8, kk = it & 255, bh = (kk & 7) * 4 + rr, jq = kk >> 3;
    const int qt = (rr & 1) ? 31 - jq : jq;
    const int b = bh >> 3, h = bh & 7;
    const int Q0 = qt * 256, q0w = Q0 + wave * 32, t = q0w + l31;
    const int nkt = 4 * (qt + 1);
    unsigned* O1L = (unsigned*)(lds + LDS_WORK + 32768) + tid;
#pragma unroll 1
    for (int pass = 0; pass < 2; ++pass) {
      const int col = h * 2 + pass;
      bf16x8 qf[4];
      const bf16_t* qp = qk + (size_t)(b * SEQ + t) * 2048 + h * 128 + pass * 64 + hh * 8;
#pragma unroll
      for (int ks = 0; ks < 4; ++ks) qf[ks] = ldg8(qp + ks * 16);
      f32x16 O[4];
#pragma unroll
      for (int e = 0; e < 4; ++e) O[e] = zero16();
      float m_run = NEGB, l_run = 0.f;
      const float bfar = tab[col * 128 + 127];
      const unsigned kgo = (unsigned)((b * SEQ + (tid >> 3)) * 2048 + 1024 + h * 128 + pass * 64 + (tid & 7) * 8);
      const unsigned vgo = (unsigned)(((b * 8 + h) * 128 + (tid >> 3)) * SEQ + (tid & 7) * 8);
      u32x4 rk = *(const u32x4*)(qk + kgo), rv0 = *(const u32x4*)(vT + vgo), rv1 = *(const u32x4*)(vT + vgo + 64 * SEQ);
      __syncthreads();
      *(u32x4*)(sK + (tid >> 3) * LROW + (tid & 7) * 8) = rk;
      *(u32x4*)(sV + (tid >> 3) * LROW + (tid & 7) * 8) = rv0;
      *(u32x4*)(sV + ((tid >> 3) + 64) * LROW + (tid & 7) * 8) = rv1;
      __syncthreads();
#pragma unroll 1
      for (int kt = 0; kt < nkt; ++kt) {
        if (kt + 1 < nkt) {
          const int kn = kt + 1;
          GLOAD16(rk, qk + kgo + (unsigned)(kn * 64 * 2048));
          GLOAD16(rv0, vT + vgo + (unsigned)(kn * 64));
          GLOAD16(rv1, vT + vgo + (unsigned)(kn * 64 + 64 * SEQ));
        }
#pragma unroll
        for (int sub = 0; sub < 2; ++sub) {
          const int s0 = kt * 64 + sub * 32;
          if (s0 <= q0w + 31) {
            f32x16 s = zero16();
            bf16x8 kf[4], vf[8];
#pragma unroll
            for (int ks = 0; ks < 4; ++ks) kf[ks] = *(const bf16x8*)(sK + (sub * 32 + pr) * LROW + ks * 16 + hh * 8);
#pragma unroll
            for (int st = 0; st < 2; ++st)
#pragma unroll
              for (int e = 0; e < 4; ++e) vf[st * 4 + e] = *(const bf16x8*)(sV + (e * 32 + l31) * LROW + sub * 32 + st * 16 + hh * 8);
            __builtin_amdgcn_sched_barrier(0);
#pragma unroll
            for (int ks = 0; ks < 4; ++ks) s = MFMA32(kf[ks], qf[ks], s);
            float mloc = NEGB;
            const bool far = (q0w - (s0 + 31) >= 127);
            if (far) {
#pragma unroll
              for (int i = 0; i < 16; ++i) mloc = fmaxf(mloc, s[i]);
              mloc = fmaf(mloc, C1, bfar);
            } else {
#pragma unroll
              for (int i = 0; i < 16; ++i) {
                int key = s0 + (i & 7) + 8 * hh + 16 * (i >> 3);
                int dist = t - key; int dd = dist < 0 ? 0 : (dist > 127 ? 127 : dist);
                const float tb = tab[col * 128 + dd];
                float z = fmaf(s[i], C1, tb); z = dist < 0 ? NEGB : z;
                s[i] = z; mloc = fmaxf(mloc, z);
              }
            }
            mloc = red_max32(mloc);
            const float m_new = (mloc > m_run + 16.f) ? mloc : m_run;
            const float alpha = ex2(m_run - m_new);
            float ls = 0.f;
            if (far) {
              const float boff_ = bfar - m_new;
#pragma unroll
              for (int i = 0; i < 16; ++i) { float p = ex2(fmaf(s[i], C1, boff_)); s[i] = p; ls += p; }
            } else {
#pragma unroll
              for (int i = 0; i < 16; ++i) { float p = ex2(s[i] - m_new); s[i] = p; ls += p; }
            }
            l_run = l_run * alpha + ls; m_run = m_new;
            if (__any(alpha != 1.0f)) {
#pragma unroll
              for (int e = 0; e < 4; ++e)
#pragma unroll
                for (int i = 0; i < 16; ++i) O[e][i] *= alpha;
            }
#pragma unroll
            for (int st = 0; st < 2; ++st) {
              bf16x8 pf = pack8(s, st);
#pragma unroll
              for (int e = 0; e < 4; ++e) O[e] = MFMA32(vf[st * 4 + e], pf, O[e]);
            }
          }
        }
        __syncthreads();
        vm_wait0();
        if (kt + 1 < nkt) {
          *(u32x4*)(sK + (tid >> 3) * LROW + (tid & 7) * 8) = rk;
          *(u32x4*)(sV + (tid >> 3) * LROW + (tid & 7) * 8) = rv0;
          *(u32x4*)(sV + ((tid >> 3) + 64) * LROW + (tid & 7) * 8) = rv1;
        }
        __syncthreads();
      }
      const float lt = red_sum32(l_run);
      const float inv = 1.f / lt;
      if (pass == 0) {
#pragma unroll
        for (int e = 0; e < 4; ++e)
#pragma unroll
          for (int i = 0; i < 8; ++i) O1L[(e * 8 + i) * 512] = pk2(O[e][2 * i] * inv, O[e][2 * i + 1] * inv);
      } else {
        float ss = 0.f;
#pragma unroll
        for (int e = 0; e < 4; ++e)
#pragma unroll
          for (int i = 0; i < 16; ++i) {
            const unsigned pw = O1L[(e * 8 + (i >> 1)) * 512];
            float o1 = (i & 1) ? __uint_as_float(pw & 0xffff0000u) : __uint_as_float(pw << 16);
            float o = o1 - lam_full * (O[e][i] * inv); O[e][i] = o; ss += o * o; }
        ss = red_sum32(ss);
        const float rs = rsqrtf(ss * (1.f / 128.f) + 1e-5f) * (1.f - lambda_init);
        bf16_t* op = ao + (size_t)(b * SEQ + t) * DM + h * 128;
#pragma unroll
        for (int e = 0; e < 4; ++e)
#pragma unroll
          for (int g = 0; g < 4; ++g) {
            int ee = e * 32 + 8 * g + 4 * hh;
            float4 sl = *(const float4*)(subln + ee);
            *(u32x2*)(op + ee) = pk4(O[e][4 * g] * rs * sl.x, O[e][4 * g + 1] * rs * sl.y, O[e][4 * g + 2] * rs * sl.z, O[e][4 * g + 3] * rs * sl.w);
          }
      }
    }
  }
}

DI void cmp_z(f32x16& s, int kt, int t, int t0, int hh, const float* tabh, float& mloc) {
  const int nb = kt * 32;
  if (t0 - (16 * (nb + 31) + 31) >= 127) {
    const float bf = tabh[127];
#pragma unroll
    for (int i = 0; i < 16; ++i) { float z = fmaf(s[i], C1, bf); s[i] = z; mloc = fmaxf(mloc, z); }
  } else {
#pragma unroll
    for (int i = 0; i < 16; ++i) {
      int n = nb + (i & 7) + 8 * hh + 16 * (i >> 3);
      int dc = t - (16 * n + 31); int dd = dc < 0 ? 0 : (dc > 127 ? 127 : dc);
      float z = dc < 0 ? NEGB : fmaf(s[i], C1, tabh[dd]);
      s[i] = z; mloc = fmaxf(mloc, z);
    }
  }
}

DI void nsa_phase(unsigned char* lds, KParamPtr P, int wv) {
  unsigned char* wsq = opqp(P->ws);
  const float* tab = (const float*)(lds + LDS_TAB);
  const int tid = tid_of(wv), lane = tid & 63, wave = tid >> 6, l31 = lane & 31, hh = lane >> 5;
  unsigned char* selL = lds + LDS_WORK + wave * 512;
  float* scw = (float*)(lds + LDS_WORK + 4096 + wave * 16384);
  const bf16_t* proj = (const bf16_t*)(wsq + OFF_U + U_PROJ);
  const bf16_t* vsT = (const bf16_t*)(wsq + OFF_U + U_VST);
  const bf16_t* vwT = (const bf16_t*)(wsq + OFF_U + U_VWT);
  const bf16_t* kc = (const bf16_t*)(wsq + OFF_MISC + MS_KC);
  const bf16_t* vcT = (const bf16_t*)(wsq + OFF_MISC + MS_VCT);
  float* part = (float*)(wsq + OFF_HB);
  bf16_t* ao = (bf16_t*)(wsq + OFF_AO);
  const int nw = gridDim.x * 8, gw = blockIdx.x * 8 + wave;
  const int pr = pi_row(l31);
  for (int it = gw; it < 2048; it += nw) {
    const int blk_ = it >> 3, combo_ = blk_ & 7;
    const int b = combo_ >> 1, g = combo_ & 1, tile = ((blk_ >> 3) << 3) + (it & 7), t0 = tile * 32, t = t0 + l31;
    const size_t tok = (size_t)b * SEQ + t;
    const bf16_t* kcb = kc + (size_t)((b * 2 + g) * 512) * 64;
    const bf16_t* vcb = vcT + (size_t)((b * 2 + g) * 64) * 512;
#pragma unroll 1
    for (int x = 0; x < 64; ++x) scw[x * 64 + lane] = 0.f;
    const int nkt = (2 * tile + 1 + 31) >> 5;
#pragma unroll 1
    for (int hp = 0; hp < 4; ++hp) {
      const int head = g * 4 + hp;
      const float* tabh = tab + head * 128;
      bf16x8 qf[4];
#pragma unroll
      for (int ks = 0; ks < 4; ++ks) qf[ks] = ldg8(proj + tok * EIN + C_NQ + head * 64 + ks * 16 + hh * 8);
      float m = NEGB, l = 0.f;
      bf16x8 kf[4];
      const unsigned kco = (unsigned)(pr * 64 + hh * 8);
#pragma unroll
      for (int ks = 0; ks < 4; ++ks) kf[ks] = ldg8(kcb + kco + ks * 16);
#pragma unroll 1
      for (int kt = 0; kt < nkt; ++kt) {
        f32x16 s = zero16();
#pragma unroll
        for (int ks = 0; ks < 4; ++ks) s = MFMA32(kf[ks], qf[ks], s);
        {
          const int kn = kt + 1 < nkt ? kt + 1 : kt;
#pragma unroll
          for (int ks = 0; ks < 4; ++ks) kf[ks] = ldg8(kcb + kco + (unsigned)(kn * 32 * 64 + ks * 16));
        }
        float mloc = NEGB;
        cmp_z(s, kt, t, t0, hh, tabh, mloc);
        mloc = red_max32(mloc);
        const float mn = fmaxf(m, mloc);
        float ls = 0.f;
#pragma unroll
        for (int i = 0; i < 16; ++i) ls += (s[i] > -1e29f) ? ex2(s[i] - mn) : 0.f;
        l = l * ex2(m - mn) + ls; m = mn;
      }
      const float lt = red_sum32(l);
      const float inv = lt > 0.f ? 1.f / lt : 0.f;
      f32x16 O[2]; O[0] = zero16(); O[1] = zero16();
      float carry = 0.f;
#pragma unroll
      for (int ks = 0; ks < 4; ++ks) kf[ks] = ldg8(kcb + kco + ks * 16);
#pragma unroll 1
      for (int kt = 0; kt < nkt; ++kt) {
        {
          bf16x8 vf[4];
#pragma unroll
          for (int st = 0; st < 2; ++st)
#pragma unroll
            for (int et = 0; et < 2; ++et) vf[st * 2 + et] = ldg8(vcb + (unsigned)((et * 32 + l31) * 512 + kt * 32 + st * 16 + hh * 8));
          f32x16 s = zero16();
#pragma unroll
          for (int ks = 0; ks < 4; ++ks) s = MFMA32(kf[ks], qf[ks], s);
          {
            const int kn = kt + 1 < nkt ? kt + 1 : kt;
#pragma unroll
            for (int ks = 0; ks < 4; ++ks) kf[ks] = ldg8(kcb + kco + (unsigned)(kn * 32 * 64 + ks * 16));
          }
          float mloc = NEGB;
          cmp_z(s, kt, t, t0, hh, tabh, mloc);
#pragma unroll
          for (int i = 0; i < 16; ++i) s[i] = (s[i] > -1e29f) ? ex2(s[i] - m) * inv : 0.f;
          const float G00 = s[0] + s[1] + s[2] + s[3], G01 = s[4] + s[5] + s[6] + s[7];
          const float G10 = s[8] + s[9] + s[10] + s[11], G11 = s[12] + s[13] + s[14] + s[15];
          const float pe0 = SHXF(s[7], 32), pe1 = SHXF(s[15], 32);
          const float X0 = hh ? pe0 : carry;
          const float X1 = hh ? pe1 : pe0;
          float* sp = scw + (8 * kt + 2 * hh) * 32 + l31;
          sp[0] += 2.f * G00 - s[3] + X0;
          sp[32] += 2.f * G01 - s[7] + s[3];
          sp[4 * 32] += 2.f * G10 - s[11] + X1;
          sp[5 * 32] += 2.f * G11 - s[15] + s[11];
          carry = pe1;
#pragma unroll
          for (int st = 0; st < 2; ++st) {
            bf16x8 pf = pack8(s, st);
#pragma unroll
            for (int et = 0; et < 2; ++et) O[et] = MFMA32(vf[st * 2 + et], pf, O[et]);
          }
        }
      }
      const float g0 = sigmoidf_(bf2f(proj[tok * EIN + C_GATE + head * 3 + 0]));
      float* pp = part + (tok * 8 + head) * 64;
#pragma unroll
      for (int et = 0; et < 2; ++et)
#pragma unroll
        for (int gq = 0; gq < 4; ++gq) {
          float4 r; r.x = g0 * O[et][4 * gq]; r.y = g0 * O[et][4 * gq + 1]; r.z = g0 * O[et][4 * gq + 2]; r.w = g0 * O[et][4 * gq + 3];
          *(float4*)(pp + et * 32 + 8 * gq + 4 * hh) = r;
        }
    }
    {
      const int cb = t >> 6;
#pragma unroll 1
      for (int r = 0; r < 64; ++r) {
        const int j = 4 * (r >> 1) + (r & 1) + 2 * hh;
        const bool forced = (j == 0) | (j == cb) | (j == cb - 1);
        const float v = scw[j * 32 + l31];
        scw[j * 32 + l31] = forced ? 1e9f : (j <= cb ? v : -1e9f);
      }
      unsigned mk0 = 0u, mk1 = 0u, mk2 = 0u, mk3 = 0u;
#pragma unroll 1
      for (int rd = 0; rd < 16; ++rd) {
        float bv = -INFINITY; int bj = 255;
#pragma unroll 4
        for (int r = 0; r < 64; ++r) {
          const int j = 4 * (r >> 1) + (r & 1) + 2 * hh;
          const float v = scw[j * 32 + l31];
          if (v > bv) { bv = v; bj = j; }
        }
        const float ov = SHXF(bv, 32); const int oj = SHXI(bj, 32);
        const bool other = (ov > bv) || (ov == bv && oj < bj);
        const int wj = other ? oj : bj;
        if (((wj >> 1) & 1) == hh) scw[wj * 32 + l31] = -3e38f;
        const unsigned bit = 1u << (wj & 31); const int wd = wj >> 5;
        mk0 |= wd == 0 ? bit : 0u; mk1 |= wd == 1 ? bit : 0u; mk2 |= wd == 2 ? bit : 0u; mk3 |= wd == 3 ? bit : 0u;
      }
      if (hh == 0) *(u32x4*)(selL + l31 * 16) = (u32x4){mk0, mk1, mk2, mk3};
    }
    {
      const int s_lo = t0 >= 512 ? t0 - 512 : 0;
      const int nwt = (t0 + 32 - s_lo) >> 5;
#pragma unroll 1
      for (int hp = 0; hp < 4; ++hp) {
        const int head = g * 4 + hp;
        const float* tabh = tab + head * 128;
        bf16x8 qf[4];
#pragma unroll
        for (int ks = 0; ks < 4; ++ks) qf[ks] = ldg8(proj + tok * EIN + C_NQ + head * 64 + ks * 16 + hh * 8);
        f32x16 O[2]; O[0] = zero16(); O[1] = zero16();
        float m = NEGB, l = 0.f;
        bf16x8 kf[4];
        const unsigned kwo = (unsigned)((b * SEQ + s_lo + pr) * EIN + C_KW + g * 64 + hh * 8);
        const unsigned vwo = (unsigned)(((b * 2 + g) * 64 + l31) * SEQ + s_lo + hh * 8);
#pragma unroll
        for (int ks = 0; ks < 4; ++ks) kf[ks] = ldg8(proj + kwo + ks * 16);
#pragma unroll 1
        for (int wt = 0; wt < nwt; ++wt) {
          const int s0 = s_lo + wt * 32;
          bf16x8 vf[4];
#pragma unroll
          for (int st = 0; st < 2; ++st)
#pragma unroll
            for (int et = 0; et < 2; ++et) vf[st * 2 + et] = ldg8(vwT + vwo + (unsigned)(et * 32 * SEQ + wt * 32 + st * 16));
          f32x16 s = zero16();
#pragma unroll
          for (int ks = 0; ks < 4; ++ks) s = MFMA32(kf[ks], qf[ks], s);
          {
            const int wn_ = wt + 1 < nwt ? wt + 1 : wt;
#pragma unroll
            for (int ks = 0; ks < 4; ++ks) kf[ks] = ldg8(proj + kwo + (unsigned)(wn_ * 32 * EIN + ks * 16));
          }
          float mloc = NEGB;
          const bool full = (s0 + 31 <= t0) && (t0 + 31 - s0 < 512);
          if (full && (t0 - (s0 + 31) >= 127)) {
            const float bf = tabh[127];
#pragma unroll
            for (int i = 0; i < 16; ++i) { float z = fmaf(s[i], C1, bf); s[i] = z; mloc = fmaxf(mloc, z); }
          } else {
#pragma unroll
            for (int i = 0; i < 16; ++i) {
              int key = s0 + (i & 7) + 8 * hh + 16 * (i >> 3);
              int dw = t - key; int dd = dw < 0 ? 0 : (dw > 127 ? 127 : dw);
              float z = (dw >= 0 && dw < 512) ? fmaf(s[i], C1, tabh[dd]) : NEGB;
              s[i] = z; mloc = fmaxf(mloc, z);
            }
          }
          mloc = red_max32(mloc);
          const float mn = fmaxf(m, mloc);
          const float alpha = ex2(m - mn);
          float ls = 0.f;
#pragma unroll
          for (int i = 0; i < 16; ++i) { float p = (s[i] > -1e29f) ? ex2(s[i] - mn) : 0.f; s[i] = p; ls += p; }
          l = l * alpha + ls; m = mn;
#pragma unroll
          for (int et = 0; et < 2; ++et)
#pragma unroll
            for (int i = 0; i < 16; ++i) O[et][i] *= alpha;
#pragma unroll
          for (int st = 0; st < 2; ++st) {
            bf16x8 pf = pack8(s, st);
#pragma unroll
            for (int et = 0; et < 2; ++et) O[et] = MFMA32(vf[st * 2 + et], pf, O[et]);
          }
        }
        const float lt = red_sum32(l);
        const float g2 = sigmoidf_(bf2f(proj[tok * EIN + C_GATE + head * 3 + 2])) / lt;
        float* pp = part + (tok * 8 + head) * 64;
#pragma unroll
        for (int et = 0; et < 2; ++et)
#pragma unroll
          for (int gq = 0; gq < 4; ++gq) {
            float4 r = *(float4*)(pp + et * 32 + 8 * gq + 4 * hh);
            r.x += g2 * O[et][4 * gq]; r.y += g2 * O[et][4 * gq + 1]; r.z += g2 * O[et][4 * gq + 2]; r.w += g2 * O[et][4 * gq + 3];
            *(float4*)(pp + et * 32 + 8 * gq + 4 * hh) = r;
          }
      }
    }
    __threadfence();
    {
      const int col = lane & 15, q4 = lane >> 4;
      const int qq = col >> 2, hcol = g * 4 + (col & 3);
      const float* tabc = tab + hcol * 128;
      const int rk = 8 * (col >> 2) + (col & 3);
      const unsigned kbase = (unsigned)((b * SEQ + rk) * EIN + C_KS + g * 64 + q4 * 8);
      const unsigned vbase = (unsigned)(((b * 2 + g) * 64 + col) * SEQ + q4 * 8);
#pragma unroll 1
      for (int grp_ = 0; grp_ < 8 * REP_C; ++grp_) {
        const int grp = grp_ & 7;
        const int tq = t0 + grp * 4 + qq;
        const int tmin = t0 + grp * 4, tmax = tmin + 3;
        const size_t tokq = (size_t)b * SEQ + tq;
        const u32x4 mym = *(const u32x4*)(selL + (grp * 4 + qq) * 16);
        unsigned u0, u1, u2, u3;
        {
          const u32x4 a0 = *(const u32x4*)(selL + (grp * 4 + 0) * 16), a1 = *(const u32x4*)(selL + (grp * 4 + 1) * 16);
          const u32x4 a2 = *(const u32x4*)(selL + (grp * 4 + 2) * 16), a3 = *(const u32x4*)(selL + (grp * 4 + 3) * 16);
          const u32x4 uu = a0 | a1 | a2 | a3;
          u0 = __builtin_amdgcn_readfirstlane(uu.x); u1 = __builtin_amdgcn_readfirstlane(uu.y);
          u2 = __builtin_amdgcn_readfirstlane(uu.z); u3 = __builtin_amdgcn_readfirstlane(uu.w);
          const int cbm = tmax >> 6;
          if (cbm < 31) { u0 &= (2u << cbm) - 1u; u1 = 0u; u2 = 0u; u3 = 0u; }
          else if (cbm < 63) { u1 &= (2u << (cbm - 32)) - 1u; u2 = 0u; u3 = 0u; }
          else if (cbm < 95) { u2 &= (2u << (cbm - 64)) - 1u; u3 = 0u; }
          else if (cbm < 127) { u3 &= (2u << (cbm - 96)) - 1u; }
        }
        auto next_blk = [&]() -> int {
          if (u0) { int bq = __builtin_ctz(u0); u0 &= u0 - 1u; return bq; }
          if (u1) { int bq = __builtin_ctz(u1); u1 &= u1 - 1u; return 32 + bq; }
          if (u2) { int bq = __builtin_ctz(u2); u2 &= u2 - 1u; return 64 + bq; }
          if (u3) { int bq = __builtin_ctz(u3); u3 &= u3 - 1u; return 96 + bq; }
          return -1;
        };
        bf16x8 qf[2];
#pragma unroll
        for (int st = 0; st < 2; ++st) qf[st] = ldg8(proj + tokq * EIN + C_NQ + hcol * 64 + st * 32 + q4 * 8);
        f32x4 O[4];
#pragma unroll
        for (int e = 0; e < 4; ++e) O[e] = (f32x4){0.f, 0.f, 0.f, 0.f};
        float m = NEGB, l = 0.f;
        bf16x8 kf[8], vf[8];
        auto load_k = [&](int jb) {
          const unsigned ko = kbase + (unsigned)(jb * 64 * EIN);
#pragma unroll
          for (int hf = 0; hf < 2; ++hf)
#pragma unroll
            for (int tl = 0; tl < 2; ++tl) {
              kf[(hf * 2 + tl) * 2 + 0] = ldg8(proj + ko + (unsigned)((hf * 32 + 4 * tl) * EIN));
              kf[(hf * 2 + tl) * 2 + 1] = ldg8(proj + ko + (unsigned)((hf * 32 + 4 * tl) * EIN + 32));
            }
        };
        auto load_v = [&](int jb) {
          const unsigned vo = vbase + (unsigned)(jb * 64);
#pragma unroll
          for (int hf = 0; hf < 2; ++hf)
#pragma unroll
            for (int e = 0; e < 4; ++e) vf[hf * 4 + e] = ldg8(vsT + vo + (unsigned)(e * 16 * SEQ + hf * 32));
        };
        int jb = next_blk();
        if (jb >= 0) { load_k(jb); load_v(jb); }
        while (jb >= 0) {
          const int base = jb * 64;
          const unsigned mw = jb < 32 ? mym.x : (jb < 64 ? mym.y : (jb < 96 ? mym.z : mym.w));
          const bool member = (mw >> (jb & 31)) & 1u;
          f32x4 a[2][2];
#pragma unroll
          for (int hf = 0; hf < 2; ++hf)
#pragma unroll
            for (int tl = 0; tl < 2; ++tl) {
              f32x4 acc = (f32x4){0.f, 0.f, 0.f, 0.f};
              acc = MFMA16(kf[(hf * 2 + tl) * 2 + 0], qf[0], acc);
              acc = MFMA16(kf[(hf * 2 + tl) * 2 + 1], qf[1], acc);
              a[hf][tl] = acc;
            }
          const int jn = next_blk();
          if (jn >= 0) load_k(jn);
          float mloc = NEGB;
          if (tmin - (base + 63) >= 127) {
            const float bf = tabc[127];
#pragma unroll
            for (int hf = 0; hf < 2; ++hf)
#pragma unroll
              for (int tl = 0; tl < 2; ++tl)
#pragma unroll
                for (int j = 0; j < 4; ++j) { float z = member ? fmaf(a[hf][tl][j], C1, bf) : NEGB; a[hf][tl][j] = z; mloc = fmaxf(mloc, z); }
          } else {
#pragma unroll
            for (int hf = 0; hf < 2; ++hf)
#pragma unroll
              for (int tl = 0; tl < 2; ++tl)
#pragma unroll
                for (int j = 0; j < 4; ++j) {
                  int key = base + hf * 32 + 8 * q4 + 4 * tl + j;
                  int dist = tq - key; int dd = dist < 0 ? 0 : (dist > 127 ? 127 : dist);
                  float z = (dist < 0 || !member) ? NEGB : fmaf(a[hf][tl][j], C1, tabc[dd]);
                  a[hf][tl][j] = z; mloc = fmaxf(mloc, z);
                }
          }
          mloc = red_max16(mloc);
          mloc = red_max32(mloc);
          const float mn = fmaxf(m, mloc);
          const float alpha = ex2(m - mn);
          float ls = 0.f;
#pragma unroll
          for (int hf = 0; hf < 2; ++hf)
#pragma unroll
            for (int tl = 0; tl < 2; ++tl)
#pragma unroll
              for (int j = 0; j < 4; ++j) { float p = (a[hf][tl][j] > -1e29f) ? ex2(a[hf][tl][j] - mn) : 0.f; a[hf][tl][j] = p; ls += p; }
          l = l * alpha + ls; m = mn;
#pragma unroll
          for (int e = 0; e < 4; ++e) O[e] *= alpha;
#pragma unroll
          for (int hf = 0; hf < 2; ++hf) {
            u32x4 u; u.x = pk2(a[hf][0][0], a[hf][0][1]); u.y = pk2(a[hf][0][2], a[hf][0][3]); u.z = pk2(a[hf][1][0], a[hf][1][1]); u.w = pk2(a[hf][1][2], a[hf][1][3]);
            const bf16x8 pf = __builtin_bit_cast(bf16x8, u);
#pragma unroll
            for (int e = 0; e < 4; ++e) O[e] = MFMA16(vf[hf * 4 + e], pf, O[e]);
          }
          if (jn >= 0) load_v(jn);
          jb = jn;
        }
        l = red_sum16(l);
        l = red_sum32(l);
        {
          const float g1 = sigmoidf_(bf2f(proj[tokq * EIN + C_GATE + hcol * 3 + 1])) / l;
          const float* pp = part + (tokq * 8 + hcol) * 64;
          bf16_t* op = ao + tokq * DM + hcol * 64;
#pragma unroll
          for (int e = 0; e < 4; ++e) {
            float4 pv = *(const float4*)(pp + e * 16 + 4 * q4);
            *(u32x2*)(op + e * 16 + 4 * q4) = pk4(pv.x + g1 * O[e][0], pv.y + g1 * O[e][1], pv.z + g1 * O[e][2], pv.w + g1 * O[e][3]);
          }
        }
      }
    }
  }
}

DI void ckv_norm_phase(KParamPtr P, int wv, int i2) {
  unsigned char* wsq = opqp(P->ws);
  const bf16_t* proj = (const bf16_t*)(wsq + OFF_U + U_PROJ);
  bf16_t* ckv = (bf16_t*)(wsq + OFF_MISC + 12 * MiB);
  const float* gn = P->in[15] + (size_t)i2 * 128;
  const int tid_ = tid_of(wv); const int lane = tid_ & 63, wave = tid_ >> 6;
  const int nw = gridDim.x * 8, gw = blockIdx.x * 8 + wave;
  const float g0 = gn[2 * lane], g1 = gn[2 * lane + 1];
  for (int tk = gw; tk < NTOK; tk += nw) {
    unsigned u = *(const unsigned*)(proj + (size_t)tk * EIN + C_DKV + 2 * lane);
    float a = __uint_as_float(u << 16), c = __uint_as_float(u & 0xffff0000u);
    float ss = wave_sum(a * a + c * c, lane);
    float rs = rsqrtf(ss * (1.f / 128.f) + 1e-5f);
    *(unsigned*)(ckv + (size_t)tk * 128 + 2 * lane) = pk2(a * rs * g0, c * rs * g1);
  }
}

DI unsigned fkey(float f) { unsigned u = __float_as_uint(f); return (u & 0x80000000u) ? ~u : (u | 0x80000000u); }

DI void dsa_index_phase(unsigned char* lds, KParamPtr P, int wv) {
  unsigned char* wsq = opqp(P->ws);
  float* sc = (float*)(lds + LDS_WORK);
  unsigned* hist = (unsigned*)(lds + LDS_WORK + 131072);
  const bf16_t* proj = (const bf16_t*)(wsq + OFF_U + U_PROJ);
  unsigned short* idx = (unsigned short*)(wsq + OFF_U + U_IDX);
  const int tid = tid_of(wv), lane = tid & 63, wave = tid >> 6, l31 = lane & 31, hh = lane >> 5;
  const int rhead = (l31 & 3) + 4 * ((l31 >> 3) & 1), ru = 2 * ((l31 >> 2) & 1) + (l31 >> 4);
  const unsigned long long lt_mask = (lane == 0) ? 0ull : (~0ull >> (64 - lane));
  __syncthreads();
  if (wave < 4) { const unsigned z0 = (unsigned)opq(0); unsigned* hz = hist + wave * 256 + lane * 4; hz[0] = z0; hz[1] = z0; hz[2] = z0; hz[3] = z0; }
  lds_barrier();
  for (int item = blockIdx.x; item < 8192; item += gridDim.x) {
    const int b = (item & 7) >> 1, t0 = (((item >> 3) << 1) + (item & 1)) * 4;
    const int ntile = (t0 + 4 + 31) >> 5;
    bf16x8 af[4];
    const bf16_t* iqp = proj + (size_t)(b * SEQ + t0 + ru) * EIN + C_IQ + rhead * 64 + hh * 8;
#pragma unroll
    for (int ks = 0; ks < 4; ++ks) af[ks] = ldg8(iqp + ks * 16);
    float w[16];
#pragma unroll
    for (int i = 0; i < 16; ++i) {
      const int uq = 2 * hh + (i >> 3), hd = (i & 3) + 4 * ((i >> 2) & 1);
      w[i] = bf2f(proj[(size_t)(b * SEQ + t0 + uq) * EIN + C_IW + hd]) * 0.04419417382415922f;
    }
#pragma unroll 1
    for (int kt0 = wave * 4; kt0 < ntile; kt0 += 32) {
      bf16x8 kf[4][4];
      const unsigned ko = (unsigned)((b * SEQ + kt0 * 32 + l31) * EIN + C_IK + hh * 8);
#pragma unroll
      for (int u = 0; u < 4; ++u)
#pragma unroll
        for (int ks = 0; ks < 4; ++ks) kf[u][ks] = ldg8(proj + ko + (unsigned)(u * 32 * EIN + ks * 16));
#pragma unroll
      for (int u = 0; u < 4; ++u) {
        f32x16 acc = zero16();
#pragma unroll
        for (int ks = 0; ks < 4; ++ks) acc = MFMA32(af[ks], kf[u][ks], acc);
        float s0 = 0.f, s1 = 0.f;
#pragma unroll
        for (int i = 0; i < 8; ++i) { s0 += w[i] * fmaxf(acc[i], 0.f); s1 += w[8 + i] * fmaxf(acc[8 + i], 0.f); }
        const int key = (kt0 + u) * 32 + l31;
        s0 += 0.f; s1 += 0.f;
        sc[(2 * hh) * 8192 + key] = s0;
        sc[(2 * hh + 1) * 8192 + key] = s1;
        if (key <= t0 + 2 * hh) atomicAdd(hist + (2 * hh) * 256 + (fkey(s0) >> 24), 1u);
        if (key <= t0 + 2 * hh + 1) atomicAdd(hist + (2 * hh + 1) * 256 + (fkey(s1) >> 24), 1u);
      }
    }
    const int qs = wave & 3, half = wave >> 2;
    const int n = t0 + qs + 1;
    const float* scq = sc + qs * 8192;
    unsigned short* out = idx + (size_t)(b * SEQ + t0 + qs) * 256;
    unsigned* H0 = hist + qs * 256;
    unsigned* H1 = hist + 1024 + qs * 256;
    const bool big = n > 256;
    if (!big && half == 0) { for (int i = lane; i < 256; i += 64) out[i] = (unsigned short)(i < n ? i : 0xFFFF); }
    lds_barrier();
    unsigned prefix = 0; int Kr = 256;
#pragma unroll 1
    for (int pass = 0; pass < 4; ++pass) {
      unsigned* Hc = (pass & 1) ? H1 : H0;
      unsigned* Hn = (pass & 1) ? H0 : H1;
      const int shift = 24 - 8 * pass;
      if (big && pass > 0) {
        f32x4 vnx = *(const f32x4*)(scq + half * 256 + lane * 4);
        for (int c = half; c * 256 < n; c += 2) {
          const int i0 = c * 256 + lane * 4;
          const f32x4 v = vnx;
          { const int cn = (c + 2) * 256 < n ? c + 2 : c; vnx = *(const f32x4*)(scq + cn * 256 + lane * 4); }
#pragma unroll
          for (int e = 0; e < 4; ++e) {
            const unsigned u = fkey(v[e]);
            const bool match = (i0 + e < n) && ((pass == 0) || ((u >> ((shift + 8) & 31)) == prefix));
            if (match) atomicAdd(Hc + ((u >> shift) & 255u), 1u);
          }
        }
      }
      lds_barrier();
      if (half == 0) { const unsigned z0 = (unsigned)opq(0); Hn[lane * 4] = z0; Hn[lane * 4 + 1] = z0; Hn[lane * 4 + 2] = z0; Hn[lane * 4 + 3] = z0; }
      if (big) {
        const u32x4 hv = *(const u32x4*)(Hc + lane * 4);
        const int sloc = (int)(hv.x + hv.y + hv.z + hv.w);
        int incl = sloc;
#pragma unroll
        for (int off = 1; off < 64; off <<= 1) { int v = bperm_i(lane + off, incl); if (lane + off < 64) incl += v; }
        int cum = incl - sloc;
        bool found = false; int d = 0, nK = 0;
#pragma unroll
        for (int bq = 3; bq >= 0; --bq) {
          const int hbq = (int)hv[bq];
          if (!found && cum < Kr && Kr <= cum + hbq) { found = true; d = lane * 4 + bq; nK = Kr - cum; }
          cum += hbq;
        }
        const unsigned long long mk = __ballot(found);
        const int src = __ffsll((long long)mk) - 1;
        d = bperm_i(src, d); Kr = bperm_i(src, nK);
        prefix = (prefix << 8) | (unsigned)d;
      }
      lds_barrier();
    }
    if (big && half == 0) {
      const unsigned T = prefix;
      int cg_ = 0, ce_ = 0;
      f32x4 vnx = *(const f32x4*)(scq + lane * 4);
      for (int c = 0; c * 256 < n; ++c) {
        const int i0 = c * 256 + lane * 4;
        const f32x4 v = vnx;
        { const int cn = (c + 1) * 256 < n ? c + 1 : c; vnx = *(const f32x4*)(scq + cn * 256 + lane * 4); }
        bool gt[4], eq[4]; unsigned long long mg[4], me[4];
#pragma unroll
        for (int e = 0; e < 4; ++e) {
          const unsigned u = fkey(v[e]);
          gt[e] = (i0 + e < n) && (u > T); eq[e] = (i0 + e < n) && (u == T);
          mg[e] = __ballot(gt[e]); me[e] = __ballot(eq[e]);
        }
        int pg = cg_;
#pragma unroll
        for (int e = 0; e < 4; ++e) {
          if (gt[e]) out[pg + __popcll(mg[e] & lt_mask)] = (unsigned short)(i0 + e);
          pg += __popcll(mg[e]);
        }
        cg_ = pg;
        if ((me[0] | me[1] | me[2] | me[3]) != 0ull) {
          int below = ce_;
#pragma unroll
          for (int e = 0; e < 4; ++e) below += __popcll(me[e] & lt_mask);
          int own = 0;
#pragma unroll
          for (int e = 0; e < 4; ++e) {
            const int rank = below + own;
            if (eq[e] && rank < Kr) out[(256 - Kr) + rank] = (unsigned short)(i0 + e);
            own += eq[e] ? 1 : 0;
          }
#pragma unroll
          for (int e = 0; e < 4; ++e) ce_ += __popcll(me[e]);
        }
      }
    }
    lds_barrier();
  }
}

DI void dsa_sparse_phase(unsigned char* lds, KParamPtr P, int wv) {
  unsigned char* wsq = opqp(P->ws);
  const float* tab = (const float*)(lds + LDS_TAB);
  const int tid = tid_of(wv), lane = tid & 63, wave = tid >> 6;
  bf16_t* gbuf = (bf16_t*)(lds + LDS_WORK + 4096 + wave * 9216);
  unsigned short* idL = (unsigned short*)(lds + LDS_WORK + 4096 + wave * 9216 + 8704);
  __syncthreads();
  bf16_t* qlat = (bf16_t*)(wsq + OFF_U + U_QLAT);
  const bf16_t* ckv = (const bf16_t*)(wsq + OFF_MISC + 12 * MiB);
  const unsigned short* idx = (const unsigned short*)(wsq + OFF_U + U_IDX);
  const int nw = gridDim.x * 8, gw = blockIdx.x * 8 + wave;
  const int col = lane & 15, q4 = lane >> 4;
  const float* tabc = tab + (8 + (col & 7)) * 128;
  const int rk = 8 * (col >> 2) + (col & 3);
  const int grow = lane >> 4, gc16 = lane & 15;
  auto qmap = [](int qi) -> int {
    const int w8 = qi & 7, blk = (qi >> 3) & 255, rnd = qi >> 11, x = blk & 7;
    return ((x >> 1) << 13) + ((((rnd * 32 + (blk >> 3)) << 1) + (x & 1)) << 3) + w8;
  };
  u32x2 idn = (gw < NTOK) ? *(const u32x2*)(idx + (size_t)qmap(gw) * 256 + lane * 4) : (u32x2){0u, 0u};
  for (int qi = gw; qi < NTOK; qi += nw) {
    const int q = qmap(qi);
    const int b = q >> 13, tq = q & (SEQ - 1);
    asm volatile("" ::: "memory");
    *(u32x2*)(idL + lane * 4) = idn;
    asm volatile("" ::: "memory");
    {
      const int qn = qmap(qi + nw < NTOK ? qi + nw : qi);
      idn = *(const u32x2*)(idx + (size_t)qn * 256 + lane * 4);
    }
    bf16x8 qf[4];
#pragma unroll
    for (int st = 0; st < 4; ++st) qf[st] = (col < 8) ? ldg8(qlat + (size_t)q * DM + col * 128 + st * 32 + q4 * 8) : zero8();
    f32x4 O[8];
#pragma unroll
    for (int e = 0; e < 8; ++e) O[e] = (f32x4){0.f, 0.f, 0.f, 0.f};
    float m = NEGB, l = 0.f;
    u32x4 gr[8];
    const unsigned cb = (unsigned)(b * SEQ) * 128u + (unsigned)gc16 * 8u;
#pragma unroll
    for (int i = 0; i < 8; ++i) {
      int id = idL[grow + 4 * i]; id = id > SEQ - 1 ? SEQ - 1 : id;
      gr[i] = *(const u32x4*)(ckv + cb + (unsigned)id * 128u);
    }
#pragma unroll 1
    for (int ch = 0; ch < 8; ++ch) {
#pragma unroll
      for (int i = 0; i < 8; ++i) *(u32x4*)(gbuf + (grow + 4 * i) * 136 + gc16 * 8) = gr[i];
      asm volatile("" ::: "memory");
      {
        const int cn = ch < 7 ? ch + 1 : ch;
#pragma unroll
        for (int i = 0; i < 8; ++i) {
          int id = idL[cn * 32 + grow + 4 * i]; id = id > SEQ - 1 ? SEQ - 1 : id;
          gr[i] = *(const u32x4*)(ckv + cb + (unsigned)id * 128u);
        }
      }
      f32x4 a[2];
#pragma unroll
      for (int tl = 0; tl < 2; ++tl) {
        f32x4 acc = (f32x4){0.f, 0.f, 0.f, 0.f};
#pragma unroll
        for (int st = 0; st < 4; ++st) acc = MFMA16(*(const bf16x8*)(gbuf + (rk + 4 * tl) * 136 + st * 32 + q4 * 8), qf[st], acc);
        a[tl] = acc;
      }
      float mloc = NEGB;
#pragma unroll
      for (int tl = 0; tl < 2; ++tl)
#pragma unroll
        for (int j = 0; j < 4; ++j) {
          const int id = idL[ch * 32 + 8 * q4 + 4 * tl + j];
          const int dist = tq - id; const int dd = dist < 0 ? 0 : (dist > 127 ? 127 : dist);
          const float tb = tabc[dd];
          float z = fmaf(a[tl][j], C1, tb); z = dist < 0 ? NEGB : z;
          a[tl][j] = z; mloc = fmaxf(mloc, z);
        }
      mloc = red_max16(mloc);
      mloc = red_max32(mloc);
      const float mn = fmaxf(m, mloc);
      const float alpha = ex2(m - mn);
      float ls = 0.f;
#pragma unroll
      for (int tl = 0; tl < 2; ++tl)
#pragma unroll
        for (int j = 0; j < 4; ++j) { float p = (a[tl][j] > -1e29f) ? ex2(a[tl][j] - mn) : 0.f; a[tl][j] = p; ls += p; }
      l = l * alpha + ls; m = mn;
#pragma unroll
      for (int e = 0; e < 8; ++e) O[e] *= alpha;
      u32x4 u; u.x = pk2(a[0][0], a[0][1]); u.y = pk2(a[0][2], a[0][3]); u.z = pk2(a[1][0], a[1][1]); u.w = pk2(a[1][2], a[1][3]);
      const bf16x8 pf = __builtin_bit_cast(bf16x8, u);
#pragma unroll
      for (int rt = 0; rt < 8; ++rt) {
        const bf16_t* gp = gbuf + (8 * q4) * 136 + rt * 16 + col;
        u32x4 v;
        v.x = (unsigned)gp[0] | ((unsigned)gp[136] << 16); v.y = (unsigned)gp[2 * 136] | ((unsigned)gp[3 * 136] << 16);
        v.z = (unsigned)gp[4 * 136] | ((unsigned)gp[5 * 136] << 16); v.w = (unsigned)gp[6 * 136] | ((unsigned)gp[7 * 136] << 16);
        O[rt] = MFMA16(__builtin_bit_cast(bf16x8, v), pf, O[rt]);
      }
      asm volatile("" ::: "memory");
    }
    l = red_sum16(l);
    l = red_sum32(l);
    if (col < 8) {
      const float inv = 1.f / l;
      bf16_t* op = qlat + (size_t)q * DM + col * 128;
#pragma unroll
      for (int rt = 0; rt < 8; ++rt) *(u32x2*)(op + rt * 16 + 4 * q4) = pk4(O[rt][0] * inv, O[rt][1] * inv, O[rt][2] * inv, O[rt][3] * inv);
    }
  }
}

DI void gbar(unsigned* cnt, unsigned& target, int tid) {
  asm volatile("s_waitcnt vmcnt(0)" ::: "memory");
  __syncthreads();
  target += gridDim.x;
  if (tid == 0) {
    __builtin_amdgcn_fence(__ATOMIC_RELEASE, "agent");
    asm volatile("s_waitcnt vmcnt(0)" ::: "memory");
    __hip_atomic_fetch_add(cnt, 1u, __ATOMIC_RELAXED, __HIP_MEMORY_SCOPE_AGENT);
    while (__hip_atomic_load(cnt, __ATOMIC_RELAXED, __HIP_MEMORY_SCOPE_AGENT) < target) __builtin_amdgcn_s_sleep(1);
    __builtin_amdgcn_fence(__ATOMIC_ACQUIRE, "agent");
    asm volatile("s_waitcnt vmcnt(0)" ::: "memory");
  }
  __syncthreads();
}

__global__ void __launch_bounds__(NTHREADS) mega(Params P0) {
  extern __shared__ __attribute__((aligned(16))) unsigned char lds[];
  cg::grid_group grid = cg::this_grid();
#define P kparams()
  const int wv = __builtin_amdgcn_readfirstlane((int)(threadIdx.x >> 6));
  const int tid = tid_of(wv);
  {
    float* tab = (float*)(lds + LDS_TAB);
    for (int i = tid; i < 16 * 128; i += NTHREADS) { int col = i >> 7, d = i & 127; tab[i] = P->in[2][(int)kBucket[d] * 16 + col] * LOG2E; }
    __syncthreads();
  }
  const float* ada = (const float*)(opqp(P->ws) + OFF_MISC + MS_ADA);

  unsigned* barp = (unsigned*)(opqp(P->ws) + OFF_BAR);
  unsigned bar_target = 0;
  ada_partial_phase(lds, P, wv);
  wprep_phase(lds, P, wv, 0);
  grid.sync();
  ada_reduce_phase(P, wv);
  gbar(barp, bar_target, tid_of(wv));
  for (int rp = 0; rp < REP_SYNC; ++rp) gbar(barp, bar_target, tid_of(wv));
  ln_mod_phase(P, wv, P->in[0], nullptr, nullptr, nullptr, ada, ada + 1024, false, true);
  gbar(barp, bar_target, tid_of(wv));

#pragma unroll 1
  for (int l = 0; l < 4; ++l) {
    const int i2 = l >> 1;
    unsigned char* ws = opqp(P->ws);
    bf16_t* hb = (bf16_t*)(ws + OFF_HB);
    bf16_t* ao = (bf16_t*)(ws + OFF_AO);
    unsigned char* U = ws + OFF_U;
    unsigned char* WT = ws + OFF_WT;
    const float* ada = (const float*)(ws + OFF_MISC + MS_ADA);
    const float* adal = ada + (size_t)l * 4 * 6144;
    const float* xin = (l == 0) ? P->in[0] : P->out;
    if ((l & 1) == 0) {
      bf16_t* proj = (bf16_t*)(U + U_PROJ);
      bf16_t* qlat = (bf16_t*)(U + U_QLAT);
      bf16_t* hid = (bf16_t*)(ws + OFF_MISC + MS_HID);
      const float* cbias = (const float*)(ws + OFF_MISC + MS_CB);
      for (int rp = 0; rp < REP_GEMM; ++rp) {
      gemm_run(lds, wv, APlain{hb, DM}, (const bf16_t*)(WT + WT_IN), DM, NTOK, EIN, DM, EpiEvenProj{proj, (bf16_t*)(U + U_VST), (bf16_t*)(U + U_VWT)}, 0);
      gbar(barp, bar_target, tid_of(wv)); }
#pragma unroll 1
      for (int kv = 0; kv < 2; ++kv)
        gemm_run(lds, wv, ACmp{proj, kv ? C_VC : C_KC}, (const bf16_t*)(WT + WT_CW1) + kv * 256 * 2048, 2048, 4096, 256, 2048, EpiCmp1{cbias + kv * 256, hid + kv * 4096 * 256}, 16 * kv);
#pragma unroll 1
      for (int h = 0; h < 8; ++h)
        gemm_run(lds, wv, APlain{proj + C_DQ + h * 64, EIN}, (const bf16_t*)(WT + WT_UK) + h * 64, 512, NTOK, 128, 64, EpiRow{qlat + h * 128, DM}, 32 + h * 128);
      ckv_norm_phase(P, wv, i2);
      gbar(barp, bar_target, tid_of(wv));
#pragma unroll 1
      for (int kv = 0; kv < 2; ++kv)
        gemm_run(lds, wv, APlain{hid + kv * 4096 * 256, 256}, (const bf16_t*)(WT + WT_CW2) + kv * 64 * 256, 256, 4096, 64, 256, EpiCmp2{(bf16_t*)(ws + OFF_MISC + MS_KC), (bf16_t*)(ws + OFF_MISC + MS_VCT), kv}, 16 * kv);
      for (int rp = 0; rp < REP_IDX; ++rp) dsa_index_phase(lds, P, wv);
      gbar(barp, bar_target, tid_of(wv));
      for (int rp = 0; rp < REP_NSA; ++rp) nsa_phase(lds, P, wv);
      dsa_sparse_phase(lds, P, wv);
      gbar(barp, bar_target, tid_of(wv));
#pragma unroll 1
      for (int h = 0; h < 8; ++h)
        gemm_run(lds, wv, APlain{qlat + h * 128, DM}, (const bf16_t*)(WT + WT_UV) + h * 64 * 128, 128, NTOK, 64, 128, EpiRow{ao + 512 + h * 64, DM}, h * 128);
      gbar(barp, bar_target, tid_of(wv));
    } else {
      for (int rp = 0; rp < REP_GEMM; ++rp) {
      gemm_run(lds, wv, APlain{hb, DM}, (const bf16_t*)(WT + WT_IN), DM, NTOK, OIN, DM, EpiOddProj{(bf16_t*)(U + U_QK), (bf16_t*)(U + U_VT)}, 0);
      gbar(barp, bar_target, tid_of(wv)); }
      for (int rp = 0; rp < REP_DIFF; ++rp) {
      diff_attn_phase(lds, P, wv, l);
      gbar(barp, bar_target, tid_of(wv)); }
    }
    gemm_run(lds, wv, APlain{ao, DM}, (const bf16_t*)(WT + WT_OUT), DM, NTOK, DM, DM, EpiResid{xin, P->out, adal + 2048}, 0);
    gbar(barp, bar_target, tid_of(wv));
    ln_mod_phase(P, wv, P->out, P->out, P->in[5] + (size_t)(l * 2) * DM, P->in[6] + (size_t)(l * 2) * DM, adal + 3072, adal + 4096, true, true);
    gbar(barp, bar_target, tid_of(wv));
    for (int rp = 0; rp < REP_GEMM; ++rp) {
    gemm_run(lds, wv, APlain{hb, DM}, (const bf16_t*)(WT + WT_M1), DM, NTOK, DFF, DM, EpiSqRelu{(bf16_t*)U}, 0);
    gbar(barp, bar_target, tid_of(wv)); }
    gemm_run(lds, wv, APlain{(const bf16_t*)U, DFF}, (const bf16_t*)(WT + WT_M2), DFF, NTOK, DM, DFF, EpiResid{P->out, P->out, adal + 5120}, 0);
    gbar(barp, bar_target, tid_of(wv));
    ln_mod_phase(P, wv, P->out, P->out, P->in[5] + (size_t)(l * 2 + 1) * DM, P->in[6] + (size_t)(l * 2 + 1) * DM, adal + 4 * 6144, adal + 4 * 6144 + 1024, true, l < 3);
    if (l < 3) { wprep_phase(lds, P, wv, l + 1); gbar(barp, bar_target, tid_of(wv)); }
  }
}

#undef P
extern "C" void kernel_launch(void* const* d_in, const int* in_sizes, int n_in, void* d_out, int out_size, void* d_ws, size_t ws_size, hipStream_t stream) {
  static int grid_blocks = 0;
  if (grid_blocks == 0) {
    int dev = 0, cus = 0, per_cu = 0;
    (void)hipGetDevice(&dev);
    (void)hipDeviceGetAttribute(&cus, hipDeviceAttributeMultiprocessorCount, dev);
    if (hipFuncSetAttribute((const void*)mega, hipFuncAttributeMaxDynamicSharedMemorySize, LDS_BYTES) != hipSuccess) fprintf(stderr, "setattr failed\n");
    (void)hipOccupancyMaxActiveBlocksPerMultiprocessor(&per_cu, (const void*)mega, NTHREADS, LDS_BYTES);
    fprintf(stderr, "cus %d per_cu %d ws_size %zu n_in %d\n", cus, per_cu, ws_size, n_in);
    if (per_cu < 1 || n_in != 24 || ws_size < WS_NEED + 8 * MiB) { fprintf(stderr, "cannot launch\n"); grid_blocks = -1; }
    else grid_blocks = cus;
  }
  if (grid_blocks < 0) return;
  Params p{};
  for (int i = 0; i < 24; ++i) p.in[i] = (const float*)d_in[i];
  p.out = (float*)d_out; p.ws = (unsigned char*)d_ws;
  void* args[] = {&p};
  if (hipMemsetAsync((unsigned char*)d_ws + OFF_BAR, 0, 256, stream) != hipSuccess) fprintf(stderr, "memset failed\n");
  hipError_t e = hipLaunchCooperativeKernel((const void*)mega, dim3(grid_blocks), dim3(NTHREADS), args, LDS_BYTES, stream);
  if (e != hipSuccess) fprintf(stderr, "coop launch failed: %s\n", hipGetErrorString(e));
}
```

```cpp
#include <hip/hip_runtime.h>
#include <hip/hip_bf16.h>
#include <hip/hip_cooperative_groups.h>
#include <cstdio>
namespace cg = cooperative_groups;

#define DI __device__ __forceinline__
#define NTHREADS 512
#ifndef REP_C
#define REP_C 1
#endif
#ifndef REP_SYNC
#define REP_SYNC 0
#endif
#ifndef REP_GEMM
#define REP_GEMM 1
#endif
#ifndef REP_DIFF
#define REP_DIFF 1
#endif
#ifndef REP_NSA
#define REP_NSA 1
#endif
#ifndef REP_IDX
#define REP_IDX 1
#endif
#define LDS_BYTES (144 * 1024)

typedef unsigned short bf16_t;
typedef __attribute__((ext_vector_type(8))) short bf16x8;
typedef __attribute__((ext_vector_type(16))) float f32x16;
typedef __attribute__((ext_vector_type(4))) float f32x4;
typedef __attribute__((ext_vector_type(2))) float f32x2;
typedef __attribute__((ext_vector_type(2))) __bf16 bfx2;
typedef __attribute__((ext_vector_type(4))) unsigned u32x4;
typedef __attribute__((ext_vector_type(2))) unsigned u32x2;

#define MFMA32(a, b, c) __builtin_amdgcn_mfma_f32_32x32x16_bf16((a), (b), (c), 0, 0, 0)
#define MFMA16(a, b, c) __builtin_amdgcn_mfma_f32_16x16x32_bf16((a), (b), (c), 0, 0, 0)

constexpr int SEQ = 8192, NB = 4, DM = 1024, NTOK = NB * SEQ, DFF = 4096;
constexpr int EIN = 2528, OIN = 3072;
constexpr float ALPHA_C = 1.681792830507429f;
constexpr float LOG2E = 1.4426950408889634f;
constexpr float C1 = 0.125f * LOG2E;
constexpr float NEGB = -1e30f;
constexpr int C_NQ = 0, C_KC = 512, C_VC = 640, C_KS = 768, C_VS = 896, C_KW = 1024, C_VW = 1152, C_GATE = 1280, C_DQ = 1304, C_DKV = 1816, C_IQ = 1944, C_IK = 2456, C_IW = 2520;

constexpr size_t MiB = 1024 * 1024;
constexpr size_t OFF_HB = 0;
constexpr size_t OFF_AO = 64 * MiB;
constexpr size_t OFF_U = 128 * MiB;
constexpr size_t OFF_WT = 384 * MiB;
constexpr size_t OFF_MISC = 416 * MiB;
constexpr size_t OFF_BAR = 436 * MiB;
constexpr size_t WS_NEED = 440 * MiB;
constexpr size_t U_PROJ = 0;
constexpr size_t U_VST = 158 * MiB;
constexpr size_t U_VWT = 166 * MiB;
constexpr size_t U_QLAT = 174 * MiB;
constexpr size_t U_IDX = 238 * MiB;
constexpr size_t U_QK = 0;
constexpr size_t U_VT = 128 * MiB;
constexpr size_t WT_IN = 0, WT_OUT = 6 * MiB, WT_M1 = 8 * MiB, WT_M2 = 16 * MiB, WT_CW1 = 24 * MiB, WT_CW2 = 26 * MiB, WT_UK = 27 * MiB, WT_UV = 28 * MiB;
constexpr size_t MS_ADAP = 0;
constexpr size_t MS_ADA = 4 * MiB;
constexpr size_t MS_CB = 5 * MiB;
constexpr size_t MS_KC = 6 * MiB;
constexpr size_t MS_VCT = 7 * MiB;
constexpr size_t MS_HID = 8 * MiB;

struct Params {
  const float* in[24];
  float* out;
  unsigned char* ws;
  int pad0, pad1;
};

typedef const __attribute__((address_space(4))) Params* KParamPtr;
__device__ __forceinline__ KParamPtr kparams() { unsigned long long v = (unsigned long long)__builtin_amdgcn_kernarg_segment_ptr(); asm volatile("" : "+s"(v)); return (KParamPtr)v; }
__device__ const unsigned char kBucket[128] = {0, 1, 2, 3, 4, 5, 6, 7, 8, 9, 10, 11, 12, 13, 14, 15, 16, 16, 16, 17, 17, 18, 18, 18, 19, 19, 19, 20, 20, 20, 20, 21, 21, 21, 21, 22, 22, 22, 22, 22, 23, 23, 23, 23, 23, 23, 24, 24, 24, 24, 24, 24, 25, 25, 25, 25, 25, 25, 25, 26, 26, 26, 26, 26, 26, 26, 26, 27, 27, 27, 27, 27, 27, 27, 27, 27, 27, 28, 28, 28, 28, 28, 28, 28, 28, 28, 28, 29, 29, 29, 29, 29, 29, 29, 29, 29, 29, 29, 29, 30, 30, 30, 30, 30, 30, 30, 30, 30, 30, 30, 30, 30, 30, 31, 31, 31, 31, 31, 31, 31, 31, 31, 31, 31, 31, 31, 31, 31};

DI unsigned pk2(float a, float b) { f32x2 v = {a, b}; bfx2 r = __builtin_convertvector(v, bfx2); return __builtin_bit_cast(unsigned, r); }
DI bf16_t f2bf(float a) { return (bf16_t)(pk2(a, 0.f) & 0xffffu); }
DI float bf2f(bf16_t v) { return __uint_as_float(((unsigned)v) << 16); }
DI u32x2 pk4(float a, float b, float c, float d) { u32x2 r; r.x = pk2(a, b); r.y = pk2(c, d); return r; }
DI int opq(int x) { asm volatile("" : "+v"(x)); return x; }
DI float opqf(float x) { asm volatile("" : "+v"(x)); return x; }
template <class T> DI T* opqp(T* p) { unsigned long long v = (unsigned long long)p; asm volatile("" : "+s"(v)); return (T*)v; }
DI int tid_of(int wave_s) { unsigned z = 0; asm volatile("" : "+s"(z)); int l = __builtin_amdgcn_mbcnt_hi(~0u, __builtin_amdgcn_mbcnt_lo(~0u, z)); return wave_s * 64 + l; }
DI float ex2(float x) { return __builtin_amdgcn_exp2f(x); }
DI float bperm_f(int srclane, float v) { return __int_as_float(__builtin_amdgcn_ds_bpermute(srclane << 2, __float_as_int(v))); }
DI int bperm_i(int srclane, int v) { return __builtin_amdgcn_ds_bpermute(srclane << 2, v); }
#define SHXF(v, m) bperm_f(lane ^ (m), (v))
#define SHXI(v, m) bperm_i(lane ^ (m), (v))
DI float red_max32(float x) { auto r = __builtin_amdgcn_permlane32_swap(__float_as_uint(x), __float_as_uint(x), false, false); return fmaxf(__uint_as_float(r[0]), __uint_as_float(r[1])); }
DI float red_max16(float x) { auto r = __builtin_amdgcn_permlane16_swap(__float_as_uint(x), __float_as_uint(x), false, false); return fmaxf(__uint_as_float(r[0]), __uint_as_float(r[1])); }
DI float red_sum32(float x) { auto r = __builtin_amdgcn_permlane32_swap(__float_as_uint(x), __float_as_uint(x), false, false); return __uint_as_float(r[0]) + __uint_as_float(r[1]); }
DI float red_sum16(float x) { auto r = __builtin_amdgcn_permlane16_swap(__float_as_uint(x), __float_as_uint(x), false, false); return __uint_as_float(r[0]) + __uint_as_float(r[1]); }
DI float wave_sum(float v, int lane) {
#pragma unroll
  for (int o = 32; o >= 1; o >>= 1) v += SHXF(v, o);
  return v;
}
DI int pi_row(int r) { return (r & 0x13) | ((r & 4) << 1) | ((r & 8) >> 1); }
DI bf16x8 pack8(const f32x16& x, int s8) {
  u32x4 u; u.x = pk2(x[8 * s8 + 0], x[8 * s8 + 1]); u.y = pk2(x[8 * s8 + 2], x[8 * s8 + 3]); u.z = pk2(x[8 * s8 + 4], x[8 * s8 + 5]); u.w = pk2(x[8 * s8 + 6], x[8 * s8 + 7]);
  return __builtin_bit_cast(bf16x8, u);
}
DI bf16x8 ldg8(const bf16_t* p) { return *(const bf16x8*)p; }
#define GLOAD16(dst, ptr) asm volatile("global_load_dwordx4 %0, %1, off" : "=&v"(dst) : "v"(ptr) : "memory")
DI void lds_barrier() { asm volatile("s_waitcnt lgkmcnt(0)\n\ts_barrier" ::: "memory"); }
DI void vm_wait0() { asm volatile("s_waitcnt vmcnt(0)" ::: "memory"); }
DI bf16x8 zero8() { u32x4 u = {0u, 0u, 0u, 0u}; return __builtin_bit_cast(bf16x8, u); }
DI f32x16 zero16() { f32x16 z;
#pragma unroll
  for (int i = 0; i < 16; ++i) z[i] = 0.f;
  return z; }
DI float sigmoidf_(float x) { return 1.f / (1.f + __expf(-x)); }
DI float gelu_tanh(float x) { float u = 0.7978845608028654f * (x + 0.044715f * x * x * x); float e = __expf(2.f * u); float th = 1.f - 2.f / (e + 1.f); return 0.5f * x * (1.f + th); }

constexpr int LROW = 72;
constexpr int LDS_TAB = 0;
constexpr int LDS_WORK = 8192;

struct APlain { const bf16_t* A; int lda; DI const bf16_t* base() const { return A; } DI unsigned rowoff(int m) const { return (unsigned)(m * lda); } DI unsigned koff(int k) const { return (unsigned)k; } };
struct ACmp {
  const bf16_t* proj; int col0;
  DI const bf16_t* base() const { return proj; }
  DI unsigned rowoff(int m) const { int combo = m >> 9, n = m & 511, b = combo >> 1, g = combo & 1; return (unsigned)((b * SEQ + 16 * n) * EIN + col0 + g * 64); }
  DI unsigned koff(int k) const { return (unsigned)((k >> 6) * EIN + (k & 63)); }
};

typedef __attribute__((address_space(3))) unsigned lds_u32_t;
DI void dma16(const void* g, unsigned char* l) { __builtin_amdgcn_global_load_lds((const unsigned*)g, (lds_u32_t*)(unsigned)(size_t)l, 16, 0, 0); }
constexpr int GST = 65536;
template <class AF, class EF>
DI void gemm_run(unsigned char* lds, int wv, const AF& af, const bf16_t* __restrict__ Bt, int ldb, int M, int N, int K, const EF& ef, int blk_off) {
  unsigned char* sBase = lds + LDS_WORK;
  const int tid = tid_of(wv), lane = tid & 63, wave = tid >> 6;
  const int wn = wave & 3, wm = wave >> 2;
  const int l15 = lane & 15, q4 = lane >> 4;
  const int mtiles = M >> 8, ntiles = (N + 255) >> 8, ntl = mtiles * ntiles;
  const int G = gridDim.x;
  int first = ((int)blockIdx.x - (blk_off % G) + G) % G;
  const int nk = K >> 6;
  const bool xmap = (blk_off == 0) && ((mtiles & 7) == 0) && ((G & 7) == 0);
  int tstep = G;
  if (xmap) { first = (int)blockIdx.x >> 3; tstep = G >> 3; }
  const int ntl_eff = xmap ? (ntl >> 3) : ntl;
  const int crow = tid >> 3;
  const int cch = ((tid & 7) ^ ((tid >> 4) & 7)) * 8;
  const int swz = l15 >> 1;
  for (int tile_ = first; tile_ < ntl_eff; tile_ += tstep) {
    int nt, mt;
    if (xmap) { nt = tile_ % ntiles; mt = (tile_ / ntiles) * 8 + ((int)blockIdx.x & 7); }
    else { nt = tile_ % ntiles; mt = tile_ / ntiles; }
    const int m0 = mt << 8, n0 = nt << 8;
    f32x4 acc[4][8];
#pragma unroll
    for (int i = 0; i < 4; ++i)
#pragma unroll
      for (int j = 0; j < 8; ++j) acc[i][j] = (f32x4){0.f, 0.f, 0.f, 0.f};
    unsigned aoff[4], boff[4];
    const bf16_t* Ab = af.base();
#pragma unroll
    for (int i = 0; i < 4; ++i) {
      int row = crow + 64 * i;
      aoff[i] = af.rowoff(m0 + row);
      int n = n0 + row; n = n < N ? n : N - 1;
      boff[i] = (unsigned)(n * ldb + cch);
    }
    __syncthreads();
#pragma unroll
    for (int i = 0; i < 4; ++i) {
      dma16(Ab + aoff[i] + af.koff(cch), sBase + 32768 + (i * 512 + tid) * 16);
      dma16(Bt + boff[i], sBase + (i * 512 + tid) * 16);
    }
    vm_wait0();
    __syncthreads();
#pragma unroll 1
    for (int kt = 0; kt < nk; ++kt) {
      unsigned char* cur = sBase + (kt & 1) * GST;
      if (kt + 1 < nk) {
        unsigned char* nxt = sBase + ((kt + 1) & 1) * GST;
        const int k0 = (kt + 1) << 6;
#pragma unroll
        for (int i = 0; i < 4; ++i) {
          dma16(Ab + aoff[i] + af.koff(k0 + cch), nxt + 32768 + (i * 512 + tid) * 16);
          dma16(Bt + boff[i] + (unsigned)k0, nxt + (i * 512 + tid) * 16);
        }
      }
#pragma unroll
      for (int ks = 0; ks < 2; ++ks) {
        bf16x8 wf[4], xf[8];
#pragma unroll
        for (int i = 0; i < 4; ++i) wf[i] = *(const bf16x8*)(cur + (wn * 64 + i * 16 + l15) * 128 + (((ks * 4 + q4) ^ swz) * 16));
#pragma unroll
        for (int j = 0; j < 8; ++j) xf[j] = *(const bf16x8*)(cur + 32768 + (wm * 128 + j * 16 + l15) * 128 + (((ks * 4 + q4) ^ swz) * 16));
#pragma unroll
        for (int i = 0; i < 4; ++i)
#pragma unroll
          for (int j = 0; j < 8; ++j) acc[i][j] = MFMA16(wf[i], xf[j], acc[i][j]);
      }
      vm_wait0();
      __syncthreads();
    }
#pragma unroll
    for (int i = 0; i < 4; ++i)
#pragma unroll
      for (int j = 0; j < 8; ++j) {
        int n = n0 + wn * 64 + i * 16 + 4 * q4;
        int m = m0 + wm * 128 + j * 16 + l15;
        if (n < N) ef.store(m, n, acc[i][j][0], acc[i][j][1], acc[i][j][2], acc[i][j][3]);
      }
  }
}

struct EpiRow { bf16_t* C; int ldc; DI void store(int m, int n, float a, float b, float c, float d) const { *(u32x2*)(C + (size_t)m * ldc + n) = pk4(a, b, c, d); } };
struct EpiSqRelu { bf16_t* C; DI void store(int m, int n, float a, float b, float c, float d) const {
    a = fmaxf(a, 0.f); b = fmaxf(b, 0.f); c = fmaxf(c, 0.f); d = fmaxf(d, 0.f);
    *(u32x2*)(C + (size_t)m * DFF + n) = pk4(a * a, b * b, c * c, d * d); } };
struct EpiResid { const float* xin; float* out; const float* gate;
  DI void store(int m, int n, float a, float b, float c, float d) const {
    int bb = m >> 13;
    float4 x = *(const float4*)(xin + (size_t)m * DM + n);
    float4 g = *(const float4*)(gate + bb * 6144 + n);
    const float one = opqf(1.0f);
    float4 r; r.x = ALPHA_C * x.x + (one + g.x) * a; r.y = ALPHA_C * x.y + (one + g.y) * b; r.z = ALPHA_C * x.z + (one + g.z) * c; r.w = ALPHA_C * x.w + (one + g.w) * d;
    *(float4*)(out + (size_t)m * DM + n) = r; } };
struct EpiEvenProj { bf16_t* proj; bf16_t* vsT; bf16_t* vwT;
  DI void store(int m, int n, float a, float b, float c, float d) const {
    int bb = m >> 13, s = m & (SEQ - 1);
    if (n >= C_VS && n < C_KW) { int e = n - C_VS; bf16_t* p = vsT + ((size_t)(bb * 128 + e)) * SEQ + s; p[0] = f2bf(a); p[SEQ] = f2bf(b); p[2 * SEQ] = f2bf(c); p[3 * SEQ] = f2bf(d); }
    else if (n >= C_VW && n < C_GATE) { int e = n - C_VW; bf16_t* p = vwT + ((size_t)(bb * 128 + e)) * SEQ + s; p[0] = f2bf(a); p[SEQ] = f2bf(b); p[2 * SEQ] = f2bf(c); p[3 * SEQ] = f2bf(d); }
    else *(u32x2*)(proj + (size_t)m * EIN + n) = pk4(a, b, c, d); } };
struct EpiOddProj { bf16_t* qk; bf16_t* vT;
  DI void store(int m, int n, float a, float b, float c, float d) const {
    if (n < 2048) *(u32x2*)(qk + (size_t)m * 2048 + n) = pk4(a, b, c, d);
    else { int bb = m >> 13, s = m & (SEQ - 1); int e = n - 2048; bf16_t* p = vT + ((size_t)(bb * 1024 + e)) * SEQ + s; p[0] = f2bf(a); p[SEQ] = f2bf(b); p[2 * SEQ] = f2bf(c); p[3 * SEQ] = f2bf(d); } } };
struct EpiCmp1 { const float* bias; bf16_t* hid;
  DI void store(int m, int n, float a, float b, float c, float d) const {
    float4 bv = *(const float4*)(bias + n);
    *(u32x2*)(hid + (size_t)m * 256 + n) = pk4(gelu_tanh(a + bv.x), gelu_tanh(b + bv.y), gelu_tanh(c + bv.z), gelu_tanh(d + bv.w)); } };
struct EpiCmp2 { bf16_t* kc; bf16_t* vcT; int kv; DI void store(int m, int n, float a, float b, float c, float d) const {
    int combo = m >> 9, nn = m & 511;
    if (nn == 511) { a = b = c = d = 0.f; }
    if (kv == 0) *(u32x2*)(kc + (size_t)m * 64 + n) = pk4(a, b, c, d);
    else { bf16_t* p = vcT + ((size_t)(combo * 64 + n)) * 512 + nn; p[0] = f2bf(a); p[512] = f2bf(b); p[1024] = f2bf(c); p[1536] = f2bf(d); } } };

DI void tr_convert(unsigned char* lds, int wv, const float* __restrict__ src, int K, int N, bf16_t* __restrict__ dst, int& tb) {
  bf16_t* sT = (bf16_t*)(lds + LDS_WORK);
  const int tid = tid_of(wv), G = gridDim.x;
  const int nkt = K >> 6, nnt = (N + 63) >> 6, ntl = nkt * nnt;
  int first = ((int)blockIdx.x - (tb % G) + G) % G;
  for (int tl = first; tl < ntl; tl += G) {
    const int k0 = (tl / nnt) << 6, n0 = (tl % nnt) << 6;
    const int kk = tid >> 4, n4 = (tid & 15) * 4;
    __syncthreads();
#pragma unroll
    for (int i = 0; i < 2; ++i) {
      int k = kk + 32 * i;
      float4 v = make_float4(0.f, 0.f, 0.f, 0.f);
      if (n0 + n4 < N) v = *(const float4*)(src + (size_t)(k0 + k) * N + n0 + n4);
      sT[(n4 + 0) * LROW + k] = f2bf(v.x); sT[(n4 + 1) * LROW + k] = f2bf(v.y); sT[(n4 + 2) * LROW + k] = f2bf(v.z); sT[(n4 + 3) * LROW + k] = f2bf(v.w);
    }
    __syncthreads();
    const int n = tid >> 3, k8 = (tid & 7) * 8;
    if (n0 + n < N) *(u32x4*)(dst + (size_t)(n0 + n) * K + k0 + k8) = *(const u32x4*)(sT + n * LROW + k8);
  }
  tb += ntl;
}

DI void wprep_phase(unsigned char* lds, KParamPtr P, int wv, int l) {
  unsigned char* wsq = opqp(P->ws);
  bf16_t* WT = (bf16_t*)(wsq + OFF_WT);
  int tb = 0;
  const int i2 = l >> 1;
  tr_convert(lds, wv, P->in[22] + (size_t)l * DM * DFF, DM, DFF, (bf16_t*)((unsigned char*)WT + WT_M1), tb);
  tr_convert(lds, wv, P->in[23] + (size_t)l * DFF * DM, DFF, DM, (bf16_t*)((unsigned char*)WT + WT_M2), tb);
  if ((l & 1) == 0) {
    tr_convert(lds, wv, P->in[7] + (size_t)i2 * DM * EIN, DM, EIN, (bf16_t*)((unsigned char*)WT + WT_IN), tb);
    tr_convert(lds, wv, P->in[8] + (size_t)i2 * DM * DM, DM, DM, (bf16_t*)((unsigned char*)WT + WT_OUT), tb);
    tr_convert(lds, wv, P->in[11] + (size_t)i2 * 2048 * 256, 2048, 256, (bf16_t*)((unsigned char*)WT + WT_CW1), tb);
    tr_convert(lds, wv, P->in[13] + (size_t)i2 * 2048 * 256, 2048, 256, (bf16_t*)((unsigned char*)WT + WT_CW1) + 256 * 2048, tb);
    tr_convert(lds, wv, P->in[12] + (size_t)i2 * 256 * 64, 256, 64, (bf16_t*)((unsigned char*)WT + WT_CW2), tb);
    tr_convert(lds, wv, P->in[14] + (size_t)i2 * 256 * 64, 256, 64, (bf16_t*)((unsigned char*)WT + WT_CW2) + 64 * 256, tb);
    tr_convert(lds, wv, P->in[17] + (size_t)i2 * 128 * 512, 128, 512, (bf16_t*)((unsigned char*)WT + WT_UV), tb);
    {
      const float* src = P->in[16] + (size_t)i2 * 128 * 512; bf16_t* dst = (bf16_t*)((unsigned char*)WT + WT_UK);
      for (int i = (blockIdx.x * NTHREADS + tid_of(wv)) * 4; i < 128 * 512; i += gridDim.x * NTHREADS * 4) {
        float4 v = *(const float4*)(src + i); *(u32x2*)(dst + i) = pk4(v.x, v.y, v.z, v.w);
      }
    }
    {
      float* red = (float*)(lds + LDS_WORK + 16384);
      float* cb = (float*)(wsq + OFF_MISC + MS_CB);
      const int tid_ = tid_of(wv); const int lane = tid_ & 63, wave = tid_ >> 6;
      for (int it = (int)gridDim.x - 1 - (int)blockIdx.x; it < 8; it += gridDim.x) {
        const int kv = it >> 2, n0 = (it & 3) * 64;
        const float* pe = P->in[kv ? 10 : 9] + (size_t)i2 * 2048;
        const float* w1 = P->in[kv ? 13 : 11] + (size_t)i2 * 2048 * 256;
        float a = 0.f;
        for (int k = wave * 256; k < wave * 256 + 256; ++k) a += pe[k] * w1[(size_t)k * 256 + n0 + lane];
        __syncthreads();
        red[wave * 64 + lane] = a;
        __syncthreads();
        if (wave == 0) { float s = 0.f; for (int w = 0; w < 8; ++w) s += red[w * 64 + lane]; cb[kv * 256 + n0 + lane] = s; }
      }
    }
  } else {
    tr_convert(lds, wv, P->in[18] + (size_t)i2 * DM * OIN, DM, OIN, (bf16_t*)((unsigned char*)WT + WT_IN), tb);
    tr_convert(lds, wv, P->in[19] + (size_t)i2 * DM * DM, DM, DM, (bf16_t*)((unsigned char*)WT + WT_OUT), tb);
  }
}

DI void ada_partial_phase(unsigned char* lds, KParamPtr P, int wv) {
  unsigned char* wsq = opqp(P->ws);
  float* cact = (float*)(lds + LDS_WORK);
  float* part = (float*)(wsq + OFF_MISC + MS_ADAP);
  const int tid = tid_of(wv);
  __syncthreads();
  for (int i = tid; i < 4096; i += NTHREADS) { float v = P->in[1][i]; cact[i] = v / (1.f + __expf(-v)); }
  __syncthreads();
  for (int it = blockIdx.x; it < 384; it += gridDim.x) {
    const int kc = it & 7, jc = (it >> 3) % 12, l = it / 96;
    const int j = jc * 512 + tid;
    const float* w = P->in[3] + ((size_t)l * 1024 + kc * 128) * 6144 + j;
    float a0 = 0.f, a1 = 0.f, a2 = 0.f, a3 = 0.f;
#pragma unroll 8
    for (int k = 0; k < 128; ++k) {
      float wgt = w[(size_t)k * 6144];
      int kk = kc * 128 + k;
      a0 += cact[kk] * wgt; a1 += cact[1024 + kk] * wgt; a2 += cact[2048 + kk] * wgt; a3 += cact[3072 + kk] * wgt;
    }
    float* o = part + ((size_t)(kc * 4 + l) * 4) * 6144 + j;
    o[0] = a0; o[6144] = a1; o[2 * 6144] = a2; o[3 * 6144] = a3;
  }
}
DI void ada_reduce_phase(KParamPtr P, int wv) {
  unsigned char* wsq = opqp(P->ws);
  const float* part = (const float*)(wsq + OFF_MISC + MS_ADAP);
  float* ada = (float*)(wsq + OFF_MISC + MS_ADA);
  for (int i = blockIdx.x * NTHREADS + tid_of(wv); i < 4 * 4 * 6144; i += gridDim.x * NTHREADS) {
    int l = i / (4 * 6144), j = i % 6144;
    float s = P->in[4][l * 6144 + j];
#pragma unroll
    for (int kc = 0; kc < 8; ++kc) s += part[(size_t)kc * 4 * 4 * 6144 + i];
    ada[i] = s;
  }
}

DI void ln_mod_phase(KParamPtr P, int wv, const float* src, float* xdst, const float* lng, const float* lnb, const float* sh, const float* sc, bool do_ln, bool write_hb) {
  unsigned char* wsq = opqp(P->ws);
  bf16_t* hb = (bf16_t*)(wsq + OFF_HB);
  const int tid_ = tid_of(wv); const int lane = tid_ & 63, wave = tid_ >> 6;
  const int nw = gridDim.x * 8, gw = blockIdx.x * 8 + wave;
  const int rpw = (NTOK + nw - 1) / nw;
  int r0 = gw * rpw, r1 = r0 + rpw; if (r1 > NTOK) r1 = NTOK;
  float4 g4[4], b4[4], sh4[4], sc4[4];
#pragma unroll
  for (int i = 0; i < 4; ++i) { int c = lane * 4 + 256 * i; if (do_ln) { g4[i] = *(const float4*)(lng + c); b4[i] = *(const float4*)(lnb + c); } }
  int curb = -1;
  const float one = opqf(1.0f);
  f32x4 vn[4];
  if (r0 < r1) {
#pragma unroll
    for (int i = 0; i < 4; ++i) vn[i] = *(const f32x4*)(src + (size_t)r0 * DM + lane * 4 + 256 * i);
  }
  for (int row = r0; row < r1; ++row) {
    const int bb = row >> 13;
    if (bb != curb && write_hb) {
      curb = bb;
#pragma unroll
      for (int i = 0; i < 4; ++i) { int c = lane * 4 + 256 * i; sh4[i] = *(const float4*)(sh + bb * 6144 + c); sc4[i] = *(const float4*)(sc + bb * 6144 + c); }
    }
    float4 v[4];
#pragma unroll
    for (int i = 0; i < 4; ++i) { v[i].x = vn[i][0]; v[i].y = vn[i][1]; v[i].z = vn[i][2]; v[i].w = vn[i][3]; }
    {
      const int rn = row + 1 < r1 ? row + 1 : row;
#pragma unroll
      for (int i = 0; i < 4; ++i) vn[i] = *(const f32x4*)(src + (size_t)rn * DM + lane * 4 + 256 * i);
    }
    if (do_ln) {
      float s = 0.f;
#pragma unroll
      for (int i = 0; i < 4; ++i) s += v[i].x + v[i].y + v[i].z + v[i].w;
      const float mu = wave_sum(s, lane) * (1.f / 1024.f);
      float q = 0.f;
#pragma unroll
      for (int i = 0; i < 4; ++i) { v[i].x -= mu; v[i].y -= mu; v[i].z -= mu; v[i].w -= mu; q += v[i].x * v[i].x + v[i].y * v[i].y + v[i].z * v[i].z + v[i].w * v[i].w; }
      const float rstd = rsqrtf(wave_sum(q, lane) * (1.f / 1024.f) + 1e-5f);
#pragma unroll
      for (int i = 0; i < 4; ++i) {
        v[i].x = v[i].x * rstd * g4[i].x + b4[i].x; v[i].y = v[i].y * rstd * g4[i].y + b4[i].y; v[i].z = v[i].z * rstd * g4[i].z + b4[i].z; v[i].w = v[i].w * rstd * g4[i].w + b4[i].w;
        *(float4*)(xdst + (size_t)row * DM + lane * 4 + 256 * i) = v[i];
      }
    }
    if (write_hb) {
#pragma unroll
      for (int i = 0; i < 4; ++i) {
        *(u32x2*)(hb + (size_t)row * DM + lane * 4 + 256 * i) = pk4(v[i].x * (one + sc4[i].x) + sh4[i].x, v[i].y * (one + sc4[i].y) + sh4[i].y, v[i].z * (one + sc4[i].z) + sh4[i].z, v[i].w * (one + sc4[i].w) + sh4[i].w);
      }
    }
  }
}

DI void diff_attn_phase(unsigned char* lds, KParamPtr P, int wv, int l) {
  unsigned char* wsq = opqp(P->ws);
  const float* tab = (const float*)(lds + LDS_TAB);
  bf16_t* sK = (bf16_t*)(lds + LDS_WORK);
  bf16_t* sV = sK + 64 * LROW;
  const bf16_t* qk = (const bf16_t*)(wsq + OFF_U + U_QK);
  const bf16_t* vT = (const bf16_t*)(wsq + OFF_U + U_VT);
  bf16_t* ao = (bf16_t*)(wsq + OFF_AO);
  const int i2 = l >> 1;
  const int tid = tid_of(wv), lane = tid & 63, wave = tid >> 6, l31 = lane & 31, hh = lane >> 5;
  const float lambda_init = 0.8f - 0.6f * __expf(-0.3f * (float)l);
  float lam_full;
  {
    const float* lam = P->in[20] + (size_t)i2 * 256;
    float s1 = 0.f, s2 = 0.f;
    for (int d = 0; d < 64; ++d) { s1 += lam[d] * lam[64 + d]; s2 += lam[128 + d] * lam[192 + d]; }
    lam_full = __expf(s1) - __expf(s2) + lambda_init;
  }
  const float* subln = P->in[21] + (size_t)i2 * 128;
  const int pr = pi_row(l31);
  for (int it = blockIdx.x; it < 1024; it += gridDim.x) {
    const int rr = it >> 8, kk = it & 255, bh = (kk & 7) * 4 + rr, jq = kk >> 3;
    const int qt = (rr & 1) ? 31 - jq : jq;
    const int b = bh >> 3, h = bh & 7;
    const int Q0 = qt * 256, q0w = Q0 + wave * 32, t = q0w + l31;
    const int nkt = 4 * (qt + 1);
    unsigned* O1L = (unsigned*)(lds + LDS_WORK + 32768) + tid;
#pragma unroll 1
    for (int pass = 0; pass < 2; ++pass) {
      const int col = h * 2 + pass;
      bf16x8 qf[4];
      const bf16_t* qp = qk + (size_t)(b * SEQ + t) * 2048 + h * 128 + pass * 64 + hh * 8;
#pragma unroll
      for (int ks = 0; ks < 4; ++ks) qf[ks] = ldg8(qp + ks * 16);
      f32x16 O[4];
#pragma unroll
      for (int e = 0; e < 4; ++e) O[e] = zero16();
      float m_run = NEGB, l_run = 0.f;
      const float bfar = tab[col * 128 + 127];
      const unsigned kgo = (unsigned)((b * SEQ + (tid >> 3)) * 2048 + 1024 + h * 128 + pass * 64 + (tid & 7) * 8);
      const unsigned vgo = (unsigned)(((b * 8 + h) * 128 + (tid >> 3)) * SEQ + (tid & 7) * 8);
      u32x4 rk = *(const u32x4*)(qk + kgo), rv0 = *(const u32x4*)(vT + vgo), rv1 = *(const u32x4*)(vT + vgo + 64 * SEQ);
      __syncthreads();
      *(u32x4*)(sK + (tid >> 3) * LROW + (tid & 7) * 8) = rk;
      *(u32x4*)(sV + (tid >> 3) * LROW + (tid & 7) * 8) = rv0;
      *(u32x4*)(sV + ((tid >> 3) + 64) * LROW + (tid & 7) * 8) = rv1;
      __syncthreads();
#pragma unroll 1
      for (int kt = 0; kt < nkt; ++kt) {
        if (kt + 1 < nkt) {
          const int kn = kt + 1;
          GLOAD16(rk, qk + kgo + (unsigned)(kn * 64 * 2048));
          GLOAD16(rv0, vT + vgo + (unsigned)(kn * 64));
          GLOAD16(rv1, vT + vgo + (unsigned)(kn * 64 + 64 * SEQ));
        }
#pragma unroll
        for (int sub = 0; sub < 2; ++sub) {
          const int s0 = kt * 64 + sub * 32;
          if (s0 <= q0w + 31) {
            f32x16 s = zero16();
            bf16x8 kf[4], vf[8];
#pragma unroll
            for (int ks = 0; ks < 4; ++ks) kf[ks] = *(const bf16x8*)(sK + (sub * 32 + pr) * LROW + ks * 16 + hh * 8);
#pragma unroll
            for (int st = 0; st < 2; ++st)
#pragma unroll
              for (int e = 0; e < 4; ++e) vf[st * 4 + e] = *(const bf16x8*)(sV + (e * 32 + l31) * LROW + sub * 32 + st * 16 + hh * 8);
            __builtin_amdgcn_sched_barrier(0);
#pragma unroll
            for (int ks = 0; ks < 4; ++ks) s = MFMA32(kf[ks], qf[ks], s);
            float mloc = NEGB;
            const bool far = (q0w - (s0 + 31) >= 127);
            if (far) {
#pragma unroll
              for (int i = 0; i < 16; ++i) mloc = fmaxf(mloc, s[i]);
              mloc = fmaf(mloc, C1, bfar);
            } else {
#pragma unroll
              for (int i = 0; i < 16; ++i) {
                int key = s0 + (i & 7) + 8 * hh + 16 * (i >> 3);
                int dist = t - key; int dd = dist < 0 ? 0 : (dist > 127 ? 127 : dist);
                const float tb = tab[col * 128 + dd];
                float z = fmaf(s[i], C1, tb); z = dist < 0 ? NEGB : z;
                s[i] = z; mloc = fmaxf(mloc, z);
              }
            }
            mloc = red_max32(mloc);
            const float m_new = (mloc > m_run + 16.f) ? mloc : m_run;
            const float alpha = ex2(m_run - m_new);
            float ls = 0.f;
            if (far) {
              const float boff_ = bfar - m_new;
#pragma unroll
              for (int i = 0; i < 16; ++i) { float p = ex2(fmaf(s[i], C1, boff_)); s[i] = p; ls += p; }
            } else {
#pragma unroll
              for (int i = 0; i < 16; ++i) { float p = ex2(s[i] - m_new); s[i] = p; ls += p; }
            }
            l_run = l_run * alpha + ls; m_run = m_new;
            if (__any(alpha != 1.0f)) {
#pragma unroll
              for (int e = 0; e < 4; ++e)
#pragma unroll
                for (int i = 0; i < 16; ++i) O[e][i] *= alpha;
            }
#pragma unroll
            for (int st = 0; st < 2; ++st) {
              bf16x8 pf = pack8(s, st);
#pragma unroll
              for (int e = 0; e < 4; ++e) O[e] = MFMA32(vf[st * 4 + e], pf, O[e]);
            }
          }
        }
        __syncthreads();
        vm_wait0();
        if (kt + 1 < nkt) {
          *(u32x4*)(sK + (tid >> 3) * LROW + (tid & 7) * 8) = rk;
          *(u32x4*)(sV + (tid >> 3) * LROW + (tid & 7) * 8) = rv0;
          *(u32x4*)(sV + ((tid >> 3) + 64) * LROW + (tid & 7) * 8) = rv1;
        }
        __syncthreads();
      }
      const float lt = red_sum32(l_run);
      const float inv = 1.f / lt;
      if (pass == 0) {
#pragma unroll
        for (int e = 0; e < 4; ++e)
#pragma unroll
          for (int i = 0; i < 8; ++i) O1L[(e * 8 + i) * 512] = pk2(O[e][2 * i] * inv, O[e][2 * i + 1] * inv);
      } else {
        float ss = 0.f;
#pragma unroll
        for (int e = 0; e < 4; ++e)
#pragma unroll
          for (int i = 0; i < 16; ++i) {
            const unsigned pw = O1L[(e * 8 + (i >> 1)) * 512];
            float o1 = (i & 1) ? __uint_as_float(pw & 0xffff0000u) : __uint_as_float(pw << 16);
            float o = o1 - lam_full * (O[e][i] * inv); O[e][i] = o; ss += o * o; }
        ss = red_sum32(ss);
        const float rs = rsqrtf(ss * (1.f / 128.f) + 1e-5f) * (1.f - lambda_init);
        bf16_t* op = ao + (size_t)(b * SEQ + t) * DM + h * 128;
#pragma unroll
        for (int e = 0; e < 4; ++e)
#pragma unroll
          for (int g = 0; g < 4; ++g) {
            int ee = e * 32 + 8 * g + 4 * hh;
            float4 sl = *(const float4*)(subln + ee);
            *(u32x2*)(op + ee) = pk4(O[e][4 * g] * rs * sl.x, O[e][4 * g + 1] * rs * sl.y, O[e][4 * g + 2] * rs * sl.z, O[e][4 * g + 3] * rs * sl.w);
          }
      }
    }
  }
}

DI void cmp_z(f32x16& s, int kt, int t, int t0, int hh, const float* tabh, float& mloc) {
  const int nb = kt * 32;
  if (t0 - (16 * (nb + 31) + 31) >= 127) {
    const float bf = tabh[127];
#pragma unroll
    for (int i = 0; i < 16; ++i) { float z = fmaf(s[i], C1, bf); s[i] = z; mloc = fmaxf(mloc, z); }
  } else {
#pragma unroll
    for (int i = 0; i < 16; ++i) {
      int n = nb + (i & 7) + 8 * hh + 16 * (i >> 3);
      int dc = t - (16 * n + 31); int dd = dc < 0 ? 0 : (dc > 127 ? 127 : dc);
      float z = dc < 0 ? NEGB : fmaf(s[i], C1, tabh[dd]);
      s[i] = z; mloc = fmaxf(mloc, z);
    }
  }
}

DI void nsa_phase(unsigned char* lds, KParamPtr P, int wv) {
  unsigned char* wsq = opqp(P->ws);
  const float* tab = (const float*)(lds + LDS_TAB);
  const int tid = tid_of(wv), lane = tid & 63, wave = tid >> 6, l31 = lane & 31, hh = lane >> 5;
  unsigned char* selL = lds + LDS_WORK + wave * 512;
  float* scw = (float*)(lds + LDS_WORK + 4096 + wave * 16384);
  const bf16_t* proj = (const bf16_t*)(wsq + OFF_U + U_PROJ);
  const bf16_t* vsT = (const bf16_t*)(wsq + OFF_U + U_VST);
  const bf16_t* vwT = (const bf16_t*)(wsq + OFF_U + U_VWT);
  const bf16_t* kc = (const bf16_t*)(wsq + OFF_MISC + MS_KC);
  const bf16_t* vcT = (const bf16_t*)(wsq + OFF_MISC + MS_VCT);
  float* part = (float*)(wsq + OFF_HB);
  bf16_t* ao = (bf16_t*)(wsq + OFF_AO);
  const int nw = gridDim.x * 8, gw = blockIdx.x * 8 + wave;
  const int pr = pi_row(l31);
  for (int it = gw; it < 2048; it += nw) {
    const int blk_ = it >> 3, combo_ = blk_ & 7;
    const int b = combo_ >> 1, g = combo_ & 1, tile = ((blk_ >> 3) << 3) + (it & 7), t0 = tile * 32, t = t0 + l31;
    const size_t tok = (size_t)b * SEQ + t;
    const bf16_t* kcb = kc + (size_t)((b * 2 + g) * 512) * 64;
    const bf16_t* vcb = vcT + (size_t)((b * 2 + g) * 64) * 512;
#pragma unroll 1
    for (int x = 0; x < 64; ++x) scw[x * 64 + lane] = 0.f;
    const int nkt = (2 * tile + 1 + 31) >> 5;
#pragma unroll 1
    for (int hp = 0; hp < 4; ++hp) {
      const int head = g * 4 + hp;
      const float* tabh = tab + head * 128;
      bf16x8 qf[4];
#pragma unroll
      for (int ks = 0; ks < 4; ++ks) qf[ks] = ldg8(proj + tok * EIN + C_NQ + head * 64 + ks * 16 + hh * 8);
      float m = NEGB, l = 0.f;
      bf16x8 kf[4];
      const unsigned kco = (unsigned)(pr * 64 + hh * 8);
#pragma unroll
      for (int ks = 0; ks < 4; ++ks) kf[ks] = ldg8(kcb + kco + ks * 16);
#pragma unroll 1
      for (int kt = 0; kt < nkt; ++kt) {
        f32x16 s = zero16();
#pragma unroll
        for (int ks = 0; ks < 4; ++ks) s = MFMA32(kf[ks], qf[ks], s);
        {
          const int kn = kt + 1 < nkt ? kt + 1 : kt;
#pragma unroll
          for (int ks = 0; ks < 4; ++ks) kf[ks] = ldg8(kcb + kco + (unsigned)(kn * 32 * 64 + ks * 16));
        }
        float mloc = NEGB;
        cmp_z(s, kt, t, t0, hh, tabh, mloc);
        mloc = red_max32(mloc);
        const float mn = fmaxf(m, mloc);
        float ls = 0.f;
#pragma unroll
        for (int i = 0; i < 16; ++i) ls += (s[i] > -1e29f) ? ex2(s[i] - mn) : 0.f;
        l = l * ex2(m - mn) + ls; m = mn;
      }
      const float lt = red_sum32(l);
      const float inv = lt > 0.f ? 1.f / lt : 0.f;
      f32x16 O[2]; O[0] = zero16(); O[1] = zero16();
      float carry = 0.f;
#pragma unroll
      for (int ks = 0; ks < 4; ++ks) kf[ks] = ldg8(kcb + kco + ks * 16);
#pragma unroll 1
      for (int kt = 0; kt < nkt; ++kt) {
        {
          bf16x8 vf[4];
#pragma unroll
          for (int st = 0; st < 2; ++st)
#pragma unroll
            for (int et = 0; et < 2; ++et) vf[st * 2 + et] = ldg8(vcb + (unsigned)((et * 32 + l31) * 512 + kt * 32 + st * 16 + hh * 8));
          f32x16 s = zero16();
#pragma unroll
          for (int ks = 0; ks < 4; ++ks) s = MFMA32(kf[ks], qf[ks], s);
          {
            const int kn = kt + 1 < nkt ? kt + 1 : kt;
#pragma unroll
            for (int ks = 0; ks < 4; ++ks) kf[ks] = ldg8(kcb + kco + (unsigned)(kn * 32 * 64 + ks * 16));
          }
          float mloc = NEGB;
          cmp_z(s, kt, t, t0, hh, tabh, mloc);
#pragma unroll
          for (int i = 0; i < 16; ++i) s[i] = (s[i] > -1e29f) ? ex2(s[i] - m) * inv : 0.f;
          const float G00 = s[0] + s[1] + s[2] + s[3], G01 = s[4] + s[5] + s[6] + s[7];
          const float G10 = s[8] + s[9] + s[10] + s[11], G11 = s[12] + s[13] + s[14] + s[15];
          const float pe0 = SHXF(s[7], 32), pe1 = SHXF(s[15], 32);
          const float X0 = hh ? pe0 : carry;
          const float X1 = hh ? pe1 : pe0;
          float* sp = scw + (8 * kt + 2 * hh) * 32 + l31;
          sp[0] += 2.f * G00 - s[3] + X0;
          sp[32] += 2.f * G01 - s[7] + s[3];
          sp[4 * 32] += 2.f * G10 - s[11] + X1;
          sp[5 * 32] += 2.f * G11 - s[15] + s[11];
          carry = pe1;
#pragma unroll
          for (int st = 0; st < 2; ++st) {
            bf16x8 pf = pack8(s, st);
#pragma unroll
            for (int et = 0; et < 2; ++et) O[et] = MFMA32(vf[st * 2 + et], pf, O[et]);
          }
        }
      }
      const float g0 = sigmoidf_(bf2f(proj[tok * EIN + C_GATE + head * 3 + 0]));
      float* pp = part + (tok * 8 + head) * 64;
#pragma unroll
      for (int et = 0; et < 2; ++et)
#pragma unroll
        for (int gq = 0; gq < 4; ++gq) {
          float4 r; r.x = g0 * O[et][4 * gq]; r.y = g0 * O[et][4 * gq + 1]; r.z = g0 * O[et][4 * gq + 2]; r.w = g0 * O[et][4 * gq + 3];
          *(float4*)(pp + et * 32 + 8 * gq + 4 * hh) = r;
        }
    }
    {
      const int cb = t >> 6;
#pragma unroll 1
      for (int r = 0; r < 64; ++r) {
        const int j = 4 * (r >> 1) + (r & 1) + 2 * hh;
        const bool forced = (j == 0) | (j == cb) | (j == cb - 1);
        const float v = scw[j * 32 + l31];
        scw[j * 32 + l31] = forced ? 1e9f : (j <= cb ? v : -1e9f);
      }
      unsigned mk0 = 0u, mk1 = 0u, mk2 = 0u, mk3 = 0u;
#pragma unroll 1
      for (int rd = 0; rd < 16; ++rd) {
        float bv = -INFINITY; int bj = 255;
#pragma unroll 4
        for (int r = 0; r < 64; ++r) {
          const int j = 4 * (r >> 1) + (r & 1) + 2 * hh;
          const float v = scw[j * 32 + l31];
          if (v > bv) { bv = v; bj = j; }
        }
        const float ov = SHXF(bv, 32); const int oj = SHXI(bj, 32);
        const bool other = (ov > bv) || (ov == bv && oj < bj);
        const int wj = other ? oj : bj;
        if (((wj >> 1) & 1) == hh) scw[wj * 32 + l31] = -3e38f;
        const unsigned bit = 1u << (wj & 31); const int wd = wj >> 5;
        mk0 |= wd == 0 ? bit : 0u; mk1 |= wd == 1 ? bit : 0u; mk2 |= wd == 2 ? bit : 0u; mk3 |= wd == 3 ? bit : 0u;
      }
      if (hh == 0) *(u32x4*)(selL + l31 * 16) = (u32x4){mk0, mk1, mk2, mk3};
    }
    {
      const int s_lo = t0 >= 512 ? t0 - 512 : 0;
      const int nwt = (t0 + 32 - s_lo) >> 5;
#pragma unroll 1
      for (int hp = 0; hp < 4; ++hp) {
        const int head = g * 4 + hp;
        const float* tabh = tab + head * 128;
        bf16x8 qf[4];
#pragma unroll
        for (int ks = 0; ks < 4; ++ks) qf[ks] = ldg8(proj + tok * EIN + C_NQ + head * 64 + ks * 16 + hh * 8);
        f32x16 O[2]; O[0] = zero16(); O[1] = zero16();
        float m = NEGB, l = 0.f;
        bf16x8 kf[4];
        const unsigned kwo = (unsigned)((b * SEQ + s_lo + pr) * EIN + C_KW + g * 64 + hh * 8);
        const unsigned vwo = (unsigned)(((b * 2 + g) * 64 + l31) * SEQ + s_lo + hh * 8);
#pragma unroll
        for (int ks = 0; ks < 4; ++ks) kf[ks] = ldg8(proj + kwo + ks * 16);
#pragma unroll 1
        for (int wt = 0; wt < nwt; ++wt) {
          const int s0 = s_lo + wt * 32;
          bf16x8 vf[4];
#pragma unroll
          for (int st = 0; st < 2; ++st)
#pragma unroll
            for (int et = 0; et < 2; ++et) vf[st * 2 + et] = ldg8(vwT + vwo + (unsigned)(et * 32 * SEQ + wt * 32 + st * 16));
          f32x16 s = zero16();
#pragma unroll
          for (int ks = 0; ks < 4; ++ks) s = MFMA32(kf[ks], qf[ks], s);
          {
            const int wn_ = wt + 1 < nwt ? wt + 1 : wt;
#pragma unroll
            for (int ks = 0; ks < 4; ++ks) kf[ks] = ldg8(proj + kwo + (unsigned)(wn_ * 32 * EIN + ks * 16));
          }
          float mloc = NEGB;
          const bool full = (s0 + 31 <= t0) && (t0 + 31 - s0 < 512);
          if (full && (t0 - (s0 + 31) >= 127)) {
            const float bf = tabh[127];
#pragma unroll
            for (int i = 0; i < 16; ++i) { float z = fmaf(s[i], C1, bf); s[i] = z; mloc = fmaxf(mloc, z); }
          } else {
#pragma unroll
            for (int i = 0; i < 16; ++i) {
              int key = s0 + (i & 7) + 8 * hh + 16 * (i >> 3);
              int dw = t - key; int dd = dw < 0 ? 0 : (dw > 127 ? 127 : dw);
              float z = (dw >= 0 && dw < 512) ? fmaf(s[i], C1, tabh[dd]) : NEGB;
              s[i] = z; mloc = fmaxf(mloc, z);
            }
          }
          mloc = red_max32(mloc);
          const float mn = fmaxf(m, mloc);
          const float alpha = ex2(m - mn);
          float ls = 0.f;
#pragma unroll
          for (int i = 0; i < 16; ++i) { float p = (s[i] > -1e29f) ? ex2(s[i] - mn) : 0.f; s[i] = p; ls += p; }
          l = l * alpha + ls; m = mn;
#pragma unroll
          for (int et = 0; et < 2; ++et)
#pragma unroll
            for (int i = 0; i < 16; ++i) O[et][i] *= alpha;
#pragma unroll
          for (int st = 0; st < 2; ++st) {
            bf16x8 pf = pack8(s, st);
#pragma unroll
            for (int et = 0; et < 2; ++et) O[et] = MFMA32(vf[st * 2 + et], pf, O[et]);
          }
        }
        const float lt = red_sum32(l);
        const float g2 = sigmoidf_(bf2f(proj[tok * EIN + C_GATE + head * 3 + 2])) / lt;
        float* pp = part + (tok * 8 + head) * 64;
#pragma unroll
        for (int et = 0; et < 2; ++et)
#pragma unroll
          for (int gq = 0; gq < 4; ++gq) {
            float4 r = *(float4*)(pp + et * 32 + 8 * gq + 4 * hh);
            r.x += g2 * O[et][4 * gq]; r.y += g2 * O[et][4 * gq + 1]; r.z += g2 * O[et][4 * gq + 2]; r.w += g2 * O[et][4 * gq + 3];
            *(float4*)(pp + et * 32 + 8 * gq + 4 * hh) = r;
          }
      }
    }
    __builtin_amdgcn_fence(__ATOMIC_SEQ_CST, "workgroup");
    {
      const int col = lane & 15, q4 = lane >> 4;
      const int qq = col >> 2, hcol = g * 4 + (col & 3);
      const float* tabc = tab + hcol * 128;
      const int rk = 8 * (col >> 2) + (col & 3);
      const unsigned kbase = (unsigned)((b * SEQ + rk) * EIN + C_KS + g * 64 + q4 * 8);
      const unsigned vbase = (unsigned)(((b * 2 + g) * 64 + col) * SEQ + q4 * 8);
#pragma unroll 1
      for (int grp_ = 0; grp_ < 8 * REP_C; ++grp_) {
        const int grp = grp_ & 7;
        const int tq = t0 + grp * 4 + qq;
        const int tmin = t0 + grp * 4, tmax = tmin + 3;
        const size_t tokq = (size_t)b * SEQ + tq;
        const u32x4 mym = *(const u32x4*)(selL + (grp * 4 + qq) * 16);
        unsigned u0, u1, u2, u3;
        {
          const u32x4 a0 = *(const u32x4*)(selL + (grp * 4 + 0) * 16), a1 = *(const u32x4*)(selL + (grp * 4 + 1) * 16);
          const u32x4 a2 = *(const u32x4*)(selL + (grp * 4 + 2) * 16), a3 = *(const u32x4*)(selL + (grp * 4 + 3) * 16);
          const u32x4 uu = a0 | a1 | a2 | a3;
          u0 = __builtin_amdgcn_readfirstlane(uu.x); u1 = __builtin_amdgcn_readfirstlane(uu.y);
          u2 = __builtin_amdgcn_readfirstlane(uu.z); u3 = __builtin_amdgcn_readfirstlane(uu.w);
          const int cbm = tmax >> 6;
          if (cbm < 31) { u0 &= (2u << cbm) - 1u; u1 = 0u; u2 = 0u; u3 = 0u; }
          else if (cbm < 63) { u1 &= (2u << (cbm - 32)) - 1u; u2 = 0u; u3 = 0u; }
          else if (cbm < 95) { u2 &= (2u << (cbm - 64)) - 1u; u3 = 0u; }
          else if (cbm < 127) { u3 &= (2u << (cbm - 96)) - 1u; }
        }
        auto next_blk = [&]() -> int {
          if (u0) { int bq = __builtin_ctz(u0); u0 &= u0 - 1u; return bq; }
          if (u1) { int bq = __builtin_ctz(u1); u1 &= u1 - 1u; return 32 + bq; }
          if (u2) { int bq = __builtin_ctz(u2); u2 &= u2 - 1u; return 64 + bq; }
          if (u3) { int bq = __builtin_ctz(u3); u3 &= u3 - 1u; return 96 + bq; }
          return -1;
        };
        bf16x8 qf[2];
#pragma unroll
        for (int st = 0; st < 2; ++st) qf[st] = ldg8(proj + tokq * EIN + C_NQ + hcol * 64 + st * 32 + q4 * 8);
        f32x4 O[4];
#pragma unroll
        for (int e = 0; e < 4; ++e) O[e] = (f32x4){0.f, 0.f, 0.f, 0.f};
        float m = NEGB, l = 0.f;
        bf16x8 kf[8], vf[8];
        auto load_k = [&](int jb) {
          const unsigned ko = kbase + (unsigned)(jb * 64 * EIN);
#pragma unroll
          for (int hf = 0; hf < 2; ++hf)
#pragma unroll
            for (int tl = 0; tl < 2; ++tl) {
              kf[(hf * 2 + tl) * 2 + 0] = ldg8(proj + ko + (unsigned)((hf * 32 + 4 * tl) * EIN));
              kf[(hf * 2 + tl) * 2 + 1] = ldg8(proj + ko + (unsigned)((hf * 32 + 4 * tl) * EIN + 32));
            }
        };
        auto load_v = [&](int jb) {
          const unsigned vo = vbase + (unsigned)(jb * 64);
#pragma unroll
          for (int hf = 0; hf < 2; ++hf)
#pragma unroll
            for (int e = 0; e < 4; ++e) vf[hf * 4 + e] = ldg8(vsT + vo + (unsigned)(e * 16 * SEQ + hf * 32));
        };
        int jb = next_blk();
        if (jb >= 0) { load_k(jb); load_v(jb); }
        while (jb >= 0) {
          const int base = jb * 64;
          const unsigned mw = jb < 32 ? mym.x : (jb < 64 ? mym.y : (jb < 96 ? mym.z : mym.w));
          const bool member = (mw >> (jb & 31)) & 1u;
          f32x4 a[2][2];
#pragma unroll
          for (int hf = 0; hf < 2; ++hf)
#pragma unroll
            for (int tl = 0; tl < 2; ++tl) {
              f32x4 acc = (f32x4){0.f, 0.f, 0.f, 0.f};
              acc = MFMA16(kf[(hf * 2 + tl) * 2 + 0], qf[0], acc);
              acc = MFMA16(kf[(hf * 2 + tl) * 2 + 1], qf[1], acc);
              a[hf][tl] = acc;
            }
          const int jn = next_blk();
          if (jn >= 0) load_k(jn);
          float mloc = NEGB;
          if (tmin - (base + 63) >= 127) {
            const float bf = tabc[127];
#pragma unroll
            for (int hf = 0; hf < 2; ++hf)
#pragma unroll
              for (int tl = 0; tl < 2; ++tl)
#pragma unroll
                for (int j = 0; j < 4; ++j) { float z = member ? fmaf(a[hf][tl][j], C1, bf) : NEGB; a[hf][tl][j] = z; mloc = fmaxf(mloc, z); }
          } else {
#pragma unroll
            for (int hf = 0; hf < 2; ++hf)
#pragma unroll
              for (int tl = 0; tl < 2; ++tl)
#pragma unroll
                for (int j = 0; j < 4; ++j) {
                  int key = base + hf * 32 + 8 * q4 + 4 * tl + j;
                  int dist = tq - key; int dd = dist < 0 ? 0 : (dist > 127 ? 127 : dist);
                  float z = (dist < 0 || !member) ? NEGB : fmaf(a[hf][tl][j], C1, tabc[dd]);
                  a[hf][tl][j] = z; mloc = fmaxf(mloc, z);
                }
          }
          mloc = red_max16(mloc);
          mloc = red_max32(mloc);
          const float mn = fmaxf(m, mloc);
          const float alpha = ex2(m - mn);
          float ls = 0.f;
#pragma unroll
          for (int hf = 0; hf < 2; ++hf)
#pragma unroll
            for (int tl = 0; tl < 2; ++tl)
#pragma unroll
              for (int j = 0; j < 4; ++j) { float p = (a[hf][tl][j] > -1e29f) ? ex2(a[hf][tl][j] - mn) : 0.f; a[hf][tl][j] = p; ls += p; }
          l = l * alpha + ls; m = mn;
#pragma unroll
          for (int e = 0; e < 4; ++e) O[e] *= alpha;
#pragma unroll
          for (int hf = 0; hf < 2; ++hf) {
            u32x4 u; u.x = pk2(a[hf][0][0], a[hf][0][1]); u.y = pk2(a[hf][0][2], a[hf][0][3]); u.z = pk2(a[hf][1][0], a[hf][1][1]); u.w = pk2(a[hf][1][2], a[hf][1][3]);
            const bf16x8 pf = __builtin_bit_cast(bf16x8, u);
#pragma unroll
            for (int e = 0; e < 4; ++e) O[e] = MFMA16(vf[hf * 4 + e], pf, O[e]);
          }
          if (jn >= 0) load_v(jn);
          jb = jn;
        }
        l = red_sum16(l);
        l = red_sum32(l);
        {
          const float g1 = sigmoidf_(bf2f(proj[tokq * EIN + C_GATE + hcol * 3 + 1])) / l;
          const float* pp = part + (tokq * 8 + hcol) * 64;
          bf16_t* op = ao + tokq * DM + hcol * 64;
#pragma unroll
          for (int e = 0; e < 4; ++e) {
            float4 pv = *(const float4*)(pp + e * 16 + 4 * q4);
            *(u32x2*)(op + e * 16 + 4 * q4) = pk4(pv.x + g1 * O[e][0], pv.y + g1 * O[e][1], pv.z + g1 * O[e][2], pv.w + g1 * O[e][3]);
          }
        }
      }
    }
  }
}

DI void ckv_norm_phase(KParamPtr P, int wv, int i2) {
  unsigned char* wsq = opqp(P->ws);
  const bf16_t* proj = (const bf16_t*)(wsq + OFF_U + U_PROJ);
  bf16_t* ckv = (bf16_t*)(wsq + OFF_MISC + 12 * MiB);
  const float* gn = P->in[15] + (size_t)i2 * 128;
  const int tid_ = tid_of(wv); const int lane = tid_ & 63, wave = tid_ >> 6;
  const int nw = gridDim.x * 8, gw = blockIdx.x * 8 + wave;
  const float g0 = gn[2 * lane], g1 = gn[2 * lane + 1];
  for (int tk = gw; tk < NTOK; tk += nw) {
    unsigned u = *(const unsigned*)(proj + (size_t)tk * EIN + C_DKV + 2 * lane);
    float a = __uint_as_float(u << 16), c = __uint_as_float(u & 0xffff0000u);
    float ss = wave_sum(a * a + c * c, lane);
    float rs = rsqrtf(ss * (1.f / 128.f) + 1e-5f);
    *(unsigned*)(ckv + (size_t)tk * 128 + 2 * lane) = pk2(a * rs * g0, c * rs * g1);
  }
}

DI unsigned fkey(float f) { unsigned u = __float_as_uint(f); return (u & 0x80000000u) ? ~u : (u | 0x80000000u); }

DI void dsa_index_phase(unsigned char* lds, KParamPtr P, int wv) {
  unsigned char* wsq = opqp(P->ws);
  float* sc = (float*)(lds + LDS_WORK);
  unsigned* hist = (unsigned*)(lds + LDS_WORK + 131072);
  const bf16_t* proj = (const bf16_t*)(wsq + OFF_U + U_PROJ);
  unsigned short* idx = (unsigned short*)(wsq + OFF_U + U_IDX);
  const int tid = tid_of(wv), lane = tid & 63, wave = tid >> 6, l31 = lane & 31, hh = lane >> 5;
  const int rhead = (l31 & 3) + 4 * ((l31 >> 3) & 1), ru = 2 * ((l31 >> 2) & 1) + (l31 >> 4);
  const unsigned long long lt_mask = (lane == 0) ? 0ull : (~0ull >> (64 - lane));
  __syncthreads();
  if (wave < 4) { const unsigned z0 = (unsigned)opq(0); unsigned* hz = hist + wave * 256 + lane * 4; hz[0] = z0; hz[1] = z0; hz[2] = z0; hz[3] = z0; }
  lds_barrier();
  for (int item = blockIdx.x; item < 8192; item += gridDim.x) {
    const int b = (item & 7) >> 1, t0 = (((item >> 3) << 1) + (item & 1)) * 4;
    const int ntile = (t0 + 4 + 31) >> 5;
    bf16x8 af[4];
    const bf16_t* iqp = proj + (size_t)(b * SEQ + t0 + ru) * EIN + C_IQ + rhead * 64 + hh * 8;
#pragma unroll
    for (int ks = 0; ks < 4; ++ks) af[ks] = ldg8(iqp + ks * 16);
    float w[16];
#pragma unroll
    for (int i = 0; i < 16; ++i) {
      const int uq = 2 * hh + (i >> 3), hd = (i & 3) + 4 * ((i >> 2) & 1);
      w[i] = bf2f(proj[(size_t)(b * SEQ + t0 + uq) * EIN + C_IW + hd]) * 0.04419417382415922f;
    }
#pragma unroll 1
    for (int kt0 = wave * 4; kt0 < ntile; kt0 += 32) {
      bf16x8 kf[4][4];
      const unsigned ko = (unsigned)((b * SEQ + kt0 * 32 + l31) * EIN + C_IK + hh * 8);
#pragma unroll
      for (int u = 0; u < 4; ++u)
#pragma unroll
        for (int ks = 0; ks < 4; ++ks) kf[u][ks] = ldg8(proj + ko + (unsigned)(u * 32 * EIN + ks * 16));
#pragma unroll
      for (int u = 0; u < 4; ++u) {
        f32x16 acc = zero16();
#pragma unroll
        for (int ks = 0; ks < 4; ++ks) acc = MFMA32(af[ks], kf[u][ks], acc);
        float s0 = 0.f, s1 = 0.f;
#pragma unroll
        for (int i = 0; i < 8; ++i) { s0 += w[i] * fmaxf(acc[i], 0.f); s1 += w[8 + i] * fmaxf(acc[8 + i], 0.f); }
        const int key = (kt0 + u) * 32 + l31;
        s0 += 0.f; s1 += 0.f;
        sc[(2 * hh) * 8192 + key] = s0;
        sc[(2 * hh + 1) * 8192 + key] = s1;
        if (key <= t0 + 2 * hh) atomicAdd(hist + (2 * hh) * 256 + (fkey(s0) >> 24), 1u);
        if (key <= t0 + 2 * hh + 1) atomicAdd(hist + (2 * hh + 1) * 256 + (fkey(s1) >> 24), 1u);
      }
    }
    const int qs = wave & 3, half = wave >> 2;
    const int n = t0 + qs + 1;
    const float* scq = sc + qs * 8192;
    unsigned short* out = idx + (size_t)(b * SEQ + t0 + qs) * 256;
    unsigned* H0 = hist + qs * 256;
    unsigned* H1 = hist + 1024 + qs * 256;
    const bool big = n > 256;
    if (!big && half == 0) { for (int i = lane; i < 256; i += 64) out[i] = (unsigned short)(i < n ? i : 0xFFFF); }
    lds_barrier();
    unsigned prefix = 0; int Kr = 256;
#pragma unroll 1
    for (int pass = 0; pass < 4; ++pass) {
      unsigned* Hc = (pass & 1) ? H1 : H0;
      unsigned* Hn = (pass & 1) ? H0 : H1;
      const int shift = 24 - 8 * pass;
      if (big && pass > 0) {
        f32x4 vnx = *(const f32x4*)(scq + half * 256 + lane * 4);
        for (int c = half; c * 256 < n; c += 2) {
          const int i0 = c * 256 + lane * 4;
          const f32x4 v = vnx;
          { const int cn = (c + 2) * 256 < n ? c + 2 : c; vnx = *(const f32x4*)(scq + cn * 256 + lane * 4); }
#pragma unroll
          for (int e = 0; e < 4; ++e) {
            const unsigned u = fkey(v[e]);
            const bool match = (i0 + e < n) && ((pass == 0) || ((u >> ((shift + 8) & 31)) == prefix));
            if (match) atomicAdd(Hc + ((u >> shift) & 255u), 1u);
          }
        }
      }
      lds_barrier();
      if (half == 0) { const unsigned z0 = (unsigned)opq(0); Hn[lane * 4] = z0; Hn[lane * 4 + 1] = z0; Hn[lane * 4 + 2] = z0; Hn[lane * 4 + 3] = z0; }
      if (big) {
        const u32x4 hv = *(const u32x4*)(Hc + lane * 4);
        const int sloc = (int)(hv.x + hv.y + hv.z + hv.w);
        int incl = sloc;
#pragma unroll
        for (int off = 1; off < 64; off <<= 1) { int v = bperm_i(lane + off, incl); if (lane + off < 64) incl += v; }
        int cum = incl - sloc;
        bool found = false; int d = 0, nK = 0;
#pragma unroll
        for (int bq = 3; bq >= 0; --bq) {
          const int hbq = (int)hv[bq];
          if (!found && cum < Kr && Kr <= cum + hbq) { found = true; d = lane * 4 + bq; nK = Kr - cum; }
          cum += hbq;
        }
        const unsigned long long mk = __ballot(found);
        const int src = __ffsll((long long)mk) - 1;
        d = bperm_i(src, d); Kr = bperm_i(src, nK);
        prefix = (prefix << 8) | (unsigned)d;
      }
      lds_barrier();
    }
    if (big && half == 0) {
      const unsigned T = prefix;
      int cg_ = 0, ce_ = 0;
      f32x4 vnx = *(const f32x4*)(scq + lane * 4);
      for (int c = 0; c * 256 < n; ++c) {
        const int i0 = c * 256 + lane * 4;
        const f32x4 v = vnx;
        { const int cn = (c + 1) * 256 < n ? c + 1 : c; vnx = *(const f32x4*)(scq + cn * 256 + lane * 4); }
        bool gt[4], eq[4]; unsigned long long mg[4], me[4];
#pragma unroll
        for (int e = 0; e < 4; ++e) {
          const unsigned u = fkey(v[e]);
          gt[e] = (i0 + e < n) && (u > T); eq[e] = (i0 + e < n) && (u == T);
          mg[e] = __ballot(gt[e]); me[e] = __ballot(eq[e]);
        }
        int pg = cg_;
#pragma unroll
        for (int e = 0; e < 4; ++e) {
          if (gt[e]) out[pg + __popcll(mg[e] & lt_mask)] = (unsigned short)(i0 + e);
          pg += __popcll(mg[e]);
        }
        cg_ = pg;
        if ((me[0] | me[1] | me[2] | me[3]) != 0ull) {
          int below = ce_;
#pragma unroll
          for (int e = 0; e < 4; ++e) below += __popcll(me[e] & lt_mask);
          int own = 0;
#pragma unroll
          for (int e = 0; e < 4; ++e) {
            const int rank = below + own;
            if (eq[e] && rank < Kr) out[(256 - Kr) + rank] = (unsigned short)(i0 + e);
            own += eq[e] ? 1 : 0;
          }
#pragma unroll
          for (int e = 0; e < 4; ++e) ce_ += __popcll(me[e]);
        }
      }
    }
    lds_barrier();
  }
}

DI void dsa_sparse_phase(unsigned char* lds, KParamPtr P, int wv) {
  unsigned char* wsq = opqp(P->ws);
  const float* tab = (const float*)(lds + LDS_TAB);
  const int tid = tid_of(wv), lane = tid & 63, wave = tid >> 6;
  bf16_t* gbuf = (bf16_t*)(lds + LDS_WORK + 4096 + wave * 9216);
  unsigned short* idL = (unsigned short*)(lds + LDS_WORK + 4096 + wave * 9216 + 8704);
  __syncthreads();
  bf16_t* qlat = (bf16_t*)(wsq + OFF_U + U_QLAT);
  const bf16_t* ckv = (const bf16_t*)(wsq + OFF_MISC + 12 * MiB);
  const unsigned short* idx = (const unsigned short*)(wsq + OFF_U + U_IDX);
  const int nw = gridDim.x * 8, gw = blockIdx.x * 8 + wave;
  const int col = lane & 15, q4 = lane >> 4;
  const float* tabc = tab + (8 + (col & 7)) * 128;
  const int rk = 8 * (col >> 2) + (col & 3);
  const int grow = lane >> 4, gc16 = lane & 15;
  auto qmap = [](int qi) -> int {
    const int w8 = qi & 7, blk = (qi >> 3) & 255, rnd = qi >> 11, x = blk & 7;
    return ((x >> 1) << 13) + ((((rnd * 32 + (blk >> 3)) << 1) + (x & 1)) << 3) + w8;
  };
  u32x2 idn = (gw < NTOK) ? *(const u32x2*)(idx + (size_t)qmap(gw) * 256 + lane * 4) : (u32x2){0u, 0u};
  for (int qi = gw; qi < NTOK; qi += nw) {
    const int q = qmap(qi);
    const int b = q >> 13, tq = q & (SEQ - 1);
    asm volatile("" ::: "memory");
    *(u32x2*)(idL + lane * 4) = idn;
    asm volatile("" ::: "memory");
    {
      const int qn = qmap(qi + nw < NTOK ? qi + nw : qi);
      idn = *(const u32x2*)(idx + (size_t)qn * 256 + lane * 4);
    }
    bf16x8 qf[4];
#pragma unroll
    for (int st = 0; st < 4; ++st) qf[st] = (col < 8) ? ldg8(qlat + (size_t)q * DM + col * 128 + st * 32 + q4 * 8) : zero8();
    f32x4 O[8];
#pragma unroll
    for (int e = 0; e < 8; ++e) O[e] = (f32x4){0.f, 0.f, 0.f, 0.f};
    float m = NEGB, l = 0.f;
    u32x4 gr[8];
    const unsigned cb = (unsigned)(b * SEQ) * 128u + (unsigned)gc16 * 8u;
#pragma unroll
    for (int i = 0; i < 8; ++i) {
      int id = idL[grow + 4 * i]; id = id > SEQ - 1 ? SEQ - 1 : id;
      gr[i] = *(const u32x4*)(ckv + cb + (unsigned)id * 128u);
    }
#pragma unroll 1
    for (int ch = 0; ch < 8; ++ch) {
#pragma unroll
      for (int i = 0; i < 8; ++i) *(u32x4*)(gbuf + (grow + 4 * i) * 136 + gc16 * 8) = gr[i];
      asm volatile("" ::: "memory");
      {
        const int cn = ch < 7 ? ch + 1 : ch;
#pragma unroll
        for (int i = 0; i < 8; ++i) {
          int id = idL[cn * 32 + grow + 4 * i]; id = id > SEQ - 1 ? SEQ - 1 : id;
          gr[i] = *(const u32x4*)(ckv + cb + (unsigned)id * 128u);
        }
      }
      f32x4 a[2];
#pragma unroll
      for (int tl = 0; tl < 2; ++tl) {
        f32x4 acc = (f32x4){0.f, 0.f, 0.f, 0.f};
#pragma unroll
        for (int st = 0; st < 4; ++st) acc = MFMA16(*(const bf16x8*)(gbuf + (rk + 4 * tl) * 136 + st * 32 + q4 * 8), qf[st], acc);
        a[tl] = acc;
      }
      float mloc = NEGB;
#pragma unroll
      for (int tl = 0; tl < 2; ++tl)
#pragma unroll
        for (int j = 0; j < 4; ++j) {
          const int id = idL[ch * 32 + 8 * q4 + 4 * tl + j];
          const int dist = tq - id; const int dd = dist < 0 ? 0 : (dist > 127 ? 127 : dist);
          const float tb = tabc[dd];
          float z = fmaf(a[tl][j], C1, tb); z = dist < 0 ? NEGB : z;
          a[tl][j] = z; mloc = fmaxf(mloc, z);
        }
      mloc = red_max16(mloc);
      mloc = red_max32(mloc);
      const float mn = fmaxf(m, mloc);
      const float alpha = ex2(m - mn);
      float ls = 0.f;
#pragma unroll
      for (int tl = 0; tl < 2; ++tl)
#pragma unroll
        for (int j = 0; j < 4; ++j) { float p = (a[tl][j] > -1e29f) ? ex2(a[tl][j] - mn) : 0.f; a[tl][j] = p; ls += p; }
      l = l * alpha + ls; m = mn;
#pragma unroll
      for (int e = 0; e < 8; ++e) O[e] *= alpha;
      u32x4 u; u.x = pk2(a[0][0], a[0][1]); u.y = pk2(a[0][2], a[0][3]); u.z = pk2(a[1][0], a[1][1]); u.w = pk2(a[1][2], a[1][3]);
      const bf16x8 pf = __builtin_bit_cast(bf16x8, u);
#pragma unroll
      for (int rt = 0; rt < 8; ++rt) {
        const bf16_t* gp = gbuf + (8 * q4) * 136 + rt * 16 + col;
        u32x4 v;
        v.x = (unsigned)gp[0] | ((unsigned)gp[136] << 16); v.y = (unsigned)gp[2 * 136] | ((unsigned)gp[3 * 136] << 16);
        v.z = (unsigned)gp[4 * 136] | ((unsigned)gp[5 * 136] << 16); v.w = (unsigned)gp[6 * 136] | ((unsigned)gp[7 * 136] << 16);
        O[rt] = MFMA16(__builtin_bit_cast(bf16x8, v), pf, O[rt]);
      }
      asm volatile("" ::: "memory");
    }
    l = red_sum16(l);
    l = red_sum32(l);
    if (col < 8) {
      const float inv = 1.f / l;
      bf16_t* op = qlat + (size_t)q * DM + col * 128;
#pragma unroll
      for (int rt = 0; rt < 8; ++rt) *(u32x2*)(op + rt * 16 + 4 * q4) = pk4(O[rt][0] * inv, O[rt][1] * inv, O[rt][2] * inv, O[rt][3] * inv);
    }
  }
}

DI void gbar(unsigned* cnt, unsigned& target, int tid) {
  asm volatile("s_waitcnt vmcnt(0)" ::: "memory");
  __syncthreads();
  target += gridDim.x;
  if (tid == 0) {
    __builtin_amdgcn_fence(__ATOMIC_RELEASE, "agent");
    asm volatile("s_waitcnt vmcnt(0)" ::: "memory");
    __hip_atomic_fetch_add(cnt, 1u, __ATOMIC_RELAXED, __HIP_MEMORY_SCOPE_AGENT);
    while (__hip_atomic_load(cnt, __ATOMIC_RELAXED, __HIP_MEMORY_SCOPE_AGENT) < target) __builtin_amdgcn_s_sleep(1);
    __builtin_amdgcn_fence(__ATOMIC_ACQUIRE, "agent");
    asm volatile("s_waitcnt vmcnt(0)" ::: "memory");
  }
  __syncthreads();
}

__global__ void __launch_bounds__(NTHREADS) mega(Params P0) {
  extern __shared__ __attribute__((aligned(16))) unsigned char lds[];
  cg::grid_group grid = cg::this_grid();
#define P kparams()
  const int wv = __builtin_amdgcn_readfirstlane((int)(threadIdx.x >> 6));
  const int tid = tid_of(wv);
  {
    float* tab = (float*)(lds + LDS_TAB);
    for (int i = tid; i < 16 * 128; i += NTHREADS) { int col = i >> 7, d = i & 127; tab[i] = P->in[2][(int)kBucket[d] * 16 + col] * LOG2E; }
    __syncthreads();
  }
  const float* ada = (const float*)(opqp(P->ws) + OFF_MISC + MS_ADA);

  unsigned* barp = (unsigned*)(opqp(P->ws) + OFF_BAR);
  unsigned bar_target = 0;
  ada_partial_phase(lds, P, wv);
  wprep_phase(lds, P, wv, 0);
  grid.sync();
  ada_reduce_phase(P, wv);
  gbar(barp, bar_target, tid_of(wv));
  for (int rp = 0; rp < REP_SYNC; ++rp) gbar(barp, bar_target, tid_of(wv));
  ln_mod_phase(P, wv, P->in[0], nullptr, nullptr, nullptr, ada, ada + 1024, false, true);
  gbar(barp, bar_target, tid_of(wv));

#pragma unroll 1
  for (int l = 0; l < 4; ++l) {
    const int i2 = l >> 1;
    unsigned char* ws = opqp(P->ws);
    bf16_t* hb = (bf16_t*)(ws + OFF_HB);
    bf16_t* ao = (bf16_t*)(ws + OFF_AO);
    unsigned char* U = ws + OFF_U;
    unsigned char* WT = ws + OFF_WT;
    const float* ada = (const float*)(ws + OFF_MISC + MS_ADA);
    const float* adal = ada + (size_t)l * 4 * 6144;
    const float* xin = (l == 0) ? P->in[0] : P->out;
    if ((l & 1) == 0) {
      bf16_t* proj = (bf16_t*)(U + U_PROJ);
      bf16_t* qlat = (bf16_t*)(U + U_QLAT);
      bf16_t* hid = (bf16_t*)(ws + OFF_MISC + MS_HID);
      const float* cbias = (const float*)(ws + OFF_MISC + MS_CB);
      for (int rp = 0; rp < REP_GEMM; ++rp) {
      gemm_run(lds, wv, APlain{hb, DM}, (const bf16_t*)(WT + WT_IN), DM, NTOK, EIN, DM, EpiEvenProj{proj, (bf16_t*)(U + U_VST), (bf16_t*)(U + U_VWT)}, 0);
      gbar(barp, bar_target, tid_of(wv)); }
#pragma unroll 1
      for (int kv = 0; kv < 2; ++kv)
        gemm_run(lds, wv, ACmp{proj, kv ? C_VC : C_KC}, (const bf16_t*)(WT + WT_CW1) + kv * 256 * 2048, 2048, 4096, 256, 2048, EpiCmp1{cbias + kv * 256, hid + kv * 4096 * 256}, 16 * kv);
#pragma unroll 1
      for (int h = 0; h < 8; ++h)
        gemm_run(lds, wv, APlain{proj + C_DQ + h * 64, EIN}, (const bf16_t*)(WT + WT_UK) + h * 64, 512, NTOK, 128, 64, EpiRow{qlat + h * 128, DM}, 32 + h * 128);
      ckv_norm_phase(P, wv, i2);
      gbar(barp, bar_target, tid_of(wv));
#pragma unroll 1
      for (int kv = 0; kv < 2; ++kv)
        gemm_run(lds, wv, APlain{hid + kv * 4096 * 256, 256}, (const bf16_t*)(WT + WT_CW2) + kv * 64 * 256, 256, 4096, 64, 256, EpiCmp2{(bf16_t*)(ws + OFF_MISC + MS_KC), (bf16_t*)(ws + OFF_MISC + MS_VCT), kv}, 16 * kv);
      for (int rp = 0; rp < REP_IDX; ++rp) dsa_index_phase(lds, P, wv);
      gbar(barp, bar_target, tid_of(wv));
      for (int rp = 0; rp < REP_NSA; ++rp) nsa_phase(lds, P, wv);
      dsa_sparse_phase(lds, P, wv);
      gbar(barp, bar_target, tid_of(wv));
#pragma unroll 1
      for (int h = 0; h < 8; ++h)
        gemm_run(lds, wv, APlain{qlat + h * 128, DM}, (const bf16_t*)(WT + WT_UV) + h * 64 * 128, 128, NTOK, 64, 128, EpiRow{ao + 512 + h * 64, DM}, h * 128);
      gbar(barp, bar_target, tid_of(wv));
    } else {
      for (int rp = 0; rp < REP_GEMM; ++rp) {
      gemm_run(lds, wv, APlain{hb, DM}, (const bf16_t*)(WT + WT_IN), DM, NTOK, OIN, DM, EpiOddProj{(bf16_t*)(U + U_QK), (bf16_t*)(U + U_VT)}, 0);
      gbar(barp, bar_target, tid_of(wv)); }
      for (int rp = 0; rp < REP_DIFF; ++rp) {
      diff_attn_phase(lds, P, wv, l);
      gbar(barp, bar_target, tid_of(wv)); }
    }
    gemm_run(lds, wv, APlain{ao, DM}, (const bf16_t*)(WT + WT_OUT), DM, NTOK, DM, DM, EpiResid{xin, P->out, adal + 2048}, 0);
    gbar(barp, bar_target, tid_of(wv));
    ln_mod_phase(P, wv, P->out, P->out, P->in[5] + (size_t)(l * 2) * DM, P->in[6] + (size_t)(l * 2) * DM, adal + 3072, adal + 4096, true, true);
    gbar(barp, bar_target, tid_of(wv));
    for (int rp = 0; rp < REP_GEMM; ++rp) {
    gemm_run(lds, wv, APlain{hb, DM}, (const bf16_t*)(WT + WT_M1), DM, NTOK, DFF, DM, EpiSqRelu{(bf16_t*)U}, 0);
    gbar(barp, bar_target, tid_of(wv)); }
    gemm_run(lds, wv, APlain{(const bf16_t*)U, DFF}, (const bf16_t*)(WT + WT_M2), DFF, NTOK, DM, DFF, EpiResid{P->out, P->out, adal + 5120}, 0);
    gbar(barp, bar_target, tid_of(wv));
    ln_mod_phase(P, wv, P->out, P->out, P->in[5] + (size_t)(l * 2 + 1) * DM, P->in[6] + (size_t)(l * 2 + 1) * DM, adal + 4 * 6144, adal + 4 * 6144 + 1024, true, l < 3);
    if (l < 3) { wprep_phase(lds, P, wv, l + 1); gbar(barp, bar_target, tid_of(wv)); }
  }
}

#undef P
extern "C" void kernel_launch(void* const* d_in, const int* in_sizes, int n_in, void* d_out, int out_size, void* d_ws, size_t ws_size, hipStream_t stream) {
  static int grid_blocks = 0;
  if (grid_blocks == 0) {
    int dev = 0, cus = 0, per_cu = 0;
    (void)hipGetDevice(&dev);
    (void)hipDeviceGetAttribute(&cus, hipDeviceAttributeMultiprocessorCount, dev);
    if (hipFuncSetAttribute((const void*)mega, hipFuncAttributeMaxDynamicSharedMemorySize, LDS_BYTES) != hipSuccess) fprintf(stderr, "setattr failed\n");
    (void)hipOccupancyMaxActiveBlocksPerMultiprocessor(&per_cu, (const void*)mega, NTHREADS, LDS_BYTES);
    fprintf(stderr, "cus %d per_cu %d ws_size %zu n_in %d\n", cus, per_cu, ws_size, n_in);
    if (per_cu < 1 || n_in != 24 || ws_size < WS_NEED + 8 * MiB) { fprintf(stderr, "cannot launch\n"); grid_blocks = -1; }
    else grid_blocks = cus;
  }
  if (grid_blocks < 0) return;
  Params p{};
  for (int i = 0; i < 24; ++i) p.in[i] = (const float*)d_in[i];
  p.out = (float*)d_out; p.ws = (unsigned char*)d_ws;
  void* args[] = {&p};
  if (hipMemsetAsync((unsigned char*)d_ws + OFF_BAR, 0, 256, stream) != hipSuccess) fprintf(stderr, "memset failed\n");
  hipError_t e = hipLaunchCooperativeKernel((const void*)mega, dim3(grid_blocks), dim3(NTHREADS), args, LDS_BYTES, stream);
  if (e != hipSuccess) fprintf(stderr, "coop launch failed: %s\n", hipGetErrorString(e));
}
```

```cpp
#include <hip/hip_runtime.h>
#include <hip/hip_bf16.h>
#include <hip/hip_cooperative_groups.h>
#include <cstdio>
namespace cg = cooperative_groups;

#define DI __device__ __forceinline__
#define NTHREADS 512
#ifndef REP_C
#define REP_C 1
#endif
#ifndef REP_SYNC
#define REP_SYNC 0
#endif
#ifndef REP_GEMM
#define REP_GEMM 1
#endif
#ifndef REP_DIFF
#define REP_DIFF 1
#endif
#ifndef REP_NSA
#define REP_NSA 1
#endif
#ifndef REP_IDX
#define REP_IDX 1
#endif
#define LDS_BYTES (144 * 1024)

typedef unsigned short bf16_t;
typedef __attribute__((ext_vector_type(8))) short bf16x8;
typedef __attribute__((ext_vector_type(16))) float f32x16;
typedef __attribute__((ext_vector_type(4))) float f32x4;
typedef __attribute__((ext_vector_type(2))) float f32x2;
typedef __attribute__((ext_vector_type(2))) __bf16 bfx2;
typedef __attribute__((ext_vector_type(4))) unsigned u32x4;
typedef __attribute__((ext_vector_type(2))) unsigned u32x2;

#define MFMA32(a, b, c) __builtin_amdgcn_mfma_f32_32x32x16_bf16((a), (b), (c), 0, 0, 0)
#define MFMA16(a, b, c) __builtin_amdgcn_mfma_f32_16x16x32_bf16((a), (b), (c), 0, 0, 0)

constexpr int SEQ = 8192, NB = 4, DM = 1024, NTOK = NB * SEQ, DFF = 4096;
constexpr int EIN = 2528, OIN = 3072;
constexpr float ALPHA_C = 1.681792830507429f;
constexpr float LOG2E = 1.4426950408889634f;
constexpr float C1 = 0.125f * LOG2E;
constexpr float NEGB = -1e30f;
constexpr int C_NQ = 0, C_KC = 512, C_VC = 640, C_KS = 768, C_VS = 896, C_KW = 1024, C_VW = 1152, C_GATE = 1280, C_DQ = 1304, C_DKV = 1816, C_IQ = 1944, C_IK = 2456, C_IW = 2520;

constexpr size_t MiB = 1024 * 1024;
constexpr size_t OFF_HB = 0;
constexpr size_t OFF_AO = 64 * MiB;
constexpr size_t OFF_U = 128 * MiB;
constexpr size_t OFF_WT = 384 * MiB;
constexpr size_t OFF_MISC = 416 * MiB;
constexpr size_t OFF_BAR = 436 * MiB;
constexpr size_t WS_NEED = 440 * MiB;
constexpr size_t U_PROJ = 0;
constexpr size_t U_VST = 158 * MiB;
constexpr size_t U_VWT = 166 * MiB;
constexpr size_t U_QLAT = 174 * MiB;
constexpr size_t U_IDX = 238 * MiB;
constexpr size_t U_QK = 0;
constexpr size_t U_VT = 128 * MiB;
constexpr size_t WT_IN = 0, WT_OUT = 6 * MiB, WT_M1 = 8 * MiB, WT_M2 = 16 * MiB, WT_CW1 = 24 * MiB, WT_CW2 = 26 * MiB, WT_UK = 27 * MiB, WT_UV = 28 * MiB;
constexpr size_t MS_ADAP = 0;
constexpr size_t MS_ADA = 4 * MiB;
constexpr size_t MS_CB = 5 * MiB;
constexpr size_t MS_KC = 6 * MiB;
constexpr size_t MS_VCT = 7 * MiB;
constexpr size_t MS_HID = 8 * MiB;

struct Params {
  const float* in[24];
  float* out;
  unsigned char* ws;
  int pad0, pad1;
};

__device__ const unsigned short kSpStart[33] = {0, 52, 100, 144, 184, 220, 252, 281, 306, 327, 345, 359, 369, 378, 386, 394, 402, 410, 418, 426, 434, 442, 449, 456, 463, 470, 476, 482, 488, 494, 500, 506, 512};
typedef const __attribute__((address_space(4))) Params* KParamPtr;
__device__ __forceinline__ KParamPtr kparams() { unsigned long long v = (unsigned long long)__builtin_amdgcn_kernarg_segment_ptr(); asm volatile("" : "+s"(v)); return (KParamPtr)v; }
__device__ const unsigned char kBucket[128] = {0, 1, 2, 3, 4, 5, 6, 7, 8, 9, 10, 11, 12, 13, 14, 15, 16, 16, 16, 17, 17, 18, 18, 18, 19, 19, 19, 20, 20, 20, 20, 21, 21, 21, 21, 22, 22, 22, 22, 22, 23, 23, 23, 23, 23, 23, 24, 24, 24, 24, 24, 24, 25, 25, 25, 25, 25, 25, 25, 26, 26, 26, 26, 26, 26, 26, 26, 27, 27, 27, 27, 27, 27, 27, 27, 27, 27, 28, 28, 28, 28, 28, 28, 28, 28, 28, 28, 29, 29, 29, 29, 29, 29, 29, 29, 29, 29, 29, 29, 30, 30, 30, 30, 30, 30, 30, 30, 30, 30, 30, 30, 30, 30, 31, 31, 31, 31, 31, 31, 31, 31, 31, 31, 31, 31, 31, 31, 31};

DI unsigned pk2(float a, float b) { f32x2 v = {a, b}; bfx2 r = __builtin_convertvector(v, bfx2); return __builtin_bit_cast(unsigned, r); }
DI bf16_t f2bf(float a) { return (bf16_t)(pk2(a, 0.f) & 0xffffu); }
DI float bf2f(bf16_t v) { return __uint_as_float(((unsigned)v) << 16); }
DI u32x2 pk4(float a, float b, float c, float d) { u32x2 r; r.x = pk2(a, b); r.y = pk2(c, d); return r; }
DI int opq(int x) { asm volatile("" : "+v"(x)); return x; }
DI float opqf(float x) { asm volatile("" : "+v"(x)); return x; }
template <class T> DI T* opqp(T* p) { unsigned long long v = (unsigned long long)p; asm volatile("" : "+s"(v)); return (T*)v; }
DI int tid_of(int wave_s) { unsigned z = 0; asm volatile("" : "+s"(z)); int l = __builtin_amdgcn_mbcnt_hi(~0u, __builtin_amdgcn_mbcnt_lo(~0u, z)); return wave_s * 64 + l; }
DI float ex2(float x) { return __builtin_amdgcn_exp2f(x); }
DI float bperm_f(int srclane, float v) { return __int_as_float(__builtin_amdgcn_ds_bpermute(srclane << 2, __float_as_int(v))); }
DI int bperm_i(int srclane, int v) { return __builtin_amdgcn_ds_bpermute(srclane << 2, v); }
#define SHXF(v, m) bperm_f(lane ^ (m), (v))
#define SHXI(v, m) bperm_i(lane ^ (m), (v))
DI float red_max32(float x) { auto r = __builtin_amdgcn_permlane32_swap(__float_as_uint(x), __float_as_uint(x), false, false); return fmaxf(__uint_as_float(r[0]), __uint_as_float(r[1])); }
DI float red_max16(float x) { auto r = __builtin_amdgcn_permlane16_swap(__float_as_uint(x), __float_as_uint(x), false, false); return fmaxf(__uint_as_float(r[0]), __uint_as_float(r[1])); }
DI float red_sum32(float x) { auto r = __builtin_amdgcn_permlane32_swap(__float_as_uint(x), __float_as_uint(x), false, false); return __uint_as_float(r[0]) + __uint_as_float(r[1]); }
DI float red_sum16(float x) { auto r = __builtin_amdgcn_permlane16_swap(__float_as_uint(x), __float_as_uint(x), false, false); return __uint_as_float(r[0]) + __uint_as_float(r[1]); }
DI float wave_sum(float v, int lane) {
#pragma unroll
  for (int o = 32; o >= 1; o >>= 1) v += SHXF(v, o);
  return v;
}
DI int pi_row(int r) { return (r & 0x13) | ((r & 4) << 1) | ((r & 8) >> 1); }
DI bf16x8 pack8(const f32x16& x, int s8) {
  u32x4 u; u.x = pk2(x[8 * s8 + 0], x[8 * s8 + 1]); u.y = pk2(x[8 * s8 + 2], x[8 * s8 + 3]); u.z = pk2(x[8 * s8 + 4], x[8 * s8 + 5]); u.w = pk2(x[8 * s8 + 6], x[8 * s8 + 7]);
  return __builtin_bit_cast(bf16x8, u);
}
DI bf16x8 ldg8(const bf16_t* p) { return *(const bf16x8*)p; }
#define GLOAD16(dst, ptr) asm volatile("global_load_dwordx4 %0, %1, off" : "=&v"(dst) : "v"(ptr) : "memory")
DI void lds_barrier() { asm volatile("s_waitcnt lgkmcnt(0)\n\ts_barrier" ::: "memory"); }
DI void vm_wait0() { asm volatile("s_waitcnt vmcnt(0)" ::: "memory"); }
DI bf16x8 zero8() { u32x4 u = {0u, 0u, 0u, 0u}; return __builtin_bit_cast(bf16x8, u); }
DI f32x16 zero16() { f32x16 z;
#pragma unroll
  for (int i = 0; i < 16; ++i) z[i] = 0.f;
  return z; }
DI float sigmoidf_(float x) { return 1.f / (1.f + __expf(-x)); }
DI float gelu_tanh(float x) { float u = 0.7978845608028654f * (x + 0.044715f * x * x * x); float e = __expf(2.f * u); float th = 1.f - 2.f / (e + 1.f); return 0.5f * x * (1.f + th); }

constexpr int LROW = 72;
constexpr int LDS_TAB = 0;
constexpr int LDS_WORK = 8192;

struct APlain { const bf16_t* A; int lda; DI const bf16_t* base() const { return A; } DI unsigned rowoff(int m) const { return (unsigned)(m * lda); } DI unsigned koff(int k) const { return (unsigned)k; } };
struct ACmp {
  const bf16_t* proj; int col0;
  DI const bf16_t* base() const { return proj; }
  DI unsigned rowoff(int m) const { int combo = m >> 9, n = m & 511, b = combo >> 1, g = combo & 1; return (unsigned)((b * SEQ + 16 * n) * EIN + col0 + g * 64); }
  DI unsigned koff(int k) const { return (unsigned)((k >> 6) * EIN + (k & 63)); }
};

typedef __attribute__((address_space(3))) unsigned lds_u32_t;
DI void dma16(const void* g, unsigned char* l) { __builtin_amdgcn_global_load_lds((const unsigned*)g, (lds_u32_t*)(unsigned)(size_t)l, 16, 0, 0); }
constexpr int GST = 65536;
template <class AF, class EF>
DI void gemm_run(unsigned char* lds, int wv, const AF& af, const bf16_t* __restrict__ Bt, int ldb, int M, int N, int K, const EF& ef, int blk_off) {
  unsigned char* sBase = lds + LDS_WORK;
  const int tid = tid_of(wv), lane = tid & 63, wave = tid >> 6;
  const int wn = wave & 3, wm = wave >> 2;
  const int l15 = lane & 15, q4 = lane >> 4;
  const int mtiles = M >> 8, ntiles = (N + 255) >> 8, ntl = mtiles * ntiles;
  const int G = gridDim.x;
  int first = ((int)blockIdx.x - (blk_off % G) + G) % G;
  const int nk = K >> 6;
  const bool xmap = (blk_off == 0) && ((mtiles & 7) == 0) && ((G & 7) == 0);
  int tstep = G;
  if (xmap) { first = (int)blockIdx.x >> 3; tstep = G >> 3; }
  const int ntl_eff = xmap ? (ntl >> 3) : ntl;
  const int crow = tid >> 3;
  const int cch = ((tid & 7) ^ ((tid >> 4) & 7)) * 8;
  const int swz = l15 >> 1;
  for (int tile_ = first; tile_ < ntl_eff; tile_ += tstep) {
    int nt, mt;
    if (xmap) { nt = tile_ % ntiles; mt = (tile_ / ntiles) * 8 + ((int)blockIdx.x & 7); }
    else { nt = tile_ % ntiles; mt = tile_ / ntiles; }
    const int m0 = mt << 8, n0 = nt << 8;
    f32x4 acc[4][8];
#pragma unroll
    for (int i = 0; i < 4; ++i)
#pragma unroll
      for (int j = 0; j < 8; ++j) acc[i][j] = (f32x4){0.f, 0.f, 0.f, 0.f};
    unsigned aoff[4], boff[4];
    const bf16_t* Ab = af.base();
#pragma unroll
    for (int i = 0; i < 4; ++i) {
      int row = crow + 64 * i;
      aoff[i] = af.rowoff(m0 + row);
      int n = n0 + row; n = n < N ? n : N - 1;
      boff[i] = (unsigned)(n * ldb + cch);
    }
    __syncthreads();
#pragma unroll
    for (int i = 0; i < 4; ++i) {
      dma16(Ab + aoff[i] + af.koff(cch), sBase + 32768 + (i * 512 + tid) * 16);
      dma16(Bt + boff[i], sBase + (i * 512 + tid) * 16);
    }
    vm_wait0();
    __syncthreads();
#pragma unroll 1
    for (int kt = 0; kt < nk; ++kt) {
      unsigned char* cur = sBase + (kt & 1) * GST;
      if (kt + 1 < nk) {
        unsigned char* nxt = sBase + ((kt + 1) & 1) * GST;
        const int k0 = (kt + 1) << 6;
#pragma unroll
        for (int i = 0; i < 4; ++i) {
          dma16(Ab + aoff[i] + af.koff(k0 + cch), nxt + 32768 + (i * 512 + tid) * 16);
          dma16(Bt + boff[i] + (unsigned)k0, nxt + (i * 512 + tid) * 16);
        }
      }
#pragma unroll
      for (int ks = 0; ks < 2; ++ks) {
        bf16x8 wf[4], xf[8];
#pragma unroll
        for (int i = 0; i < 4; ++i) wf[i] = *(const bf16x8*)(cur + (wn * 64 + i * 16 + l15) * 128 + (((ks * 4 + q4) ^ swz) * 16));
#pragma unroll
        for (int j = 0; j < 8; ++j) xf[j] = *(const bf16x8*)(cur + 32768 + (wm * 128 + j * 16 + l15) * 128 + (((ks * 4 + q4) ^ swz) * 16));
#pragma unroll
        for (int i = 0; i < 4; ++i)
#pragma unroll
          for (int j = 0; j < 8; ++j) acc[i][j] = MFMA16(wf[i], xf[j], acc[i][j]);
      }
      vm_wait0();
      __syncthreads();
    }
#pragma unroll
    for (int i = 0; i < 4; ++i)
#pragma unroll
      for (int j = 0; j < 8; ++j) {
        int n = n0 + wn * 64 + i * 16 + 4 * q4;
        int m = m0 + wm * 128 + j * 16 + l15;
        if (n < N) ef.store(m, n, acc[i][j][0], acc[i][j][1], acc[i][j][2], acc[i][j][3]);
      }
  }
}

struct EpiRow { bf16_t* C; int ldc; DI void store(int m, int n, float a, float b, float c, float d) const { *(u32x2*)(C + (size_t)m * ldc + n) = pk4(a, b, c, d); } };
struct EpiSqRelu { bf16_t* C; DI void store(int m, int n, float a, float b, float c, float d) const {
    a = fmaxf(a, 0.f); b = fmaxf(b, 0.f); c = fmaxf(c, 0.f); d = fmaxf(d, 0.f);
    *(u32x2*)(C + (size_t)m * DFF + n) = pk4(a * a, b * b, c * c, d * d); } };
struct EpiResid { const float* xin; float* out; const float* gate;
  DI void store(int m, int n, float a, float b, float c, float d) const {
    int bb = m >> 13;
    float4 x = *(const float4*)(xin + (size_t)m * DM + n);
    float4 g = *(const float4*)(gate + bb * 6144 + n);
    const float one = opqf(1.0f);
    float4 r; r.x = ALPHA_C * x.x + (one + g.x) * a; r.y = ALPHA_C * x.y + (one + g.y) * b; r.z = ALPHA_C * x.z + (one + g.z) * c; r.w = ALPHA_C * x.w + (one + g.w) * d;
    *(float4*)(out + (size_t)m * DM + n) = r; } };
struct EpiEvenProj { bf16_t* proj; bf16_t* vsT; bf16_t* vwT;
  DI void store(int m, int n, float a, float b, float c, float d) const {
    int bb = m >> 13, s = m & (SEQ - 1);
    if (n >= C_VS && n < C_KW) { int e = n - C_VS; bf16_t* p = vsT + ((size_t)(bb * 128 + e)) * SEQ + s; p[0] = f2bf(a); p[SEQ] = f2bf(b); p[2 * SEQ] = f2bf(c); p[3 * SEQ] = f2bf(d); }
    else if (n >= C_VW && n < C_GATE) { int e = n - C_VW; bf16_t* p = vwT + ((size_t)(bb * 128 + e)) * SEQ + s; p[0] = f2bf(a); p[SEQ] = f2bf(b); p[2 * SEQ] = f2bf(c); p[3 * SEQ] = f2bf(d); }
    else *(u32x2*)(proj + (size_t)m * EIN + n) = pk4(a, b, c, d); } };
struct EpiOddProj { bf16_t* qk; bf16_t* vT;
  DI void store(int m, int n, float a, float b, float c, float d) const {
    if (n < 2048) *(u32x2*)(qk + (size_t)m * 2048 + n) = pk4(a, b, c, d);
    else { int bb = m >> 13, s = m & (SEQ - 1); int e = n - 2048; bf16_t* p = vT + ((size_t)(bb * 1024 + e)) * SEQ + s; p[0] = f2bf(a); p[SEQ] = f2bf(b); p[2 * SEQ] = f2bf(c); p[3 * SEQ] = f2bf(d); } } };
struct EpiCmp1 { const float* bias; bf16_t* hid;
  DI void store(int m, int n, float a, float b, float c, float d) const {
    float4 bv = *(const float4*)(bias + n);
    *(u32x2*)(hid + (size_t)m * 256 + n) = pk4(gelu_tanh(a + bv.x), gelu_tanh(b + bv.y), gelu_tanh(c + bv.z), gelu_tanh(d + bv.w)); } };
struct EpiCmp2 { bf16_t* kc; bf16_t* vcT; int kv; DI void store(int m, int n, float a, float b, float c, float d) const {
    int combo = m >> 9, nn = m & 511;
    if (nn == 511) { a = b = c = d = 0.f; }
    if (kv == 0) *(u32x2*)(kc + (size_t)m * 64 + n) = pk4(a, b, c, d);
    else { bf16_t* p = vcT + ((size_t)(combo * 64 + n)) * 512 + nn; p[0] = f2bf(a); p[512] = f2bf(b); p[1024] = f2bf(c); p[1536] = f2bf(d); } } };

DI void tr_convert(unsigned char* lds, int wv, const float* __restrict__ src, int K, int N, bf16_t* __restrict__ dst, int& tb) {
  bf16_t* sT = (bf16_t*)(lds + LDS_WORK);
  const int tid = tid_of(wv), G = gridDim.x;
  const int nkt = K >> 6, nnt = (N + 63) >> 6, ntl = nkt * nnt;
  int first = ((int)blockIdx.x - (tb % G) + G) % G;
  for (int tl = first; tl < ntl; tl += G) {
    const int k0 = (tl / nnt) << 6, n0 = (tl % nnt) << 6;
    const int kk = tid >> 4, n4 = (tid & 15) * 4;
    __syncthreads();
#pragma unroll
    for (int i = 0; i < 2; ++i) {
      int k = kk + 32 * i;
      float4 v = make_float4(0.f, 0.f, 0.f, 0.f);
      if (n0 + n4 < N) v = *(const float4*)(src + (size_t)(k0 + k) * N + n0 + n4);
      sT[(n4 + 0) * LROW + k] = f2bf(v.x); sT[(n4 + 1) * LROW + k] = f2bf(v.y); sT[(n4 + 2) * LROW + k] = f2bf(v.z); sT[(n4 + 3) * LROW + k] = f2bf(v.w);
    }
    __syncthreads();
    const int n = tid >> 3, k8 = (tid & 7) * 8;
    if (n0 + n < N) *(u32x4*)(dst + (size_t)(n0 + n) * K + k0 + k8) = *(const u32x4*)(sT + n * LROW + k8);
  }
  tb += ntl;
}

DI void wprep_phase(unsigned char* lds, KParamPtr P, int wv, int l) {
  unsigned char* wsq = opqp(P->ws);
  bf16_t* WT = (bf16_t*)(wsq + OFF_WT);
  int tb = 0;
  const int i2 = l >> 1;
  tr_convert(lds, wv, P->in[22] + (size_t)l * DM * DFF, DM, DFF, (bf16_t*)((unsigned char*)WT + WT_M1), tb);
  tr_convert(lds, wv, P->in[23] + (size_t)l * DFF * DM, DFF, DM, (bf16_t*)((unsigned char*)WT + WT_M2), tb);
  if ((l & 1) == 0) {
    tr_convert(lds, wv, P->in[7] + (size_t)i2 * DM * EIN, DM, EIN, (bf16_t*)((unsigned char*)WT + WT_IN), tb);
    tr_convert(lds, wv, P->in[8] + (size_t)i2 * DM * DM, DM, DM, (bf16_t*)((unsigned char*)WT + WT_OUT), tb);
    tr_convert(lds, wv, P->in[11] + (size_t)i2 * 2048 * 256, 2048, 256, (bf16_t*)((unsigned char*)WT + WT_CW1), tb);
    tr_convert(lds, wv, P->in[13] + (size_t)i2 * 2048 * 256, 2048, 256, (bf16_t*)((unsigned char*)WT + WT_CW1) + 256 * 2048, tb);
    tr_convert(lds, wv, P->in[12] + (size_t)i2 * 256 * 64, 256, 64, (bf16_t*)((unsigned char*)WT + WT_CW2), tb);
    tr_convert(lds, wv, P->in[14] + (size_t)i2 * 256 * 64, 256, 64, (bf16_t*)((unsigned char*)WT + WT_CW2) + 64 * 256, tb);
    tr_convert(lds, wv, P->in[17] + (size_t)i2 * 128 * 512, 128, 512, (bf16_t*)((unsigned char*)WT + WT_UV), tb);
    {
      const float* src = P->in[16] + (size_t)i2 * 128 * 512; bf16_t* dst = (bf16_t*)((unsigned char*)WT + WT_UK);
      for (int i = (blockIdx.x * NTHREADS + tid_of(wv)) * 4; i < 128 * 512; i += gridDim.x * NTHREADS * 4) {
        float4 v = *(const float4*)(src + i); *(u32x2*)(dst + i) = pk4(v.x, v.y, v.z, v.w);
      }
    }
    {
      float* red = (float*)(lds + LDS_WORK + 16384);
      float* cb = (float*)(wsq + OFF_MISC + MS_CB);
      const int tid_ = tid_of(wv); const int lane = tid_ & 63, wave = tid_ >> 6;
      for (int it = (int)gridDim.x - 1 - (int)blockIdx.x; it < 8; it += gridDim.x) {
        const int kv = it >> 2, n0 = (it & 3) * 64;
        const float* pe = P->in[kv ? 10 : 9] + (size_t)i2 * 2048;
        const float* w1 = P->in[kv ? 13 : 11] + (size_t)i2 * 2048 * 256;
        float a = 0.f;
        for (int k = wave * 256; k < wave * 256 + 256; ++k) a += pe[k] * w1[(size_t)k * 256 + n0 + lane];
        __syncthreads();
        red[wave * 64 + lane] = a;
        __syncthreads();
        if (wave == 0) { float s = 0.f; for (int w = 0; w < 8; ++w) s += red[w * 64 + lane]; cb[kv * 256 + n0 + lane] = s; }
      }
    }
  } else {
    tr_convert(lds, wv, P->in[18] + (size_t)i2 * DM * OIN, DM, OIN, (bf16_t*)((unsigned char*)WT + WT_IN), tb);
    tr_convert(lds, wv, P->in[19] + (size_t)i2 * DM * DM, DM, DM, (bf16_t*)((unsigned char*)WT + WT_OUT), tb);
  }
}

DI void ada_partial_phase(unsigned char* lds, KParamPtr P, int wv) {
  unsigned char* wsq = opqp(P->ws);
  float* cact = (float*)(lds + LDS_WORK);
  float* part = (float*)(wsq + OFF_MISC + MS_ADAP);
  const int tid = tid_of(wv);
  __syncthreads();
  for (int i = tid; i < 4096; i += NTHREADS) { float v = P->in[1][i]; cact[i] = v / (1.f + __expf(-v)); }
  __syncthreads();
  for (int it = blockIdx.x; it < 384; it += gridDim.x) {
    const int kc = it & 7, jc = (it >> 3) % 12, l = it / 96;
    const int j = jc * 512 + tid;
    const float* w = P->in[3] + ((size_t)l * 1024 + kc * 128) * 6144 + j;
    float a0 = 0.f, a1 = 0.f, a2 = 0.f, a3 = 0.f;
#pragma unroll 8
    for (int k = 0; k < 128; ++k) {
      float wgt = w[(size_t)k * 6144];
      int kk = kc * 128 + k;
      a0 += cact[kk] * wgt; a1 += cact[1024 + kk] * wgt; a2 += cact[2048 + kk] * wgt; a3 += cact[3072 + kk] * wgt;
    }
    float* o = part + ((size_t)(kc * 4 + l) * 4) * 6144 + j;
    o[0] = a0; o[6144] = a1; o[2 * 6144] = a2; o[3 * 6144] = a3;
  }
}
DI void ada_reduce_phase(KParamPtr P, int wv) {
  unsigned char* wsq = opqp(P->ws);
  const float* part = (const float*)(wsq + OFF_MISC + MS_ADAP);
  float* ada = (float*)(wsq + OFF_MISC + MS_ADA);
  for (int i = blockIdx.x * NTHREADS + tid_of(wv); i < 4 * 4 * 6144; i += gridDim.x * NTHREADS) {
    int l = i / (4 * 6144), j = i % 6144;
    float s = P->in[4][l * 6144 + j];
#pragma unroll
    for (int kc = 0; kc < 8; ++kc) s += part[(size_t)kc * 4 * 4 * 6144 + i];
    ada[i] = s;
  }
}

DI void ln_mod_phase(KParamPtr P, int wv, const float* src, float* xdst, const float* lng, const float* lnb, const float* sh, const float* sc, bool do_ln, bool write_hb) {
  unsigned char* wsq = opqp(P->ws);
  bf16_t* hb = (bf16_t*)(wsq + OFF_HB);
  const int tid_ = tid_of(wv); const int lane = tid_ & 63, wave = tid_ >> 6;
  const int nw = gridDim.x * 8, gw = blockIdx.x * 8 + wave;
  const int rpw = (NTOK + nw - 1) / nw;
  int r0 = gw * rpw, r1 = r0 + rpw; if (r1 > NTOK) r1 = NTOK;
  float4 g4[4], b4[4], sh4[4], sc4[4];
#pragma unroll
  for (int i = 0; i < 4; ++i) { int c = lane * 4 + 256 * i; if (do_ln) { g4[i] = *(const float4*)(lng + c); b4[i] = *(const float4*)(lnb + c); } }
  int curb = -1;
  const float one = opqf(1.0f);
  f32x4 vn[4];
  if (r0 < r1) {
#pragma unroll
    for (int i = 0; i < 4; ++i) vn[i] = *(const f32x4*)(src + (size_t)r0 * DM + lane * 4 + 256 * i);
  }
  for (int row = r0; row < r1; ++row) {
    const int bb = row >> 13;
    if (bb != curb && write_hb) {
      curb = bb;
#pragma unroll
      for (int i = 0; i < 4; ++i) { int c = lane * 4 + 256 * i; sh4[i] = *(const float4*)(sh + bb * 6144 + c); sc4[i] = *(const float4*)(sc + bb * 6144 + c); }
    }
    float4 v[4];
#pragma unroll
    for (int i = 0; i < 4; ++i) { v[i].x = vn[i][0]; v[i].y = vn[i][1]; v[i].z = vn[i][2]; v[i].w = vn[i][3]; }
    {
      const int rn = row + 1 < r1 ? row + 1 : row;
#pragma unroll
      for (int i = 0; i < 4; ++i) vn[i] = *(const f32x4*)(src + (size_t)rn * DM + lane * 4 + 256 * i);
    }
    if (do_ln) {
      float s = 0.f;
#pragma unroll
      for (int i = 0; i < 4; ++i) s += v[i].x + v[i].y + v[i].z + v[i].w;
      const float mu = wave_sum(s, lane) * (1.f / 1024.f);
      float q = 0.f;
#pragma unroll
      for (int i = 0; i < 4; ++i) { v[i].x -= mu; v[i].y -= mu; v[i].z -= mu; v[i].w -= mu; q += v[i].x * v[i].x + v[i].y * v[i].y + v[i].z * v[i].z + v[i].w * v[i].w; }
      const float rstd = rsqrtf(wave_sum(q, lane) * (1.f / 1024.f) + 1e-5f);
#pragma unroll
      for (int i = 0; i < 4; ++i) {
        v[i].x = v[i].x * rstd * g4[i].x + b4[i].x; v[i].y = v[i].y * rstd * g4[i].y + b4[i].y; v[i].z = v[i].z * rstd * g4[i].z + b4[i].z; v[i].w = v[i].w * rstd * g4[i].w + b4[i].w;
        *(float4*)(xdst + (size_t)row * DM + lane * 4 + 256 * i) = v[i];
      }
    }
    if (write_hb) {
#pragma unroll
      for (int i = 0; i < 4; ++i) {
        *(u32x2*)(hb + (size_t)row * DM + lane * 4 + 256 * i) = pk4(v[i].x * (one + sc4[i].x) + sh4[i].x, v[i].y * (one + sc4[i].y) + sh4[i].y, v[i].z * (one + sc4[i].z) + sh4[i].z, v[i].w * (one + sc4[i].w) + sh4[i].w);
      }
    }
  }
}

DI void diff_attn_phase(unsigned char* lds, KParamPtr P, int wv, int l) {
  unsigned char* wsq = opqp(P->ws);
  const float* tab = (const float*)(lds + LDS_TAB);
  bf16_t* sK = (bf16_t*)(lds + LDS_WORK);
  bf16_t* sV = sK + 64 * LROW;
  const bf16_t* qk = (const bf16_t*)(wsq + OFF_U + U_QK);
  const bf16_t* vT = (const bf16_t*)(wsq + OFF_U + U_VT);
  bf16_t* ao = (bf16_t*)(wsq + OFF_AO);
  const int i2 = l >> 1;
  const int tid = tid_of(wv), lane = tid & 63, wave = tid >> 6, l31 = lane & 31, hh = lane >> 5;
  const float lambda_init = 0.8f - 0.6f * __expf(-0.3f * (float)l);
  float lam_full;
  {
    const float* lam = P->in[20] + (size_t)i2 * 256;
    float s1 = 0.f, s2 = 0.f;
    for (int d = 0; d < 64; ++d) { s1 += lam[d] * lam[64 + d]; s2 += lam[128 + d] * lam[192 + d]; }
    lam_full = __expf(s1) - __expf(s2) + lambda_init;
  }
  const float* subln = P->in[21] + (size_t)i2 * 128;
  const int pr = pi_row(l31);
  for (int it = blockIdx.x; it < 1024; it += gridDim.x) {
    const int rr = it >> 8, kk = it & 255, bh = (kk & 7) * 4 + rr, jq = kk >> 3;
    const int qt = (rr & 1) ? 31 - jq : jq;
    const int b = bh >> 3, h = bh & 7;
    const int Q0 = qt * 256, q0w = Q0 + wave * 32, t = q0w + l31;
    const int nkt = 4 * (qt + 1);
    unsigned* O1L = (unsigned*)(lds + LDS_WORK + 32768) + tid;
#pragma unroll 1
    for (int pass = 0; pass < 2; ++pass) {
      const int col = h * 2 + pass;
      bf16x8 qf[4];
      const bf16_t* qp = qk + (size_t)(b * SEQ + t) * 2048 + h * 128 + pass * 64 + hh * 8;
#pragma unroll
      for (int ks = 0; ks < 4; ++ks) qf[ks] = ldg8(qp + ks * 16);
      f32x16 O[4];
#pragma unroll
      for (int e = 0; e < 4; ++e) O[e] = zero16();
      float m_run = NEGB, l_run = 0.f;
      const float bfar = tab[col * 128 + 127];
      const unsigned kgo = (unsigned)((b * SEQ + (tid >> 3)) * 2048 + 1024 + h * 128 + pass * 64 + (tid & 7) * 8);
      const unsigned vgo = (unsigned)(((b * 8 + h) * 128 + (tid >> 3)) * SEQ + (tid & 7) * 8);
      u32x4 rk = *(const u32x4*)(qk + kgo), rv0 = *(const u32x4*)(vT + vgo), rv1 = *(const u32x4*)(vT + vgo + 64 * SEQ);
      __syncthreads();
      *(u32x4*)(sK + (tid >> 3) * LROW + (tid & 7) * 8) = rk;
      *(u32x4*)(sV + (tid >> 3) * LROW + (tid & 7) * 8) = rv0;
      *(u32x4*)(sV + ((tid >> 3) + 64) * LROW + (tid & 7) * 8) = rv1;
      __syncthreads();
#pragma unroll 1
      for (int kt = 0; kt < nkt; ++kt) {
        if (kt + 1 < nkt) {
          const int kn = kt + 1;
          GLOAD16(rk, qk + kgo + (unsigned)(kn * 64 * 2048));
          GLOAD16(rv0, vT + vgo + (unsigned)(kn * 64));
          GLOAD16(rv1, vT + vgo + (unsigned)(kn * 64 + 64 * SEQ));
        }
#pragma unroll
        for (int sub = 0; sub < 2; ++sub) {
          const int s0 = kt * 64 + sub * 32;
          if (s0 <= q0w + 31) {
            f32x16 s = zero16();
            bf16x8 kf[4], vf[8];
#pragma unroll
            for (int ks = 0; ks < 4; ++ks) kf[ks] = *(const bf16x8*)(sK + (sub * 32 + pr) * LROW + ks * 16 + hh * 8);
#pragma unroll
            for (int st = 0; st < 2; ++st)
#pragma unroll
              for (int e = 0; e < 4; ++e) vf[st * 4 + e] = *(const bf16x8*)(sV + (e * 32 + l31) * LROW + sub * 32 + st * 16 + hh * 8);
            __builtin_amdgcn_sched_barrier(0);
#pragma unroll
            for (int ks = 0; ks < 4; ++ks) s = MFMA32(kf[ks], qf[ks], s);
            float mloc = NEGB;
            const bool far = (q0w - (s0 + 31) >= 127);
            if (far) {
#pragma unroll
              for (int i = 0; i < 16; ++i) mloc = fmaxf(mloc, s[i]);
              mloc = fmaf(mloc, C1, bfar);
            } else {
#pragma unroll
              for (int i = 0; i < 16; ++i) {
                int key = s0 + (i & 7) + 8 * hh + 16 * (i >> 3);
                int dist = t - key; int dd = dist < 0 ? 0 : (dist > 127 ? 127 : dist);
                const float tb = tab[col * 128 + dd];
                float z = fmaf(s[i], C1, tb); z = dist < 0 ? NEGB : z;
                s[i] = z; mloc = fmaxf(mloc, z);
              }
            }
            mloc = red_max32(mloc);
            const float m_new = (mloc > m_run + 16.f) ? mloc : m_run;
            const float alpha = ex2(m_run - m_new);
            float ls = 0.f;
            if (far) {
              const float boff_ = bfar - m_new;
#pragma unroll
              for (int i = 0; i < 16; ++i) { float p = ex2(fmaf(s[i], C1, boff_)); s[i] = p; ls += p; }
            } else {
#pragma unroll
              for (int i = 0; i < 16; ++i) { float p = ex2(s[i] - m_new); s[i] = p; ls += p; }
            }
            l_run = l_run * alpha + ls; m_run = m_new;
            if (__any(alpha != 1.0f)) {
#pragma unroll
              for (int e = 0; e < 4; ++e)
#pragma unroll
                for (int i = 0; i < 16; ++i) O[e][i] *= alpha;
            }
#pragma unroll
            for (int st = 0; st < 2; ++st) {
              bf16x8 pf = pack8(s, st);
#pragma unroll
              for (int e = 0; e < 4; ++e) O[e] = MFMA32(vf[st * 4 + e], pf, O[e]);
            }
          }
        }
        __syncthreads();
        vm_wait0();
        if (kt + 1 < nkt) {
          *(u32x4*)(sK + (tid >> 3) * LROW + (tid & 7) * 8) = rk;
          *(u32x4*)(sV + (tid >> 3) * LROW + (tid & 7) * 8) = rv0;
          *(u32x4*)(sV + ((tid >> 3) + 64) * LROW + (tid & 7) * 8) = rv1;
        }
        __syncthreads();
      }
      const float lt = red_sum32(l_run);
      const float inv = 1.f / lt;
      if (pass == 0) {
#pragma unroll
        for (int e = 0; e < 4; ++e)
#pragma unroll
          for (int i = 0; i < 8; ++i) O1L[(e * 8 + i) * 512] = pk2(O[e][2 * i] * inv, O[e][2 * i + 1] * inv);
      } else {
        float ss = 0.f;
#pragma unroll
        for (int e = 0; e < 4; ++e)
#pragma unroll
          for (int i = 0; i < 16; ++i) {
            const unsigned pw = O1L[(e * 8 + (i >> 1)) * 512];
            float o1 = (i & 1) ? __uint_as_float(pw & 0xffff0000u) : __uint_as_float(pw << 16);
            float o = o1 - lam_full * (O[e][i] * inv); O[e][i] = o; ss += o * o; }
        ss = red_sum32(ss);
        const float rs = rsqrtf(ss * (1.f / 128.f) + 1e-5f) * (1.f - lambda_init);
        bf16_t* op = ao + (size_t)(b * SEQ + t) * DM + h * 128;
#pragma unroll
        for (int e = 0; e < 4; ++e)
#pragma unroll
          for (int g = 0; g < 4; ++g) {
            int ee = e * 32 + 8 * g + 4 * hh;
            float4 sl = *(const float4*)(subln + ee);
            *(u32x2*)(op + ee) = pk4(O[e][4 * g] * rs * sl.x, O[e][4 * g + 1] * rs * sl.y, O[e][4 * g + 2] * rs * sl.z, O[e][4 * g + 3] * rs * sl.w);
          }
      }
    }
  }
}

DI void cmp_z(f32x16& s, int kt, int t, int t0, int hh, const float* tabh, float& mloc) {
  const int nb = kt * 32;
  if (t0 - (16 * (nb + 31) + 31) >= 127) {
    const float bf = tabh[127];
#pragma unroll
    for (int i = 0; i < 16; ++i) { float z = fmaf(s[i], C1, bf); s[i] = z; mloc = fmaxf(mloc, z); }
  } else {
#pragma unroll
    for (int i = 0; i < 16; ++i) {
      int n = nb + (i & 7) + 8 * hh + 16 * (i >> 3);
      int dc = t - (16 * n + 31); int dd = dc < 0 ? 0 : (dc > 127 ? 127 : dc);
      float z = dc < 0 ? NEGB : fmaf(s[i], C1, tabh[dd]);
      s[i] = z; mloc = fmaxf(mloc, z);
    }
  }
}

DI void nsa_phase(unsigned char* lds, KParamPtr P, int wv) {
  unsigned char* wsq = opqp(P->ws);
  const float* tab = (const float*)(lds + LDS_TAB);
  const int tid = tid_of(wv), lane = tid & 63, wave = tid >> 6, l31 = lane & 31, hh = lane >> 5;
  unsigned char* selL = lds + LDS_WORK + wave * 512;
  float* scw = (float*)(lds + LDS_WORK + 4096 + wave * 16384);
  const bf16_t* proj = (const bf16_t*)(wsq + OFF_U + U_PROJ);
  const bf16_t* vsT = (const bf16_t*)(wsq + OFF_U + U_VST);
  const bf16_t* vwT = (const bf16_t*)(wsq + OFF_U + U_VWT);
  const bf16_t* kc = (const bf16_t*)(wsq + OFF_MISC + MS_KC);
  const bf16_t* vcT = (const bf16_t*)(wsq + OFF_MISC + MS_VCT);
  float* part = (float*)(wsq + OFF_HB);
  bf16_t* ao = (bf16_t*)(wsq + OFF_AO);
  const int nw = gridDim.x * 8, gw = blockIdx.x * 8 + wave;
  const int pr = pi_row(l31);
  for (int it = gw; it < 2048; it += nw) {
    const int blk_ = it >> 3, combo_ = blk_ & 7;
    const int b = combo_ >> 1, g = combo_ & 1, tile = ((blk_ >> 3) << 3) + (it & 7), t0 = tile * 32, t = t0 + l31;
    const size_t tok = (size_t)b * SEQ + t;
    const bf16_t* kcb = kc + (size_t)((b * 2 + g) * 512) * 64;
    const bf16_t* vcb = vcT + (size_t)((b * 2 + g) * 64) * 512;
#pragma unroll 1
    for (int x = 0; x < 64; ++x) scw[x * 64 + lane] = 0.f;
    const int nkt = (2 * tile + 1 + 31) >> 5;
#pragma unroll 1
    for (int hp = 0; hp < 4; ++hp) {
      const int head = g * 4 + hp;
      const float* tabh = tab + head * 128;
      bf16x8 qf[4];
#pragma unroll
      for (int ks = 0; ks < 4; ++ks) qf[ks] = ldg8(proj + tok * EIN + C_NQ + head * 64 + ks * 16 + hh * 8);
      float m = NEGB, l = 0.f;
      bf16x8 kf[4];
      const unsigned kco = (unsigned)(pr * 64 + hh * 8);
#pragma unroll
      for (int ks = 0; ks < 4; ++ks) kf[ks] = ldg8(kcb + kco + ks * 16);
#pragma unroll 1
      for (int kt = 0; kt < nkt; ++kt) {
        f32x16 s = zero16();
#pragma unroll
        for (int ks = 0; ks < 4; ++ks) s = MFMA32(kf[ks], qf[ks], s);
        {
          const int kn = kt + 1 < nkt ? kt + 1 : kt;
#pragma unroll
          for (int ks = 0; ks < 4; ++ks) kf[ks] = ldg8(kcb + kco + (unsigned)(kn * 32 * 64 + ks * 16));
        }
        float mloc = NEGB;
        cmp_z(s, kt, t, t0, hh, tabh, mloc);
        mloc = red_max32(mloc);
        const float mn = fmaxf(m, mloc);
        float ls = 0.f;
#pragma unroll
        for (int i = 0; i < 16; ++i) ls += (s[i] > -1e29f) ? ex2(s[i] - mn) : 0.f;
        l = l * ex2(m - mn) + ls; m = mn;
      }
      const float lt = red_sum32(l);
      const float inv = lt > 0.f ? 1.f / lt : 0.f;
      f32x16 O[2]; O[0] = zero16(); O[1] = zero16();
      float carry = 0.f;
#pragma unroll
      for (int ks = 0; ks < 4; ++ks) kf[ks] = ldg8(kcb + kco + ks * 16);
#pragma unroll 1
      for (int kt = 0; kt < nkt; ++kt) {
        {
          bf16x8 vf[4];
#pragma unroll
          for (int st = 0; st < 2; ++st)
#pragma unroll
            for (int et = 0; et < 2; ++et) vf[st * 2 + et] = ldg8(vcb + (unsigned)((et * 32 + l31) * 512 + kt * 32 + st * 16 + hh * 8));
          f32x16 s = zero16();
#pragma unroll
          for (int ks = 0; ks < 4; ++ks) s = MFMA32(kf[ks], qf[ks], s);
          {
            const int kn = kt + 1 < nkt ? kt + 1 : kt;
#pragma unroll
            for (int ks = 0; ks < 4; ++ks) kf[ks] = ldg8(kcb + kco + (unsigned)(kn * 32 * 64 + ks * 16));
          }
          float mloc = NEGB;
          cmp_z(s, kt, t, t0, hh, tabh, mloc);
#pragma unroll
          for (int i = 0; i < 16; ++i) s[i] = (s[i] > -1e29f) ? ex2(s[i] - m) * inv : 0.f;
          const float G00 = s[0] + s[1] + s[2] + s[3], G01 = s[4] + s[5] + s[6] + s[7];
          const float G10 = s[8] + s[9] + s[10] + s[11], G11 = s[12] + s[13] + s[14] + s[15];
          const float pe0 = SHXF(s[7], 32), pe1 = SHXF(s[15], 32);
          const float X0 = hh ? pe0 : carry;
          const float X1 = hh ? pe1 : pe0;
          float* sp = scw + (8 * kt + 2 * hh) * 32 + l31;
          sp[0] += 2.f * G00 - s[3] + X0;
          sp[32] += 2.f * G01 - s[7] + s[3];
          sp[4 * 32] += 2.f * G10 - s[11] + X1;
          sp[5 * 32] += 2.f * G11 - s[15] + s[11];
          carry = pe1;
#pragma unroll
          for (int st = 0; st < 2; ++st) {
            bf16x8 pf = pack8(s, st);
#pragma unroll
            for (int et = 0; et < 2; ++et) O[et] = MFMA32(vf[st * 2 + et], pf, O[et]);
          }
        }
      }
      const float g0 = sigmoidf_(bf2f(proj[tok * EIN + C_GATE + head * 3 + 0]));
      float* pp = part + (tok * 8 + head) * 64;
#pragma unroll
      for (int et = 0; et < 2; ++et)
#pragma unroll
        for (int gq = 0; gq < 4; ++gq) {
          float4 r; r.x = g0 * O[et][4 * gq]; r.y = g0 * O[et][4 * gq + 1]; r.z = g0 * O[et][4 * gq + 2]; r.w = g0 * O[et][4 * gq + 3];
          *(float4*)(pp + et * 32 + 8 * gq + 4 * hh) = r;
        }
    }
    {
      const int cb = t >> 6;
#pragma unroll 1
      for (int r = 0; r < 64; ++r) {
        const int j = 4 * (r >> 1) + (r & 1) + 2 * hh;
        const bool forced = (j == 0) | (j == cb) | (j == cb - 1);
        const float v = scw[j * 32 + l31];
        scw[j * 32 + l31] = forced ? 1e9f : (j <= cb ? v : -1e9f);
      }
      unsigned mk0 = 0u, mk1 = 0u, mk2 = 0u, mk3 = 0u;
#pragma unroll 1
      for (int rd = 0; rd < 16; ++rd) {
        float bv = -INFINITY; int bj = 255;
#pragma unroll 4
        for (int r = 0; r < 64; ++r) {
          const int j = 4 * (r >> 1) + (r & 1) + 2 * hh;
          const float v = scw[j * 32 + l31];
          if (v > bv) { bv = v; bj = j; }
        }
        const float ov = SHXF(bv, 32); const int oj = SHXI(bj, 32);
        const bool other = (ov > bv) || (ov == bv && oj < bj);
        const int wj = other ? oj : bj;
        if (((wj >> 1) & 1) == hh) scw[wj * 32 + l31] = -3e38f;
        const unsigned bit = 1u << (wj & 31); const int wd = wj >> 5;
        mk0 |= wd == 0 ? bit : 0u; mk1 |= wd == 1 ? bit : 0u; mk2 |= wd == 2 ? bit : 0u; mk3 |= wd == 3 ? bit : 0u;
      }
      if (hh == 0) *(u32x4*)(selL + l31 * 16) = (u32x4){mk0, mk1, mk2, mk3};
    }
    {
      const int s_lo = t0 >= 512 ? t0 - 512 : 0;
      const int nwt = (t0 + 32 - s_lo) >> 5;
#pragma unroll 1
      for (int hp = 0; hp < 4; ++hp) {
        const int head = g * 4 + hp;
        const float* tabh = tab + head * 128;
        bf16x8 qf[4];
#pragma unroll
        for (int ks = 0; ks < 4; ++ks) qf[ks] = ldg8(proj + tok * EIN + C_NQ + head * 64 + ks * 16 + hh * 8);
        f32x16 O[2]; O[0] = zero16(); O[1] = zero16();
        float m = NEGB, l = 0.f;
        bf16x8 kf[4];
        const unsigned kwo = (unsigned)((b * SEQ + s_lo + pr) * EIN + C_KW + g * 64 + hh * 8);
        const unsigned vwo = (unsigned)(((b * 2 + g) * 64 + l31) * SEQ + s_lo + hh * 8);
#pragma unroll
        for (int ks = 0; ks < 4; ++ks) kf[ks] = ldg8(proj + kwo + ks * 16);
#pragma unroll 1
        for (int wt = 0; wt < nwt; ++wt) {
          const int s0 = s_lo + wt * 32;
          bf16x8 vf[4];
#pragma unroll
          for (int st = 0; st < 2; ++st)
#pragma unroll
            for (int et = 0; et < 2; ++et) vf[st * 2 + et] = ldg8(vwT + vwo + (unsigned)(et * 32 * SEQ + wt * 32 + st * 16));
          f32x16 s = zero16();
#pragma unroll
          for (int ks = 0; ks < 4; ++ks) s = MFMA32(kf[ks], qf[ks], s);
          {
            const int wn_ = wt + 1 < nwt ? wt + 1 : wt;
#pragma unroll
            for (int ks = 0; ks < 4; ++ks) kf[ks] = ldg8(proj + kwo + (unsigned)(wn_ * 32 * EIN + ks * 16));
          }
          float mloc = NEGB;
          const bool full = (s0 + 31 <= t0) && (t0 + 31 - s0 < 512);
          if (full && (t0 - (s0 + 31) >= 127)) {
            const float bf = tabh[127];
#pragma unroll
            for (int i = 0; i < 16; ++i) { float z = fmaf(s[i], C1, bf); s[i] = z; mloc = fmaxf(mloc, z); }
          } else {
#pragma unroll
            for (int i = 0; i < 16; ++i) {
              int key = s0 + (i & 7) + 8 * hh + 16 * (i >> 3);
              int dw = t - key; int dd = dw < 0 ? 0 : (dw > 127 ? 127 : dw);
              float z = (dw >= 0 && dw < 512) ? fmaf(s[i], C1, tabh[dd]) : NEGB;
              s[i] = z; mloc = fmaxf(mloc, z);
            }
          }
          mloc = red_max32(mloc);
          const float mn = fmaxf(m, mloc);
          const float alpha = ex2(m - mn);
          float ls = 0.f;
#pragma unroll
          for (int i = 0; i < 16; ++i) { float p = (s[i] > -1e29f) ? ex2(s[i] - mn) : 0.f; s[i] = p; ls += p; }
          l = l * alpha + ls; m = mn;
#pragma unroll
          for (int et = 0; et < 2; ++et)
#pragma unroll
            for (int i = 0; i < 16; ++i) O[et][i] *= alpha;
#pragma unroll
          for (int st = 0; st < 2; ++st) {
            bf16x8 pf = pack8(s, st);
#pragma unroll
            for (int et = 0; et < 2; ++et) O[et] = MFMA32(vf[st * 2 + et], pf, O[et]);
          }
        }
        const float lt = red_sum32(l);
        const float g2 = sigmoidf_(bf2f(proj[tok * EIN + C_GATE + head * 3 + 2])) / lt;
        float* pp = part + (tok * 8 + head) * 64;
#pragma unroll
        for (int et = 0; et < 2; ++et)
#pragma unroll
          for (int gq = 0; gq < 4; ++gq) {
            float4 r = *(float4*)(pp + et * 32 + 8 * gq + 4 * hh);
            r.x += g2 * O[et][4 * gq]; r.y += g2 * O[et][4 * gq + 1]; r.z += g2 * O[et][4 * gq + 2]; r.w += g2 * O[et][4 * gq + 3];
            *(float4*)(pp + et * 32 + 8 * gq + 4 * hh) = r;
          }
      }
    }
    __builtin_amdgcn_fence(__ATOMIC_SEQ_CST, "workgroup");
    {
      const int col = lane & 15, q4 = lane >> 4;
      const int qq = col >> 2, hcol = g * 4 + (col & 3);
      const float* tabc = tab + hcol * 128;
      const int rk = 8 * (col >> 2) + (col & 3);
      const unsigned kbase = (unsigned)((b * SEQ + rk) * EIN + C_KS + g * 64 + q4 * 8);
      const unsigned vbase = (unsigned)(((b * 2 + g) * 64 + col) * SEQ + q4 * 8);
#pragma unroll 1
      for (int grp_ = 0; grp_ < 8 * REP_C; ++grp_) {
        const int grp = grp_ & 7;
        const int tq = t0 + grp * 4 + qq;
        const int tmin = t0 + grp * 4, tmax = tmin + 3;
        const size_t tokq = (size_t)b * SEQ + tq;
        const u32x4 mym = *(const u32x4*)(selL + (grp * 4 + qq) * 16);
        unsigned u0, u1, u2, u3;
        {
          const u32x4 a0 = *(const u32x4*)(selL + (grp * 4 + 0) * 16), a1 = *(const u32x4*)(selL + (grp * 4 + 1) * 16);
          const u32x4 a2 = *(const u32x4*)(selL + (grp * 4 + 2) * 16), a3 = *(const u32x4*)(selL + (grp * 4 + 3) * 16);
          const u32x4 uu = a0 | a1 | a2 | a3;
          u0 = __builtin_amdgcn_readfirstlane(uu.x); u1 = __builtin_amdgcn_readfirstlane(uu.y);
          u2 = __builtin_amdgcn_readfirstlane(uu.z); u3 = __builtin_amdgcn_readfirstlane(uu.w);
          const int cbm = tmax >> 6;
          if (cbm < 31) { u0 &= (2u << cbm) - 1u; u1 = 0u; u2 = 0u; u3 = 0u; }
          else if (cbm < 63) { u1 &= (2u << (cbm - 32)) - 1u; u2 = 0u; u3 = 0u; }
          else if (cbm < 95) { u2 &= (2u << (cbm - 64)) - 1u; u3 = 0u; }
          else if (cbm < 127) { u3 &= (2u << (cbm - 96)) - 1u; }
        }
        auto next_blk = [&]() -> int {
          if (u0) { int bq = __builtin_ctz(u0); u0 &= u0 - 1u; return bq; }
          if (u1) { int bq = __builtin_ctz(u1); u1 &= u1 - 1u; return 32 + bq; }
          if (u2) { int bq = __builtin_ctz(u2); u2 &= u2 - 1u; return 64 + bq; }
          if (u3) { int bq = __builtin_ctz(u3); u3 &= u3 - 1u; return 96 + bq; }
          return -1;
        };
        bf16x8 qf[2];
#pragma unroll
        for (int st = 0; st < 2; ++st) qf[st] = ldg8(proj + tokq * EIN + C_NQ + hcol * 64 + st * 32 + q4 * 8);
        f32x4 O[4];
#pragma unroll
        for (int e = 0; e < 4; ++e) O[e] = (f32x4){0.f, 0.f, 0.f, 0.f};
        float m = NEGB, l = 0.f;
        bf16x8 kf[8], vf[8];
        auto load_k = [&](int jb) {
          const unsigned ko = kbase + (unsigned)(jb * 64 * EIN);
#pragma unroll
          for (int hf = 0; hf < 2; ++hf)
#pragma unroll
            for (int tl = 0; tl < 2; ++tl) {
              kf[(hf * 2 + tl) * 2 + 0] = ldg8(proj + ko + (unsigned)((hf * 32 + 4 * tl) * EIN));
              kf[(hf * 2 + tl) * 2 + 1] = ldg8(proj + ko + (unsigned)((hf * 32 + 4 * tl) * EIN + 32));
            }
        };
        auto load_v = [&](int jb) {
          const unsigned vo = vbase + (unsigned)(jb * 64);
#pragma unroll
          for (int hf = 0; hf < 2; ++hf)
#pragma unroll
            for (int e = 0; e < 4; ++e) vf[hf * 4 + e] = ldg8(vsT + vo + (unsigned)(e * 16 * SEQ + hf * 32));
        };
        int jb = next_blk();
        if (jb >= 0) { load_k(jb); load_v(jb); }
        while (jb >= 0) {
          const int base = jb * 64;
          const unsigned mw = jb < 32 ? mym.x : (jb < 64 ? mym.y : (jb < 96 ? mym.z : mym.w));
          const bool member = (mw >> (jb & 31)) & 1u;
          f32x4 a[2][2];
#pragma unroll
          for (int hf = 0; hf < 2; ++hf)
#pragma unroll
            for (int tl = 0; tl < 2; ++tl) {
              f32x4 acc = (f32x4){0.f, 0.f, 0.f, 0.f};
              acc = MFMA16(kf[(hf * 2 + tl) * 2 + 0], qf[0], acc);
              acc = MFMA16(kf[(hf * 2 + tl) * 2 + 1], qf[1], acc);
              a[hf][tl] = acc;
            }
          const int jn = next_blk();
          if (jn >= 0) load_k(jn);
          float mloc = NEGB;
          if (tmin - (base + 63) >= 127) {
            const float bf = tabc[127];
#pragma unroll
            for (int hf = 0; hf < 2; ++hf)
#pragma unroll
              for (int tl = 0; tl < 2; ++tl)
#pragma unroll
                for (int j = 0; j < 4; ++j) { float z = member ? fmaf(a[hf][tl][j], C1, bf) : NEGB; a[hf][tl][j] = z; mloc = fmaxf(mloc, z); }
          } else {
#pragma unroll
            for (int hf = 0; hf < 2; ++hf)
#pragma unroll
              for (int tl = 0; tl < 2; ++tl)
#pragma unroll
                for (int j = 0; j < 4; ++j) {
                  int key = base + hf * 32 + 8 * q4 + 4 * tl + j;
                  int dist = tq - key; int dd = dist < 0 ? 0 : (dist > 127 ? 127 : dist);
                  float z = (dist < 0 || !member) ? NEGB : fmaf(a[hf][tl][j], C1, tabc[dd]);
                  a[hf][tl][j] = z; mloc = fmaxf(mloc, z);
                }
          }
          mloc = red_max16(mloc);
          mloc = red_max32(mloc);
          const float mn = fmaxf(m, mloc);
          const float alpha = ex2(m - mn);
          float ls = 0.f;
#pragma unroll
          for (int hf = 0; hf < 2; ++hf)
#pragma unroll
            for (int tl = 0; tl < 2; ++tl)
#pragma unroll
              for (int j = 0; j < 4; ++j) { float p = (a[hf][tl][j] > -1e29f) ? ex2(a[hf][tl][j] - mn) : 0.f; a[hf][tl][j] = p; ls += p; }
          l = l * alpha + ls; m = mn;
#pragma unroll
          for (int e = 0; e < 4; ++e) O[e] *= alpha;
#pragma unroll
          for (int hf = 0; hf < 2; ++hf) {
            u32x4 u; u.x = pk2(a[hf][0][0], a[hf][0][1]); u.y = pk2(a[hf][0][2], a[hf][0][3]); u.z = pk2(a[hf][1][0], a[hf][1][1]); u.w = pk2(a[hf][1][2], a[hf][1][3]);
            const bf16x8 pf = __builtin_bit_cast(bf16x8, u);
#pragma unroll
            for (int e = 0; e < 4; ++e) O[e] = MFMA16(vf[hf * 4 + e], pf, O[e]);
          }
          if (jn >= 0) load_v(jn);
          jb = jn;
        }
        l = red_sum16(l);
        l = red_sum32(l);
        {
          const float g1 = sigmoidf_(bf2f(proj[tokq * EIN + C_GATE + hcol * 3 + 1])) / l;
          const float* pp = part + (tokq * 8 + hcol) * 64;
          bf16_t* op = ao + tokq * DM + hcol * 64;
#pragma unroll
          for (int e = 0; e < 4; ++e) {
            float4 pv = *(const float4*)(pp + e * 16 + 4 * q4);
            *(u32x2*)(op + e * 16 + 4 * q4) = pk4(pv.x + g1 * O[e][0], pv.y + g1 * O[e][1], pv.z + g1 * O[e][2], pv.w + g1 * O[e][3]);
          }
        }
      }
    }
  }
}

DI void ckv_norm_phase(KParamPtr P, int wv, int i2) {
  unsigned char* wsq = opqp(P->ws);
  const bf16_t* proj = (const bf16_t*)(wsq + OFF_U + U_PROJ);
  bf16_t* ckv = (bf16_t*)(wsq + OFF_MISC + 12 * MiB);
  const float* gn = P->in[15] + (size_t)i2 * 128;
  const int tid_ = tid_of(wv); const int lane = tid_ & 63, wave = tid_ >> 6;
  const int nw = gridDim.x * 8, gw = blockIdx.x * 8 + wave;
  const float g0 = gn[2 * lane], g1 = gn[2 * lane + 1];
  for (int tk = gw; tk < NTOK; tk += nw) {
    unsigned u = *(const unsigned*)(proj + (size_t)tk * EIN + C_DKV + 2 * lane);
    float a = __uint_as_float(u << 16), c = __uint_as_float(u & 0xffff0000u);
    float ss = wave_sum(a * a + c * c, lane);
    float rs = rsqrtf(ss * (1.f / 128.f) + 1e-5f);
    *(unsigned*)(ckv + (size_t)tk * 128 + 2 * lane) = pk2(a * rs * g0, c * rs * g1);
  }
}

DI unsigned fkey(float f) { unsigned u = __float_as_uint(f); return (u & 0x80000000u) ? ~u : (u | 0x80000000u); }

DI void dsa_index_phase(unsigned char* lds, KParamPtr P, int wv) {
  unsigned char* wsq = opqp(P->ws);
  float* sc = (float*)(lds + LDS_WORK);
  unsigned* hist = (unsigned*)(lds + LDS_WORK + 131072);
  const bf16_t* proj = (const bf16_t*)(wsq + OFF_U + U_PROJ);
  unsigned short* idx = (unsigned short*)(wsq + OFF_U + U_IDX);
  const int tid = tid_of(wv), lane = tid & 63, wave = tid >> 6, l31 = lane & 31, hh = lane >> 5;
  const int rhead = (l31 & 3) + 4 * ((l31 >> 3) & 1), ru = 2 * ((l31 >> 2) & 1) + (l31 >> 4);
  const unsigned long long lt_mask = (lane == 0) ? 0ull : (~0ull >> (64 - lane));
  __syncthreads();
  if (wave < 4) { const unsigned z0 = (unsigned)opq(0); unsigned* hz = hist + wave * 256 + lane * 4; hz[0] = z0; hz[1] = z0; hz[2] = z0; hz[3] = z0; }
  lds_barrier();
  for (int item = blockIdx.x; item < 8192; item += gridDim.x) {
    const int b = (item & 7) >> 1, t0 = (((item >> 3) << 1) + (item & 1)) * 4;
    const int ntile = (t0 + 4 + 31) >> 5;
    bf16x8 af[4];
    const bf16_t* iqp = proj + (size_t)(b * SEQ + t0 + ru) * EIN + C_IQ + rhead * 64 + hh * 8;
#pragma unroll
    for (int ks = 0; ks < 4; ++ks) af[ks] = ldg8(iqp + ks * 16);
    float w[16];
#pragma unroll
    for (int i = 0; i < 16; ++i) {
      const int uq = 2 * hh + (i >> 3), hd = (i & 3) + 4 * ((i >> 2) & 1);
      w[i] = bf2f(proj[(size_t)(b * SEQ + t0 + uq) * EIN + C_IW + hd]) * 0.04419417382415922f;
    }
#pragma unroll 1
    for (int kt0 = wave * 4; kt0 < ntile; kt0 += 32) {
      bf16x8 kf[4][4];
      const unsigned ko = (unsigned)((b * SEQ + kt0 * 32 + l31) * EIN + C_IK + hh * 8);
#pragma unroll
      for (int u = 0; u < 4; ++u)
#pragma unroll
        for (int ks = 0; ks < 4; ++ks) kf[u][ks] = ldg8(proj + ko + (unsigned)(u * 32 * EIN + ks * 16));
#pragma unroll
      for (int u = 0; u < 4; ++u) {
        f32x16 acc = zero16();
#pragma unroll
        for (int ks = 0; ks < 4; ++ks) acc = MFMA32(af[ks], kf[u][ks], acc);
        float s0 = 0.f, s1 = 0.f;
#pragma unroll
        for (int i = 0; i < 8; ++i) { s0 += w[i] * fmaxf(acc[i], 0.f); s1 += w[8 + i] * fmaxf(acc[8 + i], 0.f); }
        const int key = (kt0 + u) * 32 + l31;
        s0 += 0.f; s1 += 0.f;
        sc[(2 * hh) * 8192 + key] = s0;
        sc[(2 * hh + 1) * 8192 + key] = s1;
        if (key <= t0 + 2 * hh) atomicAdd(hist + (2 * hh) * 256 + (fkey(s0) >> 24), 1u);
        if (key <= t0 + 2 * hh + 1) atomicAdd(hist + (2 * hh + 1) * 256 + (fkey(s1) >> 24), 1u);
      }
    }
    const int qs = wave & 3, half = wave >> 2;
    const int n = t0 + qs + 1;
    const float* scq = sc + qs * 8192;
    unsigned short* out = idx + (size_t)(b * SEQ + t0 + qs) * 256;
    unsigned* H0 = hist + qs * 256;
    unsigned* H1 = hist + 1024 + qs * 256;
    const bool big = n > 256;
    if (!big && half == 0) { for (int i = lane; i < 256; i += 64) out[i] = (unsigned short)(i < n ? i : 0xFFFF); }
    lds_barrier();
    unsigned prefix = 0; int Kr = 256;
#pragma unroll 1
    for (int pass = 0; pass < 4; ++pass) {
      unsigned* Hc = (pass & 1) ? H1 : H0;
      unsigned* Hn = (pass & 1) ? H0 : H1;
      const int shift = 24 - 8 * pass;
      if (big && pass > 0) {
        f32x4 vnx = *(const f32x4*)(scq + half * 256 + lane * 4);
        for (int c = half; c * 256 < n; c += 2) {
          const int i0 = c * 256 + lane * 4;
          const f32x4 v = vnx;
          { const int cn = (c + 2) * 256 < n ? c + 2 : c; vnx = *(const f32x4*)(scq + cn * 256 + lane * 4); }
#pragma unroll
          for (int e = 0; e < 4; ++e) {
            const unsigned u = fkey(v[e]);
            const bool match = (i0 + e < n) && ((pass == 0) || ((u >> ((shift + 8) & 31)) == prefix));
            if (match) atomicAdd(Hc + ((u >> shift) & 255u), 1u);
          }
        }
      }
      lds_barrier();
      if (half == 0) { const unsigned z0 = (unsigned)opq(0); Hn[lane * 4] = z0; Hn[lane * 4 + 1] = z0; Hn[lane * 4 + 2] = z0; Hn[lane * 4 + 3] = z0; }
      if (big) {
        const u32x4 hv = *(const u32x4*)(Hc + lane * 4);
        const int sloc = (int)(hv.x + hv.y + hv.z + hv.w);
        int incl = sloc;
#pragma unroll
        for (int off = 1; off < 64; off <<= 1) { int v = bperm_i(lane + off, incl); if (lane + off < 64) incl += v; }
        int cum = incl - sloc;
        bool found = false; int d = 0, nK = 0;
#pragma unroll
        for (int bq = 3; bq >= 0; --bq) {
          const int hbq = (int)hv[bq];
          if (!found && cum < Kr && Kr <= cum + hbq) { found = true; d = lane * 4 + bq; nK = Kr - cum; }
          cum += hbq;
        }
        const unsigned long long mk = __ballot(found);
        const int src = __ffsll((long long)mk) - 1;
        d = bperm_i(src, d); Kr = bperm_i(src, nK);
        prefix = (prefix << 8) | (unsigned)d;
      }
      lds_barrier();
    }
    if (big && half == 0) {
      const unsigned T = prefix;
      int cg_ = 0, ce_ = 0;
      f32x4 vnx = *(const f32x4*)(scq + lane * 4);
      for (int c = 0; c * 256 < n; ++c) {
        const int i0 = c * 256 + lane * 4;
        const f32x4 v = vnx;
        { const int cn = (c + 1) * 256 < n ? c + 1 : c; vnx = *(const f32x4*)(scq + cn * 256 + lane * 4); }
        bool gt[4], eq[4]; unsigned long long mg[4], me[4];
#pragma unroll
        for (int e = 0; e < 4; ++e) {
          const unsigned u = fkey(v[e]);
          gt[e] = (i0 + e < n) && (u > T); eq[e] = (i0 + e < n) && (u == T);
          mg[e] = __ballot(gt[e]); me[e] = __ballot(eq[e]);
        }
        int pg = cg_;
#pragma unroll
        for (int e = 0; e < 4; ++e) {
          if (gt[e]) out[pg + __popcll(mg[e] & lt_mask)] = (unsigned short)(i0 + e);
          pg += __popcll(mg[e]);
        }
        cg_ = pg;
        if ((me[0] | me[1] | me[2] | me[3]) != 0ull) {
          int below = ce_;
#pragma unroll
          for (int e = 0; e < 4; ++e) below += __popcll(me[e] & lt_mask);
          int own = 0;
#pragma unroll
          for (int e = 0; e < 4; ++e) {
            const int rank = below + own;
            if (eq[e] && rank < Kr) out[(256 - Kr) + rank] = (unsigned short)(i0 + e);
            own += eq[e] ? 1 : 0;
          }
#pragma unroll
          for (int e = 0; e < 4; ++e) ce_ += __popcll(me[e]);
        }
      }
    }
    lds_barrier();
  }
}

DI void dsa_sparse_phase(unsigned char* lds, KParamPtr P, int wv) {
  unsigned char* wsq = opqp(P->ws);
  const float* tab = (const float*)(lds + LDS_TAB);
  const int tid = tid_of(wv), lane = tid & 63, wave = tid >> 6;
  bf16_t* gbuf = (bf16_t*)(lds + LDS_WORK + 4096 + wave * 9216);
  unsigned short* idL = (unsigned short*)(lds + LDS_WORK + 4096 + wave * 9216 + 8704);
  __syncthreads();
  bf16_t* qlat = (bf16_t*)(wsq + OFF_U + U_QLAT);
  const bf16_t* ckv = (const bf16_t*)(wsq + OFF_MISC + 12 * MiB);
  const unsigned short* idx = (const unsigned short*)(wsq + OFF_U + U_IDX);
  const int nw = gridDim.x * 8, gw = blockIdx.x * 8 + wave;
  const int col = lane & 15, q4 = lane >> 4;
  const float* tabc = tab + (8 + (col & 7)) * 128;
  const int rk = 8 * (col >> 2) + (col & 3);
  const int grow = lane >> 4, gc16 = lane & 15;
  const bool dealt = (gridDim.x == 256);
  const int g_lo = dealt ? (int)kSpStart[blockIdx.x >> 3] : 0, g_n = dealt ? (int)kSpStart[(blockIdx.x >> 3) + 1] - g_lo : 0;
  auto qmap = [&](int qi) -> int {
    const int w8 = qi & 7, blk = (qi >> 3) & 255, rnd = qi >> 11, x = blk & 7;
    const int gidx = dealt ? g_lo + rnd : rnd * 32 + (blk >> 3);
    return ((x >> 1) << 13) + (((gidx << 1) + (x & 1)) << 3) + w8;
  };
  const int qi_end = dealt ? gw + g_n * nw : NTOK;
  u32x2 idn = (gw < qi_end) ? *(const u32x2*)(idx + (size_t)qmap(gw) * 256 + lane * 4) : (u32x2){0u, 0u};
  for (int qi = gw; qi < qi_end; qi += nw) {
    const int q = qmap(qi);
    const int b = q >> 13, tq = q & (SEQ - 1);
    asm volatile("" ::: "memory");
    *(u32x2*)(idL + lane * 4) = idn;
    asm volatile("" ::: "memory");
    {
      const int qn = qmap(qi + nw < qi_end ? qi + nw : qi);
      idn = *(const u32x2*)(idx + (size_t)qn * 256 + lane * 4);
    }
    bf16x8 qf[4];
#pragma unroll
    for (int st = 0; st < 4; ++st) qf[st] = (col < 8) ? ldg8(qlat + (size_t)q * DM + col * 128 + st * 32 + q4 * 8) : zero8();
    f32x4 O[8];
#pragma unroll
    for (int e = 0; e < 8; ++e) O[e] = (f32x4){0.f, 0.f, 0.f, 0.f};
    float m = NEGB, l = 0.f;
    u32x4 gr[8];
    const unsigned cb = (unsigned)(b * SEQ) * 128u + (unsigned)gc16 * 8u;
#pragma unroll
    for (int i = 0; i < 8; ++i) {
      int id = idL[grow + 4 * i]; id = id > SEQ - 1 ? SEQ - 1 : id;
      gr[i] = *(const u32x4*)(ckv + cb + (unsigned)id * 128u);
    }
#pragma unroll 1
    for (int ch = 0; ch < 8; ++ch) {
#pragma unroll
      for (int i = 0; i < 8; ++i) *(u32x4*)(gbuf + (grow + 4 * i) * 136 + gc16 * 8) = gr[i];
      asm volatile("" ::: "memory");
      {
        const int cn = ch < 7 ? ch + 1 : ch;
#pragma unroll
        for (int i = 0; i < 8; ++i) {
          int id = idL[cn * 32 + grow + 4 * i]; id = id > SEQ - 1 ? SEQ - 1 : id;
          gr[i] = *(const u32x4*)(ckv + cb + (unsigned)id * 128u);
        }
      }
      f32x4 a[2];
#pragma unroll
      for (int tl = 0; tl < 2; ++tl) {
        f32x4 acc = (f32x4){0.f, 0.f, 0.f, 0.f};
#pragma unroll
        for (int st = 0; st < 4; ++st) acc = MFMA16(*(const bf16x8*)(gbuf + (rk + 4 * tl) * 136 + st * 32 + q4 * 8), qf[st], acc);
        a[tl] = acc;
      }
      float mloc = NEGB;
#pragma unroll
      for (int tl = 0; tl < 2; ++tl)
#pragma unroll
        for (int j = 0; j < 4; ++j) {
          const int id = idL[ch * 32 + 8 * q4 + 4 * tl + j];
          const int dist = tq - id; const int dd = dist < 0 ? 0 : (dist > 127 ? 127 : dist);
          const float tb = tabc[dd];
          float z = fmaf(a[tl][j], C1, tb); z = dist < 0 ? NEGB : z;
          a[tl][j] = z; mloc = fmaxf(mloc, z);
        }
      mloc = red_max16(mloc);
      mloc = red_max32(mloc);
      const float mn = fmaxf(m, mloc);
      const float alpha = ex2(m - mn);
      float ls = 0.f;
#pragma unroll
      for (int tl = 0; tl < 2; ++tl)
#pragma unroll
        for (int j = 0; j < 4; ++j) { float p = (a[tl][j] > -1e29f) ? ex2(a[tl][j] - mn) : 0.f; a[tl][j] = p; ls += p; }
      l = l * alpha + ls; m = mn;
#pragma unroll
      for (int e = 0; e < 8; ++e) O[e] *= alpha;
      u32x4 u; u.x = pk2(a[0][0], a[0][1]); u.y = pk2(a[0][2], a[0][3]); u.z = pk2(a[1][0], a[1][1]); u.w = pk2(a[1][2], a[1][3]);
      const bf16x8 pf = __builtin_bit_cast(bf16x8, u);
#pragma unroll
      for (int rt = 0; rt < 8; ++rt) {
        const bf16_t* gp = gbuf + (8 * q4) * 136 + rt * 16 + col;
        u32x4 v;
        v.x = (unsigned)gp[0] | ((unsigned)gp[136] << 16); v.y = (unsigned)gp[2 * 136] | ((unsigned)gp[3 * 136] << 16);
        v.z = (unsigned)gp[4 * 136] | ((unsigned)gp[5 * 136] << 16); v.w = (unsigned)gp[6 * 136] | ((unsigned)gp[7 * 136] << 16);
        O[rt] = MFMA16(__builtin_bit_cast(bf16x8, v), pf, O[rt]);
      }
      asm volatile("" ::: "memory");
    }
    l = red_sum16(l);
    l = red_sum32(l);
    if (col < 8) {
      const float inv = 1.f / l;
      bf16_t* op = qlat + (size_t)q * DM + col * 128;
#pragma unroll
      for (int rt = 0; rt < 8; ++rt) *(u32x2*)(op + rt * 16 + 4 * q4) = pk4(O[rt][0] * inv, O[rt][1] * inv, O[rt][2] * inv, O[rt][3] * inv);
    }
  }
}

DI void gbar(unsigned* cnt, unsigned& target, int tid) {
  asm volatile("s_waitcnt vmcnt(0)" ::: "memory");
  __syncthreads();
  target += gridDim.x;
  if (tid == 0) {
    __builtin_amdgcn_fence(__ATOMIC_RELEASE, "agent");
    asm volatile("s_waitcnt vmcnt(0)" ::: "memory");
    __hip_atomic_fetch_add(cnt, 1u, __ATOMIC_RELAXED, __HIP_MEMORY_SCOPE_AGENT);
    while (__hip_atomic_load(cnt, __ATOMIC_RELAXED, __HIP_MEMORY_SCOPE_AGENT) < target) __builtin_amdgcn_s_sleep(1);
    __builtin_amdgcn_fence(__ATOMIC_ACQUIRE, "agent");
    asm volatile("s_waitcnt vmcnt(0)" ::: "memory");
  }
  __syncthreads();
}

__global__ void __launch_bounds__(NTHREADS) mega(Params P0) {
  extern __shared__ __attribute__((aligned(16))) unsigned char lds[];
  cg::grid_group grid = cg::this_grid();
#define P kparams()
  const int wv = __builtin_amdgcn_readfirstlane((int)(threadIdx.x >> 6));
  const int tid = tid_of(wv);
  {
    float* tab = (float*)(lds + LDS_TAB);
    for (int i = tid; i < 16 * 128; i += NTHREADS) { int col = i >> 7, d = i & 127; tab[i] = P->in[2][(int)kBucket[d] * 16 + col] * LOG2E; }
    __syncthreads();
  }
  const float* ada = (const float*)(opqp(P->ws) + OFF_MISC + MS_ADA);

  unsigned* barp = (unsigned*)(opqp(P->ws) + OFF_BAR);
  unsigned bar_target = 0;
  ada_partial_phase(lds, P, wv);
  wprep_phase(lds, P, wv, 0);
  grid.sync();
  ada_reduce_phase(P, wv);
  gbar(barp, bar_target, tid_of(wv));
  for (int rp = 0; rp < REP_SYNC; ++rp) gbar(barp, bar_target, tid_of(wv));
  ln_mod_phase(P, wv, P->in[0], nullptr, nullptr, nullptr, ada, ada + 1024, false, true);
  gbar(barp, bar_target, tid_of(wv));

#pragma unroll 1
  for (int l = 0; l < 4; ++l) {
    const int i2 = l >> 1;
    unsigned char* ws = opqp(P->ws);
    bf16_t* hb = (bf16_t*)(ws + OFF_HB);
    bf16_t* ao = (bf16_t*)(ws + OFF_AO);
    unsigned char* U = ws + OFF_U;
    unsigned char* WT = ws + OFF_WT;
    const float* ada = (const float*)(ws + OFF_MISC + MS_ADA);
    const float* adal = ada + (size_t)l * 4 * 6144;
    const float* xin = (l == 0) ? P->in[0] : P->out;
    if ((l & 1) == 0) {
      bf16_t* proj = (bf16_t*)(U + U_PROJ);
      bf16_t* qlat = (bf16_t*)(U + U_QLAT);
      bf16_t* hid = (bf16_t*)(ws + OFF_MISC + MS_HID);
      const float* cbias = (const float*)(ws + OFF_MISC + MS_CB);
      for (int rp = 0; rp < REP_GEMM; ++rp) {
      gemm_run(lds, wv, APlain{hb, DM}, (const bf16_t*)(WT + WT_IN), DM, NTOK, EIN, DM, EpiEvenProj{proj, (bf16_t*)(U + U_VST), (bf16_t*)(U + U_VWT)}, 0);
      gbar(barp, bar_target, tid_of(wv)); }
#pragma unroll 1
      for (int kv = 0; kv < 2; ++kv)
        gemm_run(lds, wv, ACmp{proj, kv ? C_VC : C_KC}, (const bf16_t*)(WT + WT_CW1) + kv * 256 * 2048, 2048, 4096, 256, 2048, EpiCmp1{cbias + kv * 256, hid + kv * 4096 * 256}, 16 * kv);
#pragma unroll 1
      for (int h = 0; h < 8; ++h)
        gemm_run(lds, wv, APlain{proj + C_DQ + h * 64, EIN}, (const bf16_t*)(WT + WT_UK) + h * 64, 512, NTOK, 128, 64, EpiRow{qlat + h * 128, DM}, 32 + h * 128);
      ckv_norm_phase(P, wv, i2);
      gbar(barp, bar_target, tid_of(wv));
#pragma unroll 1
      for (int kv = 0; kv < 2; ++kv)
        gemm_run(lds, wv, APlain{hid + kv * 4096 * 256, 256}, (const bf16_t*)(WT + WT_CW2) + kv * 64 * 256, 256, 4096, 64, 256, EpiCmp2{(bf16_t*)(ws + OFF_MISC + MS_KC), (bf16_t*)(ws + OFF_MISC + MS_VCT), kv}, 16 * kv);
      for (int rp = 0; rp < REP_IDX; ++rp) dsa_index_phase(lds, P, wv);
      gbar(barp, bar_target, tid_of(wv));
      for (int rp = 0; rp < REP_NSA; ++rp) nsa_phase(lds, P, wv);
      dsa_sparse_phase(lds, P, wv);
      gbar(barp, bar_target, tid_of(wv));
#pragma unroll 1
      for (int h = 0; h < 8; ++h)
        gemm_run(lds, wv, APlain{qlat + h * 128, DM}, (const bf16_t*)(WT + WT_UV) + h * 64 * 128, 128, NTOK, 64, 128, EpiRow{ao + 512 + h * 64, DM}, h * 128);
      gbar(barp, bar_target, tid_of(wv));
    } else {
      for (int rp = 0; rp < REP_GEMM; ++rp) {
      gemm_run(lds, wv, APlain{hb, DM}, (const bf16_t*)(WT + WT_IN), DM, NTOK, OIN, DM, EpiOddProj{(bf16_t*)(U + U_QK), (bf16_t*)(U + U_VT)}, 0);
      gbar(barp, bar_target, tid_of(wv)); }
      for (int rp = 0; rp < REP_DIFF; ++rp) {
      diff_attn_phase(lds, P, wv, l);
      gbar(barp, bar_target, tid_of(wv)); }
    }
    gemm_run(lds, wv, APlain{ao, DM}, (const bf16_t*)(WT + WT_OUT), DM, NTOK, DM, DM, EpiResid{xin, P->out, adal + 2048}, 0);
    gbar(barp, bar_target, tid_of(wv));
    ln_mod_phase(P, wv, P->out, P->out, P->in[5] + (size_t)(l * 2) * DM, P->in[6] + (size_t)(l * 2) * DM, adal + 3072, adal + 4096, true, true);
    gbar(barp, bar_target, tid_of(wv));
    for (int rp = 0; rp < REP_GEMM; ++rp) {
    gemm_run(lds, wv, APlain{hb, DM}, (const bf16_t*)(WT + WT_M1), DM, NTOK, DFF, DM, EpiSqRelu{(bf16_t*)U}, 0);
    gbar(barp, bar_target, tid_of(wv)); }
    gemm_run(lds, wv, APlain{(const bf16_t*)U, DFF}, (const bf16_t*)(WT + WT_M2), DFF, NTOK, DM, DFF, EpiResid{P->out, P->out, adal + 5120}, 0);
    gbar(barp, bar_target, tid_of(wv));
    ln_mod_phase(P, wv, P->out, P->out, P->in[5] + (size_t)(l * 2 + 1) * DM, P->in[6] + (size_t)(l * 2 + 1) * DM, adal + 4 * 6144, adal + 4 * 6144 + 1024, true, l < 3);
    if (l < 3) { wprep_phase(lds, P, wv, l + 1); gbar(barp, bar_target, tid_of(wv)); }
  }
}

#undef P
extern "C" void kernel_launch(void* const* d_in, const int* in_sizes, int n_in, void* d_out, int out_size, void* d_ws, size_t ws_size, hipStream_t stream) {
  static int grid_blocks = 0;
  if (grid_blocks == 0) {
    int dev = 0, cus = 0, per_cu = 0;
    (void)hipGetDevice(&dev);
    (void)hipDeviceGetAttribute(&cus, hipDeviceAttributeMultiprocessorCount, dev);
    if (hipFuncSetAttribute((const void*)mega, hipFuncAttributeMaxDynamicSharedMemorySize, LDS_BYTES) != hipSuccess) fprintf(stderr, "setattr failed\n");
    (void)hipOccupancyMaxActiveBlocksPerMultiprocessor(&per_cu, (const void*)mega, NTHREADS, LDS_BYTES);
    fprintf(stderr, "cus %d per_cu %d ws_size %zu n_in %d\n", cus, per_cu, ws_size, n_in);
    if (per_cu < 1 || n_in != 24 || ws_size < WS_NEED + 8 * MiB) { fprintf(stderr, "cannot launch\n"); grid_blocks = -1; }
    else grid_blocks = cus;
  }
  if (grid_blocks < 0) return;
  Params p{};
  for (int i = 0; i < 24; ++i) p.in[i] = (const float*)d_in[i];
  p.out = (float*)d_out; p.ws = (unsigned char*)d_ws;
  void* args[] = {&p};
  if (hipMemsetAsync((unsigned char*)d_ws + OFF_BAR, 0, 256, stream) != hipSuccess) fprintf(stderr, "memset failed\n");
  hipError_t e = hipLaunchCooperativeKernel((const void*)mega, dim3(grid_blocks), dim3(NTHREADS), args, LDS_BYTES, stream);
  if (e != hipSuccess) fprintf(stderr, "coop launch failed: %s\n", hipGetErrorString(e));
}
```

```cpp
#include <hip/hip_runtime.h>
#include <hip/hip_bf16.h>
#include <hip/hip_cooperative_groups.h>
#include <cstdio>
namespace cg = cooperative_groups;

#define DI __device__ __forceinline__
#define NTHREADS 512
#ifndef REP_C
#define REP_C 1
#endif
#ifndef REP_SYNC
#define REP_SYNC 0
#endif
#ifndef REP_GEMM
#define REP_GEMM 1
#endif
#ifndef REP_DIFF
#define REP_DIFF 1
#endif
#ifndef REP_NSA
#define REP_NSA 1
#endif
#ifndef REP_IDX
#define REP_IDX 1
#endif
#define LDS_BYTES (144 * 1024)

typedef unsigned short bf16_t;
typedef __attribute__((ext_vector_type(8))) short bf16x8;
typedef __attribute__((ext_vector_type(16))) float f32x16;
typedef __attribute__((ext_vector_type(4))) float f32x4;
typedef __attribute__((ext_vector_type(2))) float f32x2;
typedef __attribute__((ext_vector_type(2))) __bf16 bfx2;
typedef __attribute__((ext_vector_type(4))) unsigned u32x4;
typedef __attribute__((ext_vector_type(2))) unsigned u32x2;

#define MFMA32(a, b, c) __builtin_amdgcn_mfma_f32_32x32x16_bf16((a), (b), (c), 0, 0, 0)
#define MFMA16(a, b, c) __builtin_amdgcn_mfma_f32_16x16x32_bf16((a), (b), (c), 0, 0, 0)

constexpr int SEQ = 8192, NB = 4, DM = 1024, NTOK = NB * SEQ, DFF = 4096;
constexpr int EIN = 2528, OIN = 3072;
constexpr float ALPHA_C = 1.681792830507429f;
constexpr float LOG2E = 1.4426950408889634f;
constexpr float C1 = 0.125f * LOG2E;
constexpr float NEGB = -1e30f;
constexpr int C_NQ = 0, C_KC = 512, C_VC = 640, C_KS = 768, C_VS = 896, C_KW = 1024, C_VW = 1152, C_GATE = 1280, C_DQ = 1304, C_DKV = 1816, C_IQ = 1944, C_IK = 2456, C_IW = 2520;

constexpr size_t MiB = 1024 * 1024;
constexpr size_t OFF_HB = 0;
constexpr size_t OFF_AO = 64 * MiB;
constexpr size_t OFF_U = 128 * MiB;
constexpr size_t OFF_WT = 384 * MiB;
constexpr size_t OFF_MISC = 416 * MiB;
constexpr size_t OFF_BAR = 436 * MiB;
constexpr size_t WS_NEED = 440 * MiB;
constexpr size_t U_PROJ = 0;
constexpr size_t U_VST = 158 * MiB;
constexpr size_t U_VWT = 166 * MiB;
constexpr size_t U_QLAT = 174 * MiB;
constexpr size_t U_IDX = 238 * MiB;
constexpr size_t U_QK = 0;
constexpr size_t U_VT = 128 * MiB;
constexpr size_t WT_IN = 0, WT_OUT = 6 * MiB, WT_M1 = 8 * MiB, WT_M2 = 16 * MiB, WT_CW1 = 24 * MiB, WT_CW2 = 26 * MiB, WT_UK = 27 * MiB, WT_UV = 28 * MiB;
constexpr size_t MS_ADAP = 0;
constexpr size_t MS_ADA = 4 * MiB;
constexpr size_t MS_CB = 5 * MiB;
constexpr size_t MS_KC = 6 * MiB;
constexpr size_t MS_VCT = 7 * MiB;
constexpr size_t MS_HID = 8 * MiB;

struct Params {
  const float* in[24];
  float* out;
  unsigned char* ws;
  int pad0, pad1;
};

__device__ const unsigned short kSpStart[33] = {0, 52, 100, 144, 184, 220, 252, 281, 306, 327, 345, 359, 369, 378, 386, 394, 402, 410, 418, 426, 434, 442, 449, 456, 463, 470, 476, 482, 488, 494, 500, 506, 512};
typedef const __attribute__((address_space(4))) Params* KParamPtr;
__device__ __forceinline__ KParamPtr kparams() { unsigned long long v = (unsigned long long)__builtin_amdgcn_kernarg_segment_ptr(); asm volatile("" : "+s"(v)); return (KParamPtr)v; }
__device__ const unsigned char kBucket[128] = {0, 1, 2, 3, 4, 5, 6, 7, 8, 9, 10, 11, 12, 13, 14, 15, 16, 16, 16, 17, 17, 18, 18, 18, 19, 19, 19, 20, 20, 20, 20, 21, 21, 21, 21, 22, 22, 22, 22, 22, 23, 23, 23, 23, 23, 23, 24, 24, 24, 24, 24, 24, 25, 25, 25, 25, 25, 25, 25, 26, 26, 26, 26, 26, 26, 26, 26, 27, 27, 27, 27, 27, 27, 27, 27, 27, 27, 28, 28, 28, 28, 28, 28, 28, 28, 28, 28, 29, 29, 29, 29, 29, 29, 29, 29, 29, 29, 29, 29, 30, 30, 30, 30, 30, 30, 30, 30, 30, 30, 30, 30, 30, 30, 31, 31, 31, 31, 31, 31, 31, 31, 31, 31, 31, 31, 31, 31, 31};

DI unsigned pk2(float a, float b) { f32x2 v = {a, b}; bfx2 r = __builtin_convertvector(v, bfx2); return __builtin_bit_cast(unsigned, r); }
DI bf16_t f2bf(float a) { return (bf16_t)(pk2(a, 0.f) & 0xffffu); }
DI float bf2f(bf16_t v) { return __uint_as_float(((unsigned)v) << 16); }
DI u32x2 pk4(float a, float b, float c, float d) { u32x2 r; r.x = pk2(a, b); r.y = pk2(c, d); return r; }
DI int opq(int x) { asm volatile("" : "+v"(x)); return x; }
DI float opqf(float x) { asm volatile("" : "+v"(x)); return x; }
template <class T> DI T* opqp(T* p) { unsigned long long v = (unsigned long long)p; asm volatile("" : "+s"(v)); return (T*)v; }
DI int tid_of(int wave_s) { unsigned z = 0; asm volatile("" : "+s"(z)); int l = __builtin_amdgcn_mbcnt_hi(~0u, __builtin_amdgcn_mbcnt_lo(~0u, z)); return wave_s * 64 + l; }
DI float ex2(float x) { return __builtin_amdgcn_exp2f(x); }
DI float bperm_f(int srclane, float v) { return __int_as_float(__builtin_amdgcn_ds_bpermute(srclane << 2, __float_as_int(v))); }
DI int bperm_i(int srclane, int v) { return __builtin_amdgcn_ds_bpermute(srclane << 2, v); }
#define SHXF(v, m) bperm_f(lane ^ (m), (v))
#define SHXI(v, m) bperm_i(lane ^ (m), (v))
DI float red_max32(float x) { auto r = __builtin_amdgcn_permlane32_swap(__float_as_uint(x), __float_as_uint(x), false, false); return fmaxf(__uint_as_float(r[0]), __uint_as_float(r[1])); }
DI float red_max16(float x) { auto r = __builtin_amdgcn_permlane16_swap(__float_as_uint(x), __float_as_uint(x), false, false); return fmaxf(__uint_as_float(r[0]), __uint_as_float(r[1])); }
DI float red_sum32(float x) { auto r = __builtin_amdgcn_permlane32_swap(__float_as_uint(x), __float_as_uint(x), false, false); return __uint_as_float(r[0]) + __uint_as_float(r[1]); }
DI float red_sum16(float x) { auto r = __builtin_amdgcn_permlane16_swap(__float_as_uint(x), __float_as_uint(x), false, false); return __uint_as_float(r[0]) + __uint_as_float(r[1]); }
DI float wave_sum(float v, int lane) {
#pragma unroll
  for (int o = 32; o >= 1; o >>= 1) v += SHXF(v, o);
  return v;
}
DI int pi_row(int r) { return (r & 0x13) | ((r & 4) << 1) | ((r & 8) >> 1); }
DI bf16x8 pack8(const f32x16& x, int s8) {
  u32x4 u; u.x = pk2(x[8 * s8 + 0], x[8 * s8 + 1]); u.y = pk2(x[8 * s8 + 2], x[8 * s8 + 3]); u.z = pk2(x[8 * s8 + 4], x[8 * s8 + 5]); u.w = pk2(x[8 * s8 + 6], x[8 * s8 + 7]);
  return __builtin_bit_cast(bf16x8, u);
}
DI bf16x8 ldg8(const bf16_t* p) { return *(const bf16x8*)p; }
#define GLOAD16(dst, ptr) asm volatile("global_load_dwordx4 %0, %1, off" : "=&v"(dst) : "v"(ptr) : "memory")
DI void lds_barrier() { asm volatile("s_waitcnt lgkmcnt(0)\n\ts_barrier" ::: "memory"); }
DI void vm_wait0() { asm volatile("s_waitcnt vmcnt(0)" ::: "memory"); }
DI bf16x8 zero8() { u32x4 u = {0u, 0u, 0u, 0u}; return __builtin_bit_cast(bf16x8, u); }
DI f32x16 zero16() { f32x16 z;
#pragma unroll
  for (int i = 0; i < 16; ++i) z[i] = 0.f;
  return z; }
DI float sigmoidf_(float x) { return 1.f / (1.f + __expf(-x)); }
DI float gelu_tanh(float x) { float u = 0.7978845608028654f * (x + 0.044715f * x * x * x); float e = __expf(2.f * u); float th = 1.f - 2.f / (e + 1.f); return 0.5f * x * (1.f + th); }

constexpr int LROW = 72;
constexpr int LDS_TAB = 0;
constexpr int LDS_WORK = 8192;

struct APlain { const bf16_t* A; int lda; DI const bf16_t* base() const { return A; } DI unsigned rowoff(int m) const { return (unsigned)(m * lda); } DI unsigned koff(int k) const { return (unsigned)k; } };
struct ACmp {
  const bf16_t* proj; int col0;
  DI const bf16_t* base() const { return proj; }
  DI unsigned rowoff(int m) const { int combo = m >> 9, n = m & 511, b = combo >> 1, g = combo & 1; return (unsigned)((b * SEQ + 16 * n) * EIN + col0 + g * 64); }
  DI unsigned koff(int k) const { return (unsigned)((k >> 6) * EIN + (k & 63)); }
};

typedef __attribute__((address_space(3))) unsigned lds_u32_t;
DI void dma16(const void* g, unsigned char* l) { __builtin_amdgcn_global_load_lds((const unsigned*)g, (lds_u32_t*)(unsigned)(size_t)l, 16, 0, 0); }
constexpr int GST = 65536;
template <class AF, class EF>
DI void gemm_run(unsigned char* lds, int wv, const AF& af, const bf16_t* __restrict__ Bt, int ldb, int M, int N, int K, const EF& ef, int blk_off) {
  unsigned char* sBase = lds + LDS_WORK;
  const int tid = tid_of(wv), lane = tid & 63, wave = tid >> 6;
  const int wn = wave & 3, wm = wave >> 2;
  const int l15 = lane & 15, q4 = lane >> 4;
  const int mtiles = M >> 8, ntiles = (N + 255) >> 8, ntl = mtiles * ntiles;
  const int G = gridDim.x;
  int first = ((int)blockIdx.x - (blk_off % G) + G) % G;
  const int nk = K >> 6;
  const bool xmap = (blk_off == 0) && ((mtiles & 7) == 0) && ((G & 7) == 0);
  int tstep = G;
  if (xmap) { first = (int)blockIdx.x >> 3; tstep = G >> 3; }
  const int ntl_eff = xmap ? (ntl >> 3) : ntl;
  const int crow = tid >> 3;
  const int cch = ((tid & 7) ^ ((tid >> 4) & 7)) * 8;
  const int swz = l15 >> 1;
  for (int tile_ = first; tile_ < ntl_eff; tile_ += tstep) {
    int nt, mt;
    if (xmap) { nt = tile_ % ntiles; mt = (tile_ / ntiles) * 8 + ((int)blockIdx.x & 7); }
    else { nt = tile_ % ntiles; mt = tile_ / ntiles; }
    const int m0 = mt << 8, n0 = nt << 8;
    f32x4 acc[4][8];
#pragma unroll
    for (int i = 0; i < 4; ++i)
#pragma unroll
      for (int j = 0; j < 8; ++j) acc[i][j] = (f32x4){0.f, 0.f, 0.f, 0.f};
    unsigned aoff[4], boff[4];
    const bf16_t* Ab = af.base();
#pragma unroll
    for (int i = 0; i < 4; ++i) {
      int row = crow + 64 * i;
      aoff[i] = af.rowoff(m0 + row);
      int n = n0 + row; n = n < N ? n : N - 1;
      boff[i] = (unsigned)(n * ldb + cch);
    }
    __syncthreads();
#pragma unroll
    for (int i = 0; i < 4; ++i) {
      dma16(Ab + aoff[i] + af.koff(cch), sBase + 32768 + (i * 512 + tid) * 16);
      dma16(Bt + boff[i], sBase + (i * 512 + tid) * 16);
    }
    vm_wait0();
    __syncthreads();
#pragma unroll 1
    for (int kt = 0; kt < nk; ++kt) {
      unsigned char* cur = sBase + (kt & 1) * GST;
      if (kt + 1 < nk) {
        unsigned char* nxt = sBase + ((kt + 1) & 1) * GST;
        const int k0 = (kt + 1) << 6;
#pragma unroll
        for (int i = 0; i < 4; ++i) {
          dma16(Ab + aoff[i] + af.koff(k0 + cch), nxt + 32768 + (i * 512 + tid) * 16);
          dma16(Bt + boff[i] + (unsigned)k0, nxt + (i * 512 + tid) * 16);
        }
      }
#pragma unroll
      for (int ks = 0; ks < 2; ++ks) {
        bf16x8 wf[4], xf[8];
#pragma unroll
        for (int i = 0; i < 4; ++i) wf[i] = *(const bf16x8*)(cur + (wn * 64 + i * 16 + l15) * 128 + (((ks * 4 + q4) ^ swz) * 16));
#pragma unroll
        for (int j = 0; j < 8; ++j) xf[j] = *(const bf16x8*)(cur + 32768 + (wm * 128 + j * 16 + l15) * 128 + (((ks * 4 + q4) ^ swz) * 16));
#pragma unroll
        for (int i = 0; i < 4; ++i)
#pragma unroll
          for (int j = 0; j < 8; ++j) acc[i][j] = MFMA16(wf[i], xf[j], acc[i][j]);
      }
      vm_wait0();
      __syncthreads();
    }
#pragma unroll
    for (int ip = 0; ip < 2; ++ip)
#pragma unroll
      for (int j = 0; j < 8; ++j) {
        float lo[4], hi[4];
#pragma unroll
        for (int k = 0; k < 4; ++k) {
          auto r = __builtin_amdgcn_permlane16_swap(__float_as_uint(acc[2 * ip][j][k]), __float_as_uint(acc[2 * ip + 1][j][k]), false, false);
          lo[k] = __uint_as_float(r[0]); hi[k] = __uint_as_float(r[1]);
        }
        int n = n0 + wn * 64 + (2 * ip + (q4 & 1)) * 16 + (q4 >> 1) * 8;
        int m = m0 + wm * 128 + j * 16 + l15;
        if (n < N) ef.store8(m, n, lo[0], lo[1], lo[2], lo[3], hi[0], hi[1], hi[2], hi[3]);
      }
  }
}

struct EpiRow { bf16_t* C; int ldc; DI void store(int m, int n, float a, float b, float c, float d) const { *(u32x2*)(C + (size_t)m * ldc + n) = pk4(a, b, c, d); }
  DI void store8(int m, int n, float a, float b, float c, float d, float e, float f, float g, float h) const { *(u32x4*)(C + (size_t)m * ldc + n) = (u32x4){pk2(a, b), pk2(c, d), pk2(e, f), pk2(g, h)}; } };
struct EpiSqRelu { bf16_t* C; DI void store(int m, int n, float a, float b, float c, float d) const {
    a = fmaxf(a, 0.f); b = fmaxf(b, 0.f); c = fmaxf(c, 0.f); d = fmaxf(d, 0.f);
    *(u32x2*)(C + (size_t)m * DFF + n) = pk4(a * a, b * b, c * c, d * d); }
  DI void store8(int m, int n, float a, float b, float c, float d, float e, float f, float g, float h) const {
    a = fmaxf(a, 0.f); b = fmaxf(b, 0.f); c = fmaxf(c, 0.f); d = fmaxf(d, 0.f); e = fmaxf(e, 0.f); f = fmaxf(f, 0.f); g = fmaxf(g, 0.f); h = fmaxf(h, 0.f);
    *(u32x4*)(C + (size_t)m * DFF + n) = (u32x4){pk2(a * a, b * b), pk2(c * c, d * d), pk2(e * e, f * f), pk2(g * g, h * h)}; } };
struct EpiResid { const float* xin; float* out; const float* gate;
  DI void store(int m, int n, float a, float b, float c, float d) const {
    int bb = m >> 13;
    float4 x = *(const float4*)(xin + (size_t)m * DM + n);
    float4 g = *(const float4*)(gate + bb * 6144 + n);
    const float one = opqf(1.0f);
    float4 r; r.x = ALPHA_C * x.x + (one + g.x) * a; r.y = ALPHA_C * x.y + (one + g.y) * b; r.z = ALPHA_C * x.z + (one + g.z) * c; r.w = ALPHA_C * x.w + (one + g.w) * d;
    *(float4*)(out + (size_t)m * DM + n) = r; }
  DI void store8(int m, int n, float a, float b, float c, float d, float e, float f, float g, float h) const { store(m, n, a, b, c, d); store(m, n + 4, e, f, g, h); } };
struct EpiEvenProj { bf16_t* proj; bf16_t* vsT; bf16_t* vwT;
  DI void store(int m, int n, float a, float b, float c, float d) const {
    int bb = m >> 13, s = m & (SEQ - 1);
    if (n >= C_VS && n < C_KW) { int e = n - C_VS; bf16_t* p = vsT + ((size_t)(bb * 128 + e)) * SEQ + s; p[0] = f2bf(a); p[SEQ] = f2bf(b); p[2 * SEQ] = f2bf(c); p[3 * SEQ] = f2bf(d); }
    else if (n >= C_VW && n < C_GATE) { int e = n - C_VW; bf16_t* p = vwT + ((size_t)(bb * 128 + e)) * SEQ + s; p[0] = f2bf(a); p[SEQ] = f2bf(b); p[2 * SEQ] = f2bf(c); p[3 * SEQ] = f2bf(d); }
    else *(u32x2*)(proj + (size_t)m * EIN + n) = pk4(a, b, c, d); }
  DI void store8(int m, int n, float a, float b, float c, float d, float e, float f, float g, float h) const {
    if ((n >= C_VS && n < C_KW) || (n >= C_VW && n < C_GATE)) { store(m, n, a, b, c, d); store(m, n + 4, e, f, g, h); }
    else *(u32x4*)(proj + (size_t)m * EIN + n) = (u32x4){pk2(a, b), pk2(c, d), pk2(e, f), pk2(g, h)}; } };
struct EpiOddProj { bf16_t* qk; bf16_t* vT;
  DI void store(int m, int n, float a, float b, float c, float d) const {
    if (n < 2048) *(u32x2*)(qk + (size_t)m * 2048 + n) = pk4(a, b, c, d);
    else { int bb = m >> 13, s = m & (SEQ - 1); int e = n - 2048; bf16_t* p = vT + ((size_t)(bb * 1024 + e)) * SEQ + s; p[0] = f2bf(a); p[SEQ] = f2bf(b); p[2 * SEQ] = f2bf(c); p[3 * SEQ] = f2bf(d); } }
  DI void store8(int m, int n, float a, float b, float c, float d, float e, float f, float g, float h) const {
    if (n < 2048) *(u32x4*)(qk + (size_t)m * 2048 + n) = (u32x4){pk2(a, b), pk2(c, d), pk2(e, f), pk2(g, h)};
    else { store(m, n, a, b, c, d); store(m, n + 4, e, f, g, h); } } };
struct EpiCmp1 { const float* bias; bf16_t* hid;
  DI void store(int m, int n, float a, float b, float c, float d) const {
    float4 bv = *(const float4*)(bias + n);
    *(u32x2*)(hid + (size_t)m * 256 + n) = pk4(gelu_tanh(a + bv.x), gelu_tanh(b + bv.y), gelu_tanh(c + bv.z), gelu_tanh(d + bv.w)); }
  DI void store8(int m, int n, float a, float b, float c, float d, float e, float f, float g, float h) const { store(m, n, a, b, c, d); store(m, n + 4, e, f, g, h); } };
struct EpiCmp2 { bf16_t* kc; bf16_t* vcT; int kv; DI void store(int m, int n, float a, float b, float c, float d) const {
    int combo = m >> 9, nn = m & 511;
    if (nn == 511) { a = b = c = d = 0.f; }
    if (kv == 0) *(u32x2*)(kc + (size_t)m * 64 + n) = pk4(a, b, c, d);
    else { bf16_t* p = vcT + ((size_t)(combo * 64 + n)) * 512 + nn; p[0] = f2bf(a); p[512] = f2bf(b); p[1024] = f2bf(c); p[1536] = f2bf(d); } }
  DI void store8(int m, int n, float a, float b, float c, float d, float e, float f, float g, float h) const { store(m, n, a, b, c, d); store(m, n + 4, e, f, g, h); } };

DI void tr_convert(unsigned char* lds, int wv, const float* __restrict__ src, int K, int N, bf16_t* __restrict__ dst, int& tb) {
  bf16_t* sT = (bf16_t*)(lds + LDS_WORK);
  const int tid = tid_of(wv), G = gridDim.x;
  const int nkt = K >> 6, nnt = (N + 63) >> 6, ntl = nkt * nnt;
  int first = ((int)blockIdx.x - (tb % G) + G) % G;
  for (int tl = first; tl < ntl; tl += G) {
    const int k0 = (tl / nnt) << 6, n0 = (tl % nnt) << 6;
    const int kk = tid >> 4, n4 = (tid & 15) * 4;
    __syncthreads();
#pragma unroll
    for (int i = 0; i < 2; ++i) {
      int k = kk + 32 * i;
      float4 v = make_float4(0.f, 0.f, 0.f, 0.f);
      if (n0 + n4 < N) v = *(const float4*)(src + (size_t)(k0 + k) * N + n0 + n4);
      sT[(n4 + 0) * LROW + k] = f2bf(v.x); sT[(n4 + 1) * LROW + k] = f2bf(v.y); sT[(n4 + 2) * LROW + k] = f2bf(v.z); sT[(n4 + 3) * LROW + k] = f2bf(v.w);
    }
    __syncthreads();
    const int n = tid >> 3, k8 = (tid & 7) * 8;
    if (n0 + n < N) *(u32x4*)(dst + (size_t)(n0 + n) * K + k0 + k8) = *(const u32x4*)(sT + n * LROW + k8);
  }
  tb += ntl;
}

DI void wprep_phase(unsigned char* lds, KParamPtr P, int wv, int l) {
  unsigned char* wsq = opqp(P->ws);
  bf16_t* WT = (bf16_t*)(wsq + OFF_WT);
  int tb = 0;
  const int i2 = l >> 1;
  tr_convert(lds, wv, P->in[22] + (size_t)l * DM * DFF, DM, DFF, (bf16_t*)((unsigned char*)WT + WT_M1), tb);
  tr_convert(lds, wv, P->in[23] + (size_t)l * DFF * DM, DFF, DM, (bf16_t*)((unsigned char*)WT + WT_M2), tb);
  if ((l & 1) == 0) {
    tr_convert(lds, wv, P->in[7] + (size_t)i2 * DM * EIN, DM, EIN, (bf16_t*)((unsigned char*)WT + WT_IN), tb);
    tr_convert(lds, wv, P->in[8] + (size_t)i2 * DM * DM, DM, DM, (bf16_t*)((unsigned char*)WT + WT_OUT), tb);
    tr_convert(lds, wv, P->in[11] + (size_t)i2 * 2048 * 256, 2048, 256, (bf16_t*)((unsigned char*)WT + WT_CW1), tb);
    tr_convert(lds, wv, P->in[13] + (size_t)i2 * 2048 * 256, 2048, 256, (bf16_t*)((unsigned char*)WT + WT_CW1) + 256 * 2048, tb);
    tr_convert(lds, wv, P->in[12] + (size_t)i2 * 256 * 64, 256, 64, (bf16_t*)((unsigned char*)WT + WT_CW2), tb);
    tr_convert(lds, wv, P->in[14] + (size_t)i2 * 256 * 64, 256, 64, (bf16_t*)((unsigned char*)WT + WT_CW2) + 64 * 256, tb);
    tr_convert(lds, wv, P->in[17] + (size_t)i2 * 128 * 512, 128, 512, (bf16_t*)((unsigned char*)WT + WT_UV), tb);
    {
      const float* src = P->in[16] + (size_t)i2 * 128 * 512; bf16_t* dst = (bf16_t*)((unsigned char*)WT + WT_UK);
      for (int i = (blockIdx.x * NTHREADS + tid_of(wv)) * 4; i < 128 * 512; i += gridDim.x * NTHREADS * 4) {
        float4 v = *(const float4*)(src + i); *(u32x2*)(dst + i) = pk4(v.x, v.y, v.z, v.w);
      }
    }
    {
      float* red = (float*)(lds + LDS_WORK + 16384);
      float* cb = (float*)(wsq + OFF_MISC + MS_CB);
      const int tid_ = tid_of(wv); const int lane = tid_ & 63, wave = tid_ >> 6;
      for (int it = (int)gridDim.x - 1 - (int)blockIdx.x; it < 8; it += gridDim.x) {
        const int kv = it >> 2, n0 = (it & 3) * 64;
        const float* pe = P->in[kv ? 10 : 9] + (size_t)i2 * 2048;
        const float* w1 = P->in[kv ? 13 : 11] + (size_t)i2 * 2048 * 256;
        float a = 0.f;
        for (int k = wave * 256; k < wave * 256 + 256; ++k) a += pe[k] * w1[(size_t)k * 256 + n0 + lane];
        __syncthreads();
        red[wave * 64 + lane] = a;
        __syncthreads();
        if (wave == 0) { float s = 0.f; for (int w = 0; w < 8; ++w) s += red[w * 64 + lane]; cb[kv * 256 + n0 + lane] = s; }
      }
    }
  } else {
    tr_convert(lds, wv, P->in[18] + (size_t)i2 * DM * OIN, DM, OIN, (bf16_t*)((unsigned char*)WT + WT_IN), tb);
    tr_convert(lds, wv, P->in[19] + (size_t)i2 * DM * DM, DM, DM, (bf16_t*)((unsigned char*)WT + WT_OUT), tb);
  }
}

DI void ada_partial_phase(unsigned char* lds, KParamPtr P, int wv) {
  unsigned char* wsq = opqp(P->ws);
  float* cact = (float*)(lds + LDS_WORK);
  float* part = (float*)(wsq + OFF_MISC + MS_ADAP);
  const int tid = tid_of(wv);
  __syncthreads();
  for (int i = tid; i < 4096; i += NTHREADS) { float v = P->in[1][i]; cact[i] = v / (1.f + __expf(-v)); }
  __syncthreads();
  for (int it = blockIdx.x; it < 384; it += gridDim.x) {
    const int kc = it & 7, jc = (it >> 3) % 12, l = it / 96;
    const int j = jc * 512 + tid;
    const float* w = P->in[3] + ((size_t)l * 1024 + kc * 128) * 6144 + j;
    float a0 = 0.f, a1 = 0.f, a2 = 0.f, a3 = 0.f;
#pragma unroll 8
    for (int k = 0; k < 128; ++k) {
      float wgt = w[(size_t)k * 6144];
      int kk = kc * 128 + k;
      a0 += cact[kk] * wgt; a1 += cact[1024 + kk] * wgt; a2 += cact[2048 + kk] * wgt; a3 += cact[3072 + kk] * wgt;
    }
    float* o = part + ((size_t)(kc * 4 + l) * 4) * 6144 + j;
    o[0] = a0; o[6144] = a1; o[2 * 6144] = a2; o[3 * 6144] = a3;
  }
}
DI void ada_reduce_phase(KParamPtr P, int wv) {
  unsigned char* wsq = opqp(P->ws);
  const float* part = (const float*)(wsq + OFF_MISC + MS_ADAP);
  float* ada = (float*)(wsq + OFF_MISC + MS_ADA);
  for (int i = blockIdx.x * NTHREADS + tid_of(wv); i < 4 * 4 * 6144; i += gridDim.x * NTHREADS) {
    int l = i / (4 * 6144), j = i % 6144;
    float s = P->in[4][l * 6144 + j];
#pragma unroll
    for (int kc = 0; kc < 8; ++kc) s += part[(size_t)kc * 4 * 4 * 6144 + i];
    ada[i] = s;
  }
}

DI void ln_mod_phase(KParamPtr P, int wv, const float* src, float* xdst, const float* lng, const float* lnb, const float* sh, const float* sc, bool do_ln, bool write_hb) {
  unsigned char* wsq = opqp(P->ws);
  bf16_t* hb = (bf16_t*)(wsq + OFF_HB);
  const int tid_ = tid_of(wv); const int lane = tid_ & 63, wave = tid_ >> 6;
  const int nw = gridDim.x * 8, gw = blockIdx.x * 8 + wave;
  const int rpw = (NTOK + nw - 1) / nw;
  int r0 = gw * rpw, r1 = r0 + rpw; if (r1 > NTOK) r1 = NTOK;
  float4 g4[4], b4[4], sh4[4], sc4[4];
#pragma unroll
  for (int i = 0; i < 4; ++i) { int c = lane * 4 + 256 * i; if (do_ln) { g4[i] = *(const float4*)(lng + c); b4[i] = *(const float4*)(lnb + c); } }
  int curb = -1;
  const float one = opqf(1.0f);
  f32x4 vn[4];
  if (r0 < r1) {
#pragma unroll
    for (int i = 0; i < 4; ++i) vn[i] = *(const f32x4*)(src + (size_t)r0 * DM + lane * 4 + 256 * i);
  }
  for (int row = r0; row < r1; ++row) {
    const int bb = row >> 13;
    if (bb != curb && write_hb) {
      curb = bb;
#pragma unroll
      for (int i = 0; i < 4; ++i) { int c = lane * 4 + 256 * i; sh4[i] = *(const float4*)(sh + bb * 6144 + c); sc4[i] = *(const float4*)(sc + bb * 6144 + c); }
    }
    float4 v[4];
#pragma unroll
    for (int i = 0; i < 4; ++i) { v[i].x = vn[i][0]; v[i].y = vn[i][1]; v[i].z = vn[i][2]; v[i].w = vn[i][3]; }
    {
      const int rn = row + 1 < r1 ? row + 1 : row;
#pragma unroll
      for (int i = 0; i < 4; ++i) vn[i] = *(const f32x4*)(src + (size_t)rn * DM + lane * 4 + 256 * i);
    }
    if (do_ln) {
      float s = 0.f;
#pragma unroll
      for (int i = 0; i < 4; ++i) s += v[i].x + v[i].y + v[i].z + v[i].w;
      const float mu = wave_sum(s, lane) * (1.f / 1024.f);
      float q = 0.f;
#pragma unroll
      for (int i = 0; i < 4; ++i) { v[i].x -= mu; v[i].y -= mu; v[i].z -= mu; v[i].w -= mu; q += v[i].x * v[i].x + v[i].y * v[i].y + v[i].z * v[i].z + v[i].w * v[i].w; }
      const float rstd = rsqrtf(wave_sum(q, lane) * (1.f / 1024.f) + 1e-5f);
#pragma unroll
      for (int i = 0; i < 4; ++i) {
        v[i].x = v[i].x * rstd * g4[i].x + b4[i].x; v[i].y = v[i].y * rstd * g4[i].y + b4[i].y; v[i].z = v[i].z * rstd * g4[i].z + b4[i].z; v[i].w = v[i].w * rstd * g4[i].w + b4[i].w;
        *(float4*)(xdst + (size_t)row * DM + lane * 4 + 256 * i) = v[i];
      }
    }
    if (write_hb) {
#pragma unroll
      for (int i = 0; i < 4; ++i) {
        *(u32x2*)(hb + (size_t)row * DM + lane * 4 + 256 * i) = pk4(v[i].x * (one + sc4[i].x) + sh4[i].x, v[i].y * (one + sc4[i].y) + sh4[i].y, v[i].z * (one + sc4[i].z) + sh4[i].z, v[i].w * (one + sc4[i].w) + sh4[i].w);
      }
    }
  }
}

DI void diff_attn_phase(unsigned char* lds, KParamPtr P, int wv, int l) {
  unsigned char* wsq = opqp(P->ws);
  const float* tab = (const float*)(lds + LDS_TAB);
  bf16_t* sK = (bf16_t*)(lds + LDS_WORK);
  bf16_t* sV = sK + 64 * LROW;
  const bf16_t* qk = (const bf16_t*)(wsq + OFF_U + U_QK);
  const bf16_t* vT = (const bf16_t*)(wsq + OFF_U + U_VT);
  bf16_t* ao = (bf16_t*)(wsq + OFF_AO);
  const int i2 = l >> 1;
  const int tid = tid_of(wv), lane = tid & 63, wave = tid >> 6, l31 = lane & 31, hh = lane >> 5;
  const float lambda_init = 0.8f - 0.6f * __expf(-0.3f * (float)l);
  float lam_full;
  {
    const float* lam = P->in[20] + (size_t)i2 * 256;
    float s1 = 0.f, s2 = 0.f;
    for (int d = 0; d < 64; ++d) { s1 += lam[d] * lam[64 + d]; s2 += lam[128 + d] * lam[192 + d]; }
    lam_full = __expf(s1) - __expf(s2) + lambda_init;
  }
  const float* subln = P->in[21] + (size_t)i2 * 128;
  const int pr = pi_row(l31);
  for (int it = blockIdx.x; it < 1024; it += gridDim.x) {
    const int rr = it >> 8, kk = it & 255, bh = (kk & 7) * 4 + rr, jq = kk >> 3;
    const int qt = (rr & 1) ? 31 - jq : jq;
    const int b = bh >> 3, h = bh & 7;
    const int Q0 = qt * 256, q0w = Q0 + wave * 32, t = q0w + l31;
    const int nkt = 4 * (qt + 1);
    unsigned* O1L = (unsigned*)(lds + LDS_WORK + 32768) + tid;
#pragma unroll 1
    for (int pass = 0; pass < 2; ++pass) {
      const int col = h * 2 + pass;
      bf16x8 qf[4];
      const bf16_t* qp = qk + (size_t)(b * SEQ + t) * 2048 + h * 128 + pass * 64 + hh * 8;
#pragma unroll
      for (int ks = 0; ks < 4; ++ks) qf[ks] = ldg8(qp + ks * 16);
      f32x16 O[4];
#pragma unroll
      for (int e = 0; e < 4; ++e) O[e] = zero16();
      float m_run = NEGB, l_run = 0.f;
      const float bfar = tab[col * 128 + 127];
      const unsigned kgo = (unsigned)((b * SEQ + (tid >> 3)) * 2048 + 1024 + h * 128 + pass * 64 + (tid & 7) * 8);
      const unsigned vgo = (unsigned)(((b * 8 + h) * 128 + (tid >> 3)) * SEQ + (tid & 7) * 8);
      u32x4 rk = *(const u32x4*)(qk + kgo), rv0 = *(const u32x4*)(vT + vgo), rv1 = *(const u32x4*)(vT + vgo + 64 * SEQ);
      __syncthreads();
      *(u32x4*)(sK + (tid >> 3) * LROW + (tid & 7) * 8) = rk;
      *(u32x4*)(sV + (tid >> 3) * LROW + (tid & 7) * 8) = rv0;
      *(u32x4*)(sV + ((tid >> 3) + 64) * LROW + (tid & 7) * 8) = rv1;
      __syncthreads();
#pragma unroll 1
      for (int kt = 0; kt < nkt; ++kt) {
        if (kt + 1 < nkt) {
          const int kn = kt + 1;
          GLOAD16(rk, qk + kgo + (unsigned)(kn * 64 * 2048));
          GLOAD16(rv0, vT + vgo + (unsigned)(kn * 64));
          GLOAD16(rv1, vT + vgo + (unsigned)(kn * 64 + 64 * SEQ));
        }
#pragma unroll
        for (int sub = 0; sub < 2; ++sub) {
          const int s0 = kt * 64 + sub * 32;
          if (s0 <= q0w + 31) {
            f32x16 s = zero16();
            bf16x8 kf[4], vf[8];
#pragma unroll
            for (int ks = 0; ks < 4; ++ks) kf[ks] = *(const bf16x8*)(sK + (sub * 32 + pr) * LROW + ks * 16 + hh * 8);
#pragma unroll
            for (int st = 0; st < 2; ++st)
#pragma unroll
              for (int e = 0; e < 4; ++e) vf[st * 4 + e] = *(const bf16x8*)(sV + (e * 32 + l31) * LROW + sub * 32 + st * 16 + hh * 8);
            __builtin_amdgcn_sched_barrier(0);
#pragma unroll
            for (int ks = 0; ks < 4; ++ks) s = MFMA32(kf[ks], qf[ks], s);
            float mloc = NEGB;
            const bool far = (q0w - (s0 + 31) >= 127);
            if (far) {
#pragma unroll
              for (int i = 0; i < 16; ++i) mloc = fmaxf(mloc, s[i]);
              mloc = fmaf(mloc, C1, bfar);
            } else {
#pragma unroll
              for (int i = 0; i < 16; ++i) {
                int key = s0 + (i & 7) + 8 * hh + 16 * (i >> 3);
                int dist = t - key; int dd = dist < 0 ? 0 : (dist > 127 ? 127 : dist);
                const float tb = tab[col * 128 + dd];
                float z = fmaf(s[i], C1, tb); z = dist < 0 ? NEGB : z;
                s[i] = z; mloc = fmaxf(mloc, z);
              }
            }
            mloc = red_max32(mloc);
            const float m_new = (mloc > m_run + 16.f) ? mloc : m_run;
            const float alpha = ex2(m_run - m_new);
            float ls = 0.f;
            if (far) {
              const float boff_ = bfar - m_new;
#pragma unroll
              for (int i = 0; i < 16; ++i) { float p = ex2(fmaf(s[i], C1, boff_)); s[i] = p; ls += p; }
            } else {
#pragma unroll
              for (int i = 0; i < 16; ++i) { float p = ex2(s[i] - m_new); s[i] = p; ls += p; }
            }
            l_run = l_run * alpha + ls; m_run = m_new;
            if (__any(alpha != 1.0f)) {
#pragma unroll
              for (int e = 0; e < 4; ++e)
#pragma unroll
                for (int i = 0; i < 16; ++i) O[e][i] *= alpha;
            }
#pragma unroll
            for (int st = 0; st < 2; ++st) {
              bf16x8 pf = pack8(s, st);
#pragma unroll
              for (int e = 0; e < 4; ++e) O[e] = MFMA32(vf[st * 4 + e], pf, O[e]);
            }
          }
        }
        __syncthreads();
        vm_wait0();
        if (kt + 1 < nkt) {
          *(u32x4*)(sK + (tid >> 3) * LROW + (tid & 7) * 8) = rk;
          *(u32x4*)(sV + (tid >> 3) * LROW + (tid & 7) * 8) = rv0;
          *(u32x4*)(sV + ((tid >> 3) + 64) * LROW + (tid & 7) * 8) = rv1;
        }
        __syncthreads();
      }
      const float lt = red_sum32(l_run);
      const float inv = 1.f / lt;
      if (pass == 0) {
#pragma unroll
        for (int e = 0; e < 4; ++e)
#pragma unroll
          for (int i = 0; i < 8; ++i) O1L[(e * 8 + i) * 512] = pk2(O[e][2 * i] * inv, O[e][2 * i + 1] * inv);
      } else {
        float ss = 0.f;
#pragma unroll
        for (int e = 0; e < 4; ++e)
#pragma unroll
          for (int i = 0; i < 16; ++i) {
            const unsigned pw = O1L[(e * 8 + (i >> 1)) * 512];
            float o1 = (i & 1) ? __uint_as_float(pw & 0xffff0000u) : __uint_as_float(pw << 16);
            float o = o1 - lam_full * (O[e][i] * inv); O[e][i] = o; ss += o * o; }
        ss = red_sum32(ss);
        const float rs = rsqrtf(ss * (1.f / 128.f) + 1e-5f) * (1.f - lambda_init);
        bf16_t* op = ao + (size_t)(b * SEQ + t) * DM + h * 128;
#pragma unroll
        for (int e = 0; e < 4; ++e)
#pragma unroll
          for (int g = 0; g < 4; ++g) {
            int ee = e * 32 + 8 * g + 4 * hh;
            float4 sl = *(const float4*)(subln + ee);
            *(u32x2*)(op + ee) = pk4(O[e][4 * g] * rs * sl.x, O[e][4 * g + 1] * rs * sl.y, O[e][4 * g + 2] * rs * sl.z, O[e][4 * g + 3] * rs * sl.w);
          }
      }
    }
  }
}

DI void cmp_z(f32x16& s, int kt, int t, int t0, int hh, const float* tabh, float& mloc) {
  const int nb = kt * 32;
  if (t0 - (16 * (nb + 31) + 31) >= 127) {
    const float bf = tabh[127];
#pragma unroll
    for (int i = 0; i < 16; ++i) { float z = fmaf(s[i], C1, bf); s[i] = z; mloc = fmaxf(mloc, z); }
  } else {
#pragma unroll
    for (int i = 0; i < 16; ++i) {
      int n = nb + (i & 7) + 8 * hh + 16 * (i >> 3);
      int dc = t - (16 * n + 31); int dd = dc < 0 ? 0 : (dc > 127 ? 127 : dc);
      float z = dc < 0 ? NEGB : fmaf(s[i], C1, tabh[dd]);
      s[i] = z; mloc = fmaxf(mloc, z);
    }
  }
}

DI void nsa_phase(unsigned char* lds, KParamPtr P, int wv) {
  unsigned char* wsq = opqp(P->ws);
  const float* tab = (const float*)(lds + LDS_TAB);
  const int tid = tid_of(wv), lane = tid & 63, wave = tid >> 6, l31 = lane & 31, hh = lane >> 5;
  unsigned char* selL = lds + LDS_WORK + wave * 512;
  float* scw = (float*)(lds + LDS_WORK + 4096 + wave * 16384);
  const bf16_t* proj = (const bf16_t*)(wsq + OFF_U + U_PROJ);
  const bf16_t* vsT = (const bf16_t*)(wsq + OFF_U + U_VST);
  const bf16_t* vwT = (const bf16_t*)(wsq + OFF_U + U_VWT);
  const bf16_t* kc = (const bf16_t*)(wsq + OFF_MISC + MS_KC);
  const bf16_t* vcT = (const bf16_t*)(wsq + OFF_MISC + MS_VCT);
  float* part = (float*)(wsq + OFF_HB);
  bf16_t* ao = (bf16_t*)(wsq + OFF_AO);
  const int nw = gridDim.x * 8, gw = blockIdx.x * 8 + wave;
  const int pr = pi_row(l31);
  for (int it = gw; it < 2048; it += nw) {
    const int blk_ = it >> 3, combo_ = blk_ & 7;
    const int b = combo_ >> 1, g = combo_ & 1, tile = ((blk_ >> 3) << 3) + (it & 7), t0 = tile * 32, t = t0 + l31;
    const size_t tok = (size_t)b * SEQ + t;
    const bf16_t* kcb = kc + (size_t)((b * 2 + g) * 512) * 64;
    const bf16_t* vcb = vcT + (size_t)((b * 2 + g) * 64) * 512;
#pragma unroll 1
    for (int x = 0; x < 64; ++x) scw[x * 64 + lane] = 0.f;
    const int nkt = (2 * tile + 1 + 31) >> 5;
#pragma unroll 1
    for (int hp = 0; hp < 4; ++hp) {
      const int head = g * 4 + hp;
      const float* tabh = tab + head * 128;
      bf16x8 qf[4];
#pragma unroll
      for (int ks = 0; ks < 4; ++ks) qf[ks] = ldg8(proj + tok * EIN + C_NQ + head * 64 + ks * 16 + hh * 8);
      float m = NEGB, l = 0.f;
      bf16x8 kf[4];
      const unsigned kco = (unsigned)(pr * 64 + hh * 8);
#pragma unroll
      for (int ks = 0; ks < 4; ++ks) kf[ks] = ldg8(kcb + kco + ks * 16);
#pragma unroll 1
      for (int kt = 0; kt < nkt; ++kt) {
        f32x16 s = zero16();
#pragma unroll
        for (int ks = 0; ks < 4; ++ks) s = MFMA32(kf[ks], qf[ks], s);
        {
          const int kn = kt + 1 < nkt ? kt + 1 : kt;
#pragma unroll
          for (int ks = 0; ks < 4; ++ks) kf[ks] = ldg8(kcb + kco + (unsigned)(kn * 32 * 64 + ks * 16));
        }
        float mloc = NEGB;
        cmp_z(s, kt, t, t0, hh, tabh, mloc);
        mloc = red_max32(mloc);
        const float mn = fmaxf(m, mloc);
        float ls = 0.f;
#pragma unroll
        for (int i = 0; i < 16; ++i) ls += (s[i] > -1e29f) ? ex2(s[i] - mn) : 0.f;
        l = l * ex2(m - mn) + ls; m = mn;
      }
      const float lt = red_sum32(l);
      const float inv = lt > 0.f ? 1.f / lt : 0.f;
      f32x16 O[2]; O[0] = zero16(); O[1] = zero16();
      float carry = 0.f;
#pragma unroll
      for (int ks = 0; ks < 4; ++ks) kf[ks] = ldg8(kcb + kco + ks * 16);
#pragma unroll 1
      for (int kt = 0; kt < nkt; ++kt) {
        {
          bf16x8 vf[4];
#pragma unroll
          for (int st = 0; st < 2; ++st)
#pragma unroll
            for (int et = 0; et < 2; ++et) vf[st * 2 + et] = ldg8(vcb + (unsigned)((et * 32 + l31) * 512 + kt * 32 + st * 16 + hh * 8));
          f32x16 s = zero16();
#pragma unroll
          for (int ks = 0; ks < 4; ++ks) s = MFMA32(kf[ks], qf[ks], s);
          {
            const int kn = kt + 1 < nkt ? kt + 1 : kt;
#pragma unroll
            for (int ks = 0; ks < 4; ++ks) kf[ks] = ldg8(kcb + kco + (unsigned)(kn * 32 * 64 + ks * 16));
          }
          float mloc = NEGB;
          cmp_z(s, kt, t, t0, hh, tabh, mloc);
#pragma unroll
          for (int i = 0; i < 16; ++i) s[i] = (s[i] > -1e29f) ? ex2(s[i] - m) * inv : 0.f;
          const float G00 = s[0] + s[1] + s[2] + s[3], G01 = s[4] + s[5] + s[6] + s[7];
          const float G10 = s[8] + s[9] + s[10] + s[11], G11 = s[12] + s[13] + s[14] + s[15];
          const float pe0 = SHXF(s[7], 32), pe1 = SHXF(s[15], 32);
          const float X0 = hh ? pe0 : carry;
          const float X1 = hh ? pe1 : pe0;
          float* sp = scw + (8 * kt + 2 * hh) * 32 + l31;
          sp[0] += 2.f * G00 - s[3] + X0;
          sp[32] += 2.f * G01 - s[7] + s[3];
          sp[4 * 32] += 2.f * G10 - s[11] + X1;
          sp[5 * 32] += 2.f * G11 - s[15] + s[11];
          carry = pe1;
#pragma unroll
          for (int st = 0; st < 2; ++st) {
            bf16x8 pf = pack8(s, st);
#pragma unroll
            for (int et = 0; et < 2; ++et) O[et] = MFMA32(vf[st * 2 + et], pf, O[et]);
          }
        }
      }
      const float g0 = sigmoidf_(bf2f(proj[tok * EIN + C_GATE + head * 3 + 0]));
      float* pp = part + (tok * 8 + head) * 64;
#pragma unroll
      for (int et = 0; et < 2; ++et)
#pragma unroll
        for (int gq = 0; gq < 4; ++gq) {
          float4 r; r.x = g0 * O[et][4 * gq]; r.y = g0 * O[et][4 * gq + 1]; r.z = g0 * O[et][4 * gq + 2]; r.w = g0 * O[et][4 * gq + 3];
          *(float4*)(pp + et * 32 + 8 * gq + 4 * hh) = r;
        }
    }
    {
      const int cb = t >> 6;
#pragma unroll 1
      for (int r = 0; r < 64; ++r) {
        const int j = 4 * (r >> 1) + (r & 1) + 2 * hh;
        const bool forced = (j == 0) | (j == cb) | (j == cb - 1);
        const float v = scw[j * 32 + l31];
        scw[j * 32 + l31] = forced ? 1e9f : (j <= cb ? v : -1e9f);
      }
      unsigned mk0 = 0u, mk1 = 0u, mk2 = 0u, mk3 = 0u;
#pragma unroll 1
      for (int rd = 0; rd < 16; ++rd) {
        float bv = -INFINITY; int bj = 255;
#pragma unroll 4
        for (int r = 0; r < 64; ++r) {
          const int j = 4 * (r >> 1) + (r & 1) + 2 * hh;
          const float v = scw[j * 32 + l31];
          if (v > bv) { bv = v; bj = j; }
        }
        const float ov = SHXF(bv, 32); const int oj = SHXI(bj, 32);
        const bool other = (ov > bv) || (ov == bv && oj < bj);
        const int wj = other ? oj : bj;
        if (((wj >> 1) & 1) == hh) scw[wj * 32 + l31] = -3e38f;
        const unsigned bit = 1u << (wj & 31); const int wd = wj >> 5;
        mk0 |= wd == 0 ? bit : 0u; mk1 |= wd == 1 ? bit : 0u; mk2 |= wd == 2 ? bit : 0u; mk3 |= wd == 3 ? bit : 0u;
      }
      if (hh == 0) *(u32x4*)(selL + l31 * 16) = (u32x4){mk0, mk1, mk2, mk3};
    }
    {
      const int s_lo = t0 >= 512 ? t0 - 512 : 0;
      const int nwt = (t0 + 32 - s_lo) >> 5;
#pragma unroll 1
      for (int hp = 0; hp < 4; ++hp) {
        const int head = g * 4 + hp;
        const float* tabh = tab + head * 128;
        bf16x8 qf[4];
#pragma unroll
        for (int ks = 0; ks < 4; ++ks) qf[ks] = ldg8(proj + tok * EIN + C_NQ + head * 64 + ks * 16 + hh * 8);
        f32x16 O[2]; O[0] = zero16(); O[1] = zero16();
        float m = NEGB, l = 0.f;
        bf16x8 kf[4];
        const unsigned kwo = (unsigned)((b * SEQ + s_lo + pr) * EIN + C_KW + g * 64 + hh * 8);
        const unsigned vwo = (unsigned)(((b * 2 + g) * 64 + l31) * SEQ + s_lo + hh * 8);
#pragma unroll
        for (int ks = 0; ks < 4; ++ks) kf[ks] = ldg8(proj + kwo + ks * 16);
#pragma unroll 1
        for (int wt = 0; wt < nwt; ++wt) {
          const int s0 = s_lo + wt * 32;
          bf16x8 vf[4];
#pragma unroll
          for (int st = 0; st < 2; ++st)
#pragma unroll
            for (int et = 0; et < 2; ++et) vf[st * 2 + et] = ldg8(vwT + vwo + (unsigned)(et * 32 * SEQ + wt * 32 + st * 16));
          f32x16 s = zero16();
#pragma unroll
          for (int ks = 0; ks < 4; ++ks) s = MFMA32(kf[ks], qf[ks], s);
          {
            const int wn_ = wt + 1 < nwt ? wt + 1 : wt;
#pragma unroll
            for (int ks = 0; ks < 4; ++ks) kf[ks] = ldg8(proj + kwo + (unsigned)(wn_ * 32 * EIN + ks * 16));
          }
          float mloc = NEGB;
          const bool full = (s0 + 31 <= t0) && (t0 + 31 - s0 < 512);
          if (full && (t0 - (s0 + 31) >= 127)) {
            const float bf = tabh[127];
#pragma unroll
            for (int i = 0; i < 16; ++i) { float z = fmaf(s[i], C1, bf); s[i] = z; mloc = fmaxf(mloc, z); }
          } else {
#pragma unroll
            for (int i = 0; i < 16; ++i) {
              int key = s0 + (i & 7) + 8 * hh + 16 * (i >> 3);
              int dw = t - key; int dd = dw < 0 ? 0 : (dw > 127 ? 127 : dw);
              float z = (dw >= 0 && dw < 512) ? fmaf(s[i], C1, tabh[dd]) : NEGB;
              s[i] = z; mloc = fmaxf(mloc, z);
            }
          }
          mloc = red_max32(mloc);
          const float mn = fmaxf(m, mloc);
          const float alpha = ex2(m - mn);
          float ls = 0.f;
#pragma unroll
          for (int i = 0; i < 16; ++i) { float p = (s[i] > -1e29f) ? ex2(s[i] - mn) : 0.f; s[i] = p; ls += p; }
          l = l * alpha + ls; m = mn;
#pragma unroll
          for (int et = 0; et < 2; ++et)
#pragma unroll
            for (int i = 0; i < 16; ++i) O[et][i] *= alpha;
#pragma unroll
          for (int st = 0; st < 2; ++st) {
            bf16x8 pf = pack8(s, st);
#pragma unroll
            for (int et = 0; et < 2; ++et) O[et] = MFMA32(vf[st * 2 + et], pf, O[et]);
          }
        }
        const float lt = red_sum32(l);
        const float g2 = sigmoidf_(bf2f(proj[tok * EIN + C_GATE + head * 3 + 2])) / lt;
        float* pp = part + (tok * 8 + head) * 64;
#pragma unroll
        for (int et = 0; et < 2; ++et)
#pragma unroll
          for (int gq = 0; gq < 4; ++gq) {
            float4 r = *(float4*)(pp + et * 32 + 8 * gq + 4 * hh);
            r.x += g2 * O[et][4 * gq]; r.y += g2 * O[et][4 * gq + 1]; r.z += g2 * O[et][4 * gq + 2]; r.w += g2 * O[et][4 * gq + 3];
            *(float4*)(pp + et * 32 + 8 * gq + 4 * hh) = r;
          }
      }
    }
    __builtin_amdgcn_fence(__ATOMIC_SEQ_CST, "workgroup");
    {
      const int col = lane & 15, q4 = lane >> 4;
      const int qq = col >> 2, hcol = g * 4 + (col & 3);
      const float* tabc = tab + hcol * 128;
      const int rk = 8 * (col >> 2) + (col & 3);
      const unsigned kbase = (unsigned)((b * SEQ + rk) * EIN + C_KS + g * 64 + q4 * 8);
      const unsigned vbase = (unsigned)(((b * 2 + g) * 64 + col) * SEQ + q4 * 8);
#pragma unroll 1
      for (int grp_ = 0; grp_ < 8 * REP_C; ++grp_) {
        const int grp = grp_ & 7;
        const int tq = t0 + grp * 4 + qq;
        const int tmin = t0 + grp * 4, tmax = tmin + 3;
        const size_t tokq = (size_t)b * SEQ + tq;
        const u32x4 mym = *(const u32x4*)(selL + (grp * 4 + qq) * 16);
        unsigned u0, u1, u2, u3;
        {
          const u32x4 a0 = *(const u32x4*)(selL + (grp * 4 + 0) * 16), a1 = *(const u32x4*)(selL + (grp * 4 + 1) * 16);
          const u32x4 a2 = *(const u32x4*)(selL + (grp * 4 + 2) * 16), a3 = *(const u32x4*)(selL + (grp * 4 + 3) * 16);
          const u32x4 uu = a0 | a1 | a2 | a3;
          u0 = __builtin_amdgcn_readfirstlane(uu.x); u1 = __builtin_amdgcn_readfirstlane(uu.y);
          u2 = __builtin_amdgcn_readfirstlane(uu.z); u3 = __builtin_amdgcn_readfirstlane(uu.w);
          const int cbm = tmax >> 6;
          if (cbm < 31) { u0 &= (2u << cbm) - 1u; u1 = 0u; u2 = 0u; u3 = 0u; }
          else if (cbm < 63) { u1 &= (2u << (cbm - 32)) - 1u; u2 = 0u; u3 = 0u; }
          else if (cbm < 95) { u2 &= (2u << (cbm - 64)) - 1u; u3 = 0u; }
          else if (cbm < 127) { u3 &= (2u << (cbm - 96)) - 1u; }
        }
        auto next_blk = [&]() -> int {
          if (u0) { int bq = __builtin_ctz(u0); u0 &= u0 - 1u; return bq; }
          if (u1) { int bq = __builtin_ctz(u1); u1 &= u1 - 1u; return 32 + bq; }
          if (u2) { int bq = __builtin_ctz(u2); u2 &= u2 - 1u; return 64 + bq; }
          if (u3) { int bq = __builtin_ctz(u3); u3 &= u3 - 1u; return 96 + bq; }
          return -1;
        };
        bf16x8 qf[2];
#pragma unroll
        for (int st = 0; st < 2; ++st) qf[st] = ldg8(proj + tokq * EIN + C_NQ + hcol * 64 + st * 32 + q4 * 8);
        f32x4 O[4];
#pragma unroll
        for (int e = 0; e < 4; ++e) O[e] = (f32x4){0.f, 0.f, 0.f, 0.f};
        float m = NEGB, l = 0.f;
        bf16x8 kf[8], vf[8];
        auto load_k = [&](int jb) {
          const unsigned ko = kbase + (unsigned)(jb * 64 * EIN);
#pragma unroll
          for (int hf = 0; hf < 2; ++hf)
#pragma unroll
            for (int tl = 0; tl < 2; ++tl) {
              kf[(hf * 2 + tl) * 2 + 0] = ldg8(proj + ko + (unsigned)((hf * 32 + 4 * tl) * EIN));
              kf[(hf * 2 + tl) * 2 + 1] = ldg8(proj + ko + (unsigned)((hf * 32 + 4 * tl) * EIN + 32));
            }
        };
        auto load_v = [&](int jb) {
          const unsigned vo = vbase + (unsigned)(jb * 64);
#pragma unroll
          for (int hf = 0; hf < 2; ++hf)
#pragma unroll
            for (int e = 0; e < 4; ++e) vf[hf * 4 + e] = ldg8(vsT + vo + (unsigned)(e * 16 * SEQ + hf * 32));
        };
        int jb = next_blk();
        if (jb >= 0) { load_k(jb); load_v(jb); }
        while (jb >= 0) {
          const int base = jb * 64;
          const unsigned mw = jb < 32 ? mym.x : (jb < 64 ? mym.y : (jb < 96 ? mym.z : mym.w));
          const bool member = (mw >> (jb & 31)) & 1u;
          f32x4 a[2][2];
#pragma unroll
          for (int hf = 0; hf < 2; ++hf)
#pragma unroll
            for (int tl = 0; tl < 2; ++tl) {
              f32x4 acc = (f32x4){0.f, 0.f, 0.f, 0.f};
              acc = MFMA16(kf[(hf * 2 + tl) * 2 + 0], qf[0], acc);
              acc = MFMA16(kf[(hf * 2 + tl) * 2 + 1], qf[1], acc);
              a[hf][tl] = acc;
            }
          const int jn = next_blk();
          if (jn >= 0) load_k(jn);
          float mloc = NEGB;
          if (tmin - (base + 63) >= 127) {
            const float bf = tabc[127];
#pragma unroll
            for (int hf = 0; hf < 2; ++hf)
#pragma unroll
              for (int tl = 0; tl < 2; ++tl)
#pragma unroll
                for (int j = 0; j < 4; ++j) { float z = member ? fmaf(a[hf][tl][j], C1, bf) : NEGB; a[hf][tl][j] = z; mloc = fmaxf(mloc, z); }
          } else {
#pragma unroll
            for (int hf = 0; hf < 2; ++hf)
#pragma unroll
              for (int tl = 0; tl < 2; ++tl)
#pragma unroll
                for (int j = 0; j < 4; ++j) {
                  int key = base + hf * 32 + 8 * q4 + 4 * tl + j;
                  int dist = tq - key; int dd = dist < 0 ? 0 : (dist > 127 ? 127 : dist);
                  float z = (dist < 0 || !member) ? NEGB : fmaf(a[hf][tl][j], C1, tabc[dd]);
                  a[hf][tl][j] = z; mloc = fmaxf(mloc, z);
                }
          }
          mloc = red_max16(mloc);
          mloc = red_max32(mloc);
          const float mn = fmaxf(m, mloc);
          const float alpha = ex2(m - mn);
          float ls = 0.f;
#pragma unroll
          for (int hf = 0; hf < 2; ++hf)
#pragma unroll
            for (int tl = 0; tl < 2; ++tl)
#pragma unroll
              for (int j = 0; j < 4; ++j) { float p = (a[hf][tl][j] > -1e29f) ? ex2(a[hf][tl][j] - mn) : 0.f; a[hf][tl][j] = p; ls += p; }
          l = l * alpha + ls; m = mn;
#pragma unroll
          for (int e = 0; e < 4; ++e) O[e] *= alpha;
#pragma unroll
          for (int hf = 0; hf < 2; ++hf) {
            u32x4 u; u.x = pk2(a[hf][0][0], a[hf][0][1]); u.y = pk2(a[hf][0][2], a[hf][0][3]); u.z = pk2(a[hf][1][0], a[hf][1][1]); u.w = pk2(a[hf][1][2], a[hf][1][3]);
            const bf16x8 pf = __builtin_bit_cast(bf16x8, u);
#pragma unroll
            for (int e = 0; e < 4; ++e) O[e] = MFMA16(vf[hf * 4 + e], pf, O[e]);
          }
          if (jn >= 0) load_v(jn);
          jb = jn;
        }
        l = red_sum16(l);
        l = red_sum32(l);
        {
          const float g1 = sigmoidf_(bf2f(proj[tokq * EIN + C_GATE + hcol * 3 + 1])) / l;
          const float* pp = part + (tokq * 8 + hcol) * 64;
          bf16_t* op = ao + tokq * DM + hcol * 64;
#pragma unroll
          for (int e = 0; e < 4; ++e) {
            float4 pv = *(const float4*)(pp + e * 16 + 4 * q4);
            *(u32x2*)(op + e * 16 + 4 * q4) = pk4(pv.x + g1 * O[e][0], pv.y + g1 * O[e][1], pv.z + g1 * O[e][2], pv.w + g1 * O[e][3]);
          }
        }
      }
    }
  }
}

DI void ckv_norm_phase(KParamPtr P, int wv, int i2) {
  unsigned char* wsq = opqp(P->ws);
  const bf16_t* proj = (const bf16_t*)(wsq + OFF_U + U_PROJ);
  bf16_t* ckv = (bf16_t*)(wsq + OFF_MISC + 12 * MiB);
  const float* gn = P->in[15] + (size_t)i2 * 128;
  const int tid_ = tid_of(wv); const int lane = tid_ & 63, wave = tid_ >> 6;
  const int nw = gridDim.x * 8, gw = blockIdx.x * 8 + wave;
  const float g0 = gn[2 * lane], g1 = gn[2 * lane + 1];
  for (int tk = gw; tk < NTOK; tk += nw) {
    unsigned u = *(const unsigned*)(proj + (size_t)tk * EIN + C_DKV + 2 * lane);
    float a = __uint_as_float(u << 16), c = __uint_as_float(u & 0xffff0000u);
    float ss = wave_sum(a * a + c * c, lane);
    float rs = rsqrtf(ss * (1.f / 128.f) + 1e-5f);
    *(unsigned*)(ckv + (size_t)tk * 128 + 2 * lane) = pk2(a * rs * g0, c * rs * g1);
  }
}

DI unsigned fkey(float f) { unsigned u = __float_as_uint(f); return (u & 0x80000000u) ? ~u : (u | 0x80000000u); }

DI void dsa_index_phase(unsigned char* lds, KParamPtr P, int wv) {
  unsigned char* wsq = opqp(P->ws);
  float* sc = (float*)(lds + LDS_WORK);
  unsigned* hist = (unsigned*)(lds + LDS_WORK + 131072);
  const bf16_t* proj = (const bf16_t*)(wsq + OFF_U + U_PROJ);
  unsigned short* idx = (unsigned short*)(wsq + OFF_U + U_IDX);
  const int tid = tid_of(wv), lane = tid & 63, wave = tid >> 6, l31 = lane & 31, hh = lane >> 5;
  const int rhead = (l31 & 3) + 4 * ((l31 >> 3) & 1), ru = 2 * ((l31 >> 2) & 1) + (l31 >> 4);
  const unsigned long long lt_mask = (lane == 0) ? 0ull : (~0ull >> (64 - lane));
  __syncthreads();
  if (wave < 4) { const unsigned z0 = (unsigned)opq(0); unsigned* hz = hist + wave * 256 + lane * 4; hz[0] = z0; hz[1] = z0; hz[2] = z0; hz[3] = z0; }
  lds_barrier();
  for (int item = blockIdx.x; item < 8192; item += gridDim.x) {
    const int b = (item & 7) >> 1, t0 = (((item >> 3) << 1) + (item & 1)) * 4;
    const int ntile = (t0 + 4 + 31) >> 5;
    bf16x8 af[4];
    const bf16_t* iqp = proj + (size_t)(b * SEQ + t0 + ru) * EIN + C_IQ + rhead * 64 + hh * 8;
#pragma unroll
    for (int ks = 0; ks < 4; ++ks) af[ks] = ldg8(iqp + ks * 16);
    float w[16];
#pragma unroll
    for (int i = 0; i < 16; ++i) {
      const int uq = 2 * hh + (i >> 3), hd = (i & 3) + 4 * ((i >> 2) & 1);
      w[i] = bf2f(proj[(size_t)(b * SEQ + t0 + uq) * EIN + C_IW + hd]) * 0.04419417382415922f;
    }
#pragma unroll 1
    for (int kt0 = wave * 4; kt0 < ntile; kt0 += 32) {
      bf16x8 kf[4][4];
      const unsigned ko = (unsigned)((b * SEQ + kt0 * 32 + l31) * EIN + C_IK + hh * 8);
#pragma unroll
      for (int u = 0; u < 4; ++u)
#pragma unroll
        for (int ks = 0; ks < 4; ++ks) kf[u][ks] = ldg8(proj + ko + (unsigned)(u * 32 * EIN + ks * 16));
#pragma unroll
      for (int u = 0; u < 4; ++u) {
        f32x16 acc = zero16();
#pragma unroll
        for (int ks = 0; ks < 4; ++ks) acc = MFMA32(af[ks], kf[u][ks], acc);
        float s0 = 0.f, s1 = 0.f;
#pragma unroll
        for (int i = 0; i < 8; ++i) { s0 += w[i] * fmaxf(acc[i], 0.f); s1 += w[8 + i] * fmaxf(acc[8 + i], 0.f); }
        const int key = (kt0 + u) * 32 + l31;
        s0 += 0.f; s1 += 0.f;
        sc[(2 * hh) * 8192 + key] = s0;
        sc[(2 * hh + 1) * 8192 + key] = s1;
        if (key <= t0 + 2 * hh) atomicAdd(hist + (2 * hh) * 256 + (fkey(s0) >> 24), 1u);
        if (key <= t0 + 2 * hh + 1) atomicAdd(hist + (2 * hh + 1) * 256 + (fkey(s1) >> 24), 1u);
      }
    }
    const int qs = wave & 3, half = wave >> 2;
    const int n = t0 + qs + 1;
    const float* scq = sc + qs * 8192;
    unsigned short* out = idx + (size_t)(b * SEQ + t0 + qs) * 256;
    unsigned* H0 = hist + qs * 256;
    unsigned* H1 = hist + 1024 + qs * 256;
    const bool big = n > 256;
    if (!big && half == 0) { for (int i = lane; i < 256; i += 64) out[i] = (unsigned short)(i < n ? i : 0xFFFF); }
    lds_barrier();
    unsigned prefix = 0; int Kr = 256;
#pragma unroll 1
    for (int pass = 0; pass < 4; ++pass) {
      unsigned* Hc = (pass & 1) ? H1 : H0;
      unsigned* Hn = (pass & 1) ? H0 : H1;
      const int shift = 24 - 8 * pass;
      if (big && pass > 0) {
        f32x4 vnx = *(const f32x4*)(scq + half * 256 + lane * 4);
        for (int c = half; c * 256 < n; c += 2) {
          const int i0 = c * 256 + lane * 4;
          const f32x4 v = vnx;
          { const int cn = (c + 2) * 256 < n ? c + 2 : c; vnx = *(const f32x4*)(scq + cn * 256 + lane * 4); }
#pragma unroll
          for (int e = 0; e < 4; ++e) {
            const unsigned u = fkey(v[e]);
            const bool match = (i0 + e < n) && ((pass == 0) || ((u >> ((shift + 8) & 31)) == prefix));
            if (match) atomicAdd(Hc + ((u >> shift) & 255u), 1u);
          }
        }
      }
      lds_barrier();
      if (half == 0) { const unsigned z0 = (unsigned)opq(0); Hn[lane * 4] = z0; Hn[lane * 4 + 1] = z0; Hn[lane * 4 + 2] = z0; Hn[lane * 4 + 3] = z0; }
      if (big) {
        const u32x4 hv = *(const u32x4*)(Hc + lane * 4);
        const int sloc = (int)(hv.x + hv.y + hv.z + hv.w);
        int incl = sloc;
#pragma unroll
        for (int off = 1; off < 64; off <<= 1) { int v = bperm_i(lane + off, incl); if (lane + off < 64) incl += v; }
        int cum = incl - sloc;
        bool found = false; int d = 0, nK = 0;
#pragma unroll
        for (int bq = 3; bq >= 0; --bq) {
          const int hbq = (int)hv[bq];
          if (!found && cum < Kr && Kr <= cum + hbq) { found = true; d = lane * 4 + bq; nK = Kr - cum; }
          cum += hbq;
        }
        const unsigned long long mk = __ballot(found);
        const int src = __ffsll((long long)mk) - 1;
        d = bperm_i(src, d); Kr = bperm_i(src, nK);
        prefix = (prefix << 8) | (unsigned)d;
      }
      lds_barrier();
    }
    if (big && half == 0) {
      const unsigned T = prefix;
      int cg_ = 0, ce_ = 0;
      f32x4 vnx = *(const f32x4*)(scq + lane * 4);
      for (int c = 0; c * 256 < n; ++c) {
        const int i0 = c * 256 + lane * 4;
        const f32x4 v = vnx;
        { const int cn = (c + 1) * 256 < n ? c + 1 : c; vnx = *(const f32x4*)(scq + cn * 256 + lane * 4); }
        bool gt[4], eq[4]; unsigned long long mg[4], me[4];
#pragma unroll
        for (int e = 0; e < 4; ++e) {
          const unsigned u = fkey(v[e]);
          gt[e] = (i0 + e < n) && (u > T); eq[e] = (i0 + e < n) && (u == T);
          mg[e] = __ballot(gt[e]); me[e] = __ballot(eq[e]);
        }
        int pg = cg_;
#pragma unroll
        for (int e = 0; e < 4; ++e) {
          if (gt[e]) out[pg + __popcll(mg[e] & lt_mask)] = (unsigned short)(i0 + e);
          pg += __popcll(mg[e]);
        }
        cg_ = pg;
        if ((me[0] | me[1] | me[2] | me[3]) != 0ull) {
          int below = ce_;
#pragma unroll
          for (int e = 0; e < 4; ++e) below += __popcll(me[e] & lt_mask);
          int own = 0;
#pragma unroll
          for (int e = 0; e < 4; ++e) {
            const int rank = below + own;
            if (eq[e] && rank < Kr) out[(256 - Kr) + rank] = (unsigned short)(i0 + e);
            own += eq[e] ? 1 : 0;
          }
#pragma unroll
          for (int e = 0; e < 4; ++e) ce_ += __popcll(me[e]);
        }
      }
    }
    lds_barrier();
  }
}

DI void dsa_sparse_phase(unsigned char* lds, KParamPtr P, int wv) {
  unsigned char* wsq = opqp(P->ws);
  const float* tab = (const float*)(lds + LDS_TAB);
  const int tid = tid_of(wv), lane = tid & 63, wave = tid >> 6;
  bf16_t* gbuf = (bf16_t*)(lds + LDS_WORK + 4096 + wave * 9216);
  unsigned short* idL = (unsigned short*)(lds + LDS_WORK + 4096 + wave * 9216 + 8704);
  __syncthreads();
  bf16_t* qlat = (bf16_t*)(wsq + OFF_U + U_QLAT);
  const bf16_t* ckv = (const bf16_t*)(wsq + OFF_MISC + 12 * MiB);
  const unsigned short* idx = (const unsigned short*)(wsq + OFF_U + U_IDX);
  const int nw = gridDim.x * 8, gw = blockIdx.x * 8 + wave;
  const int col = lane & 15, q4 = lane >> 4;
  const float* tabc = tab + (8 + (col & 7)) * 128;
  const int rk = 8 * (col >> 2) + (col & 3);
  const int grow = lane >> 4, gc16 = lane & 15;
  const bool dealt = (gridDim.x == 256);
  const int g_lo = dealt ? (int)kSpStart[blockIdx.x >> 3] : 0, g_n = dealt ? (int)kSpStart[(blockIdx.x >> 3) + 1] - g_lo : 0;
  auto qmap = [&](int qi) -> int {
    const int w8 = qi & 7, blk = (qi >> 3) & 255, rnd = qi >> 11, x = blk & 7;
    const int gidx = dealt ? g_lo + rnd : rnd * 32 + (blk >> 3);
    return ((x >> 1) << 13) + (((gidx << 1) + (x & 1)) << 3) + w8;
  };
  const int qi_end = dealt ? gw + g_n * nw : NTOK;
  u32x2 idn = (gw < qi_end) ? *(const u32x2*)(idx + (size_t)qmap(gw) * 256 + lane * 4) : (u32x2){0u, 0u};
  for (int qi = gw; qi < qi_end; qi += nw) {
    const int q = qmap(qi);
    const int b = q >> 13, tq = q & (SEQ - 1);
    asm volatile("" ::: "memory");
    *(u32x2*)(idL + lane * 4) = idn;
    asm volatile("" ::: "memory");
    {
      const int qn = qmap(qi + nw < qi_end ? qi + nw : qi);
      idn = *(const u32x2*)(idx + (size_t)qn * 256 + lane * 4);
    }
    bf16x8 qf[4];
#pragma unroll
    for (int st = 0; st < 4; ++st) qf[st] = (col < 8) ? ldg8(qlat + (size_t)q * DM + col * 128 + st * 32 + q4 * 8) : zero8();
    f32x4 O[8];
#pragma unroll
    for (int e = 0; e < 8; ++e) O[e] = (f32x4){0.f, 0.f, 0.f, 0.f};
    float m = NEGB, l = 0.f;
    u32x4 gr[8];
    const unsigned cb = (unsigned)(b * SEQ) * 128u + (unsigned)gc16 * 8u;
#pragma unroll
    for (int i = 0; i < 8; ++i) {
      int id = idL[grow + 4 * i]; id = id > SEQ - 1 ? SEQ - 1 : id;
      gr[i] = *(const u32x4*)(ckv + cb + (unsigned)id * 128u);
    }
#pragma unroll 1
    for (int ch = 0; ch < 8; ++ch) {
#pragma unroll
      for (int i = 0; i < 8; ++i) *(u32x4*)(gbuf + (grow + 4 * i) * 136 + gc16 * 8) = gr[i];
      asm volatile("" ::: "memory");
      {
        const int cn = ch < 7 ? ch + 1 : ch;
#pragma unroll
        for (int i = 0; i < 8; ++i) {
          int id = idL[cn * 32 + grow + 4 * i]; id = id > SEQ - 1 ? SEQ - 1 : id;
          gr[i] = *(const u32x4*)(ckv + cb + (unsigned)id * 128u);
        }
      }
      f32x4 a[2];
#pragma unroll
      for (int tl = 0; tl < 2; ++tl) {
        f32x4 acc = (f32x4){0.f, 0.f, 0.f, 0.f};
#pragma unroll
        for (int st = 0; st < 4; ++st) acc = MFMA16(*(const bf16x8*)(gbuf + (rk + 4 * tl) * 136 + st * 32 + q4 * 8), qf[st], acc);
        a[tl] = acc;
      }
      float mloc = NEGB;
#pragma unroll
      for (int tl = 0; tl < 2; ++tl)
#pragma unroll
        for (int j = 0; j < 4; ++j) {
          const int id = idL[ch * 32 + 8 * q4 + 4 * tl + j];
          const int dist = tq - id; const int dd = dist < 0 ? 0 : (dist > 127 ? 127 : dist);
          const float tb = tabc[dd];
          float z = fmaf(a[tl][j], C1, tb); z = dist < 0 ? NEGB : z;
          a[tl][j] = z; mloc = fmaxf(mloc, z);
        }
      mloc = red_max16(mloc);
      mloc = red_max32(mloc);
      const float mn = fmaxf(m, mloc);
      const float alpha = ex2(m - mn);
      float ls = 0.f;
#pragma unroll
      for (int tl = 0; tl < 2; ++tl)
#pragma unroll
        for (int j = 0; j < 4; ++j) { float p = (a[tl][j] > -1e29f) ? ex2(a[tl][j] - mn) : 0.f; a[tl][j] = p; ls += p; }
      l = l * alpha + ls; m = mn;
#pragma unroll
      for (int e = 0; e < 8; ++e) O[e] *= alpha;
      u32x4 u; u.x = pk2(a[0][0], a[0][1]); u.y = pk2(a[0][2], a[0][3]); u.z = pk2(a[1][0], a[1][1]); u.w = pk2(a[1][2], a[1][3]);
      const bf16x8 pf = __builtin_bit_cast(bf16x8, u);
#pragma unroll
      for (int rt = 0; rt < 8; ++rt) {
        const bf16_t* gp = gbuf + (8 * q4) * 136 + rt * 16 + col;
        u32x4 v;
        v.x = (unsigned)gp[0] | ((unsigned)gp[136] << 16); v.y = (unsigned)gp[2 * 136] | ((unsigned)gp[3 * 136] << 16);
        v.z = (unsigned)gp[4 * 136] | ((unsigned)gp[5 * 136] << 16); v.w = (unsigned)gp[6 * 136] | ((unsigned)gp[7 * 136] << 16);
        O[rt] = MFMA16(__builtin_bit_cast(bf16x8, v), pf, O[rt]);
      }
      asm volatile("" ::: "memory");
    }
    l = red_sum16(l);
    l = red_sum32(l);
    if (col < 8) {
      const float inv = 1.f / l;
      bf16_t* op = qlat + (size_t)q * DM + col * 128;
#pragma unroll
      for (int rt = 0; rt < 8; ++rt) *(u32x2*)(op + rt * 16 + 4 * q4) = pk4(O[rt][0] * inv, O[rt][1] * inv, O[rt][2] * inv, O[rt][3] * inv);
    }
  }
}

DI void gbar(unsigned* cnt, unsigned& target, int tid) {
  asm volatile("s_waitcnt vmcnt(0)" ::: "memory");
  __syncthreads();
  target += gridDim.x;
  if (tid == 0) {
    __builtin_amdgcn_fence(__ATOMIC_RELEASE, "agent");
    asm volatile("s_waitcnt vmcnt(0)" ::: "memory");
    __hip_atomic_fetch_add(cnt, 1u, __ATOMIC_RELAXED, __HIP_MEMORY_SCOPE_AGENT);
    while (__hip_atomic_load(cnt, __ATOMIC_RELAXED, __HIP_MEMORY_SCOPE_AGENT) < target) __builtin_amdgcn_s_sleep(1);
    __builtin_amdgcn_fence(__ATOMIC_ACQUIRE, "agent");
    asm volatile("s_waitcnt vmcnt(0)" ::: "memory");
  }
  __syncthreads();
}

__global__ void __launch_bounds__(NTHREADS) mega(Params P0) {
  extern __shared__ __attribute__((aligned(16))) unsigned char lds[];
  cg::grid_group grid = cg::this_grid();
#define P kparams()
  const int wv = __builtin_amdgcn_readfirstlane((int)(threadIdx.x >> 6));
  const int tid = tid_of(wv);
  {
    float* tab = (float*)(lds + LDS_TAB);
    for (int i = tid; i < 16 * 128; i += NTHREADS) { int col = i >> 7, d = i & 127; tab[i] = P->in[2][(int)kBucket[d] * 16 + col] * LOG2E; }
    __syncthreads();
  }
  const float* ada = (const float*)(opqp(P->ws) + OFF_MISC + MS_ADA);

  unsigned* barp = (unsigned*)(opqp(P->ws) + OFF_BAR);
  unsigned bar_target = 0;
  ada_partial_phase(lds, P, wv);
  wprep_phase(lds, P, wv, 0);
  grid.sync();
  ada_reduce_phase(P, wv);
  gbar(barp, bar_target, tid_of(wv));
  for (int rp = 0; rp < REP_SYNC; ++rp) gbar(barp, bar_target, tid_of(wv));
  ln_mod_phase(P, wv, P->in[0], nullptr, nullptr, nullptr, ada, ada + 1024, false, true);
  gbar(barp, bar_target, tid_of(wv));

#pragma unroll 1
  for (int l = 0; l < 4; ++l) {
    const int i2 = l >> 1;
    unsigned char* ws = opqp(P->ws);
    bf16_t* hb = (bf16_t*)(ws + OFF_HB);
    bf16_t* ao = (bf16_t*)(ws + OFF_AO);
    unsigned char* U = ws + OFF_U;
    unsigned char* WT = ws + OFF_WT;
    const float* ada = (const float*)(ws + OFF_MISC + MS_ADA);
    const float* adal = ada + (size_t)l * 4 * 6144;
    const float* xin = (l == 0) ? P->in[0] : P->out;
    if ((l & 1) == 0) {
      bf16_t* proj = (bf16_t*)(U + U_PROJ);
      bf16_t* qlat = (bf16_t*)(U + U_QLAT);
      bf16_t* hid = (bf16_t*)(ws + OFF_MISC + MS_HID);
      const float* cbias = (const float*)(ws + OFF_MISC + MS_CB);
      for (int rp = 0; rp < REP_GEMM; ++rp) {
      gemm_run(lds, wv, APlain{hb, DM}, (const bf16_t*)(WT + WT_IN), DM, NTOK, EIN, DM, EpiEvenProj{proj, (bf16_t*)(U + U_VST), (bf16_t*)(U + U_VWT)}, 0);
      gbar(barp, bar_target, tid_of(wv)); }
#pragma unroll 1
      for (int kv = 0; kv < 2; ++kv)
        gemm_run(lds, wv, ACmp{proj, kv ? C_VC : C_KC}, (const bf16_t*)(WT + WT_CW1) + kv * 256 * 2048, 2048, 4096, 256, 2048, EpiCmp1{cbias + kv * 256, hid + kv * 4096 * 256}, 16 * kv);
#pragma unroll 1
      for (int h = 0; h < 8; ++h)
        gemm_run(lds, wv, APlain{proj + C_DQ + h * 64, EIN}, (const bf16_t*)(WT + WT_UK) + h * 64, 512, NTOK, 128, 64, EpiRow{qlat + h * 128, DM}, 32 + h * 128);
      ckv_norm_phase(P, wv, i2);
      gbar(barp, bar_target, tid_of(wv));
#pragma unroll 1
      for (int kv = 0; kv < 2; ++kv)
        gemm_run(lds, wv, APlain{hid + kv * 4096 * 256, 256}, (const bf16_t*)(WT + WT_CW2) + kv * 64 * 256, 256, 4096, 64, 256, EpiCmp2{(bf16_t*)(ws + OFF_MISC + MS_KC), (bf16_t*)(ws + OFF_MISC + MS_VCT), kv}, 16 * kv);
      for (int rp = 0; rp < REP_IDX; ++rp) dsa_index_phase(lds, P, wv);
      gbar(barp, bar_target, tid_of(wv));
      for (int rp = 0; rp < REP_NSA; ++rp) nsa_phase(lds, P, wv);
      dsa_sparse_phase(lds, P, wv);
      gbar(barp, bar_target, tid_of(wv));
#pragma unroll 1
      for (int h = 0; h < 8; ++h)
        gemm_run(lds, wv, APlain{qlat + h * 128, DM}, (const bf16_t*)(WT + WT_UV) + h * 64 * 128, 128, NTOK, 64, 128, EpiRow{ao + 512 + h * 64, DM}, h * 128);
      gbar(barp, bar_target, tid_of(wv));
    } else {
      for (int rp = 0; rp < REP_GEMM; ++rp) {
      gemm_run(lds, wv, APlain{hb, DM}, (const bf16_t*)(WT + WT_IN), DM, NTOK, OIN, DM, EpiOddProj{(bf16_t*)(U + U_QK), (bf16_t*)(U + U_VT)}, 0);
      gbar(barp, bar_target, tid_of(wv)); }
      for (int rp = 0; rp < REP_DIFF; ++rp) {
      diff_attn_phase(lds, P, wv, l);
      gbar(barp, bar_target, tid_of(wv)); }
    }
    gemm_run(lds, wv, APlain{ao, DM}, (const bf16_t*)(WT + WT_OUT), DM, NTOK, DM, DM, EpiResid{xin, P->out, adal + 2048}, 0);
    gbar(barp, bar_target, tid_of(wv));
    ln_mod_phase(P, wv, P->out, P->out, P->in[5] + (size_t)(l * 2) * DM, P->in[6] + (size_t)(l * 2) * DM, adal + 3072, adal + 4096, true, true);
    gbar(barp, bar_target, tid_of(wv));
    for (int rp = 0; rp < REP_GEMM; ++rp) {
    gemm_run(lds, wv, APlain{hb, DM}, (const bf16_t*)(WT + WT_M1), DM, NTOK, DFF, DM, EpiSqRelu{(bf16_t*)U}, 0);
    gbar(barp, bar_target, tid_of(wv)); }
    gemm_run(lds, wv, APlain{(const bf16_t*)U, DFF}, (const bf16_t*)(WT + WT_M2), DFF, NTOK, DM, DFF, EpiResid{P->out, P->out, adal + 5120}, 0);
    gbar(barp, bar_target, tid_of(wv));
    ln_mod_phase(P, wv, P->out, P->out, P->in[5] + (size_t)(l * 2 + 1) * DM, P->in[6] + (size_t)(l * 2 + 1) * DM, adal + 4 * 6144, adal + 4 * 6144 + 1024, true, l < 3);
    if (l < 3) { wprep_phase(lds, P, wv, l + 1); gbar(barp, bar_target, tid_of(wv)); }
  }
}

#undef P
extern "C" void kernel_launch(void* const* d_in, const int* in_sizes, int n_in, void* d_out, int out_size, void* d_ws, size_t ws_size, hipStream_t stream) {
  static int grid_blocks = 0;
  if (grid_blocks == 0) {
    int dev = 0, cus = 0, per_cu = 0;
    (void)hipGetDevice(&dev);
    (void)hipDeviceGetAttribute(&cus, hipDeviceAttributeMultiprocessorCount, dev);
    if (hipFuncSetAttribute((const void*)mega, hipFuncAttributeMaxDynamicSharedMemorySize, LDS_BYTES) != hipSuccess) fprintf(stderr, "setattr failed\n");
    (void)hipOccupancyMaxActiveBlocksPerMultiprocessor(&per_cu, (const void*)mega, NTHREADS, LDS_BYTES);
    fprintf(stderr, "cus %d per_cu %d ws_size %zu n_in %d\n", cus, per_cu, ws_size, n_in);
    if (per_cu < 1 || n_in != 24 || ws_size < WS_NEED + 8 * MiB) { fprintf(stderr, "cannot launch\n"); grid_blocks = -1; }
    else grid_blocks = cus;
  }
  if (grid_blocks < 0) return;
  Params p{};
  for (int i = 0; i < 24; ++i) p.in[i] = (const float*)d_in[i];
  p.out = (float*)d_out; p.ws = (unsigned char*)d_ws;
  void* args[] = {&p};
  if (hipMemsetAsync((unsigned char*)d_ws + OFF_BAR, 0, 256, stream) != hipSuccess) fprintf(stderr, "memset failed\n");
  hipError_t e = hipLaunchCooperativeKernel((const void*)mega, dim3(grid_blocks), dim3(NTHREADS), args, LDS_BYTES, stream);
  if (e != hipSuccess) fprintf(stderr, "coop launch failed: %s\n", hipGetErrorString(e));
}
```

```cpp
#include <hip/hip_runtime.h>
#include <hip/hip_bf16.h>
#include <hip/hip_cooperative_groups.h>
#include <cstdio>
namespace cg = cooperative_groups;

#define DI __device__ __forceinline__
#define NTHREADS 512
#ifndef REP_C
#define REP_C 1
#endif
#ifndef REP_SYNC
#define REP_SYNC 0
#endif
#ifndef REP_GEMM
#define REP_GEMM 1
#endif
#ifndef REP_DIFF
#define REP_DIFF 1
#endif
#ifndef REP_NSA
#define REP_NSA 1
#endif
#ifndef REP_IDX
#define REP_IDX 1
#endif
#define LDS_BYTES (144 * 1024)

typedef unsigned short bf16_t;
typedef __attribute__((ext_vector_type(8))) short bf16x8;
typedef __attribute__((ext_vector_type(16))) float f32x16;
typedef __attribute__((ext_vector_type(4))) float f32x4;
typedef __attribute__((ext_vector_type(2))) float f32x2;
typedef __attribute__((ext_vector_type(2))) __bf16 bfx2;
typedef __attribute__((ext_vector_type(4))) unsigned u32x4;
typedef __attribute__((ext_vector_type(2))) unsigned u32x2;

#define MFMA32(a, b, c) __builtin_amdgcn_mfma_f32_32x32x16_bf16((a), (b), (c), 0, 0, 0)
#define MFMA16(a, b, c) __builtin_amdgcn_mfma_f32_16x16x32_bf16((a), (b), (c), 0, 0, 0)

constexpr int SEQ = 8192, NB = 4, DM = 1024, NTOK = NB * SEQ, DFF = 4096;
constexpr int EIN = 2528, OIN = 3072;
constexpr float ALPHA_C = 1.681792830507429f;
constexpr float LOG2E = 1.4426950408889634f;
constexpr float C1 = 0.125f * LOG2E;
constexpr float NEGB = -1e30f;
constexpr int C_NQ = 0, C_KC = 512, C_VC = 640, C_KS = 768, C_VS = 896, C_KW = 1024, C_VW = 1152, C_GATE = 1280, C_DQ = 1304, C_DKV = 1816, C_IQ = 1944, C_IK = 2456, C_IW = 2520;

constexpr size_t MiB = 1024 * 1024;
constexpr size_t OFF_HB = 0;
constexpr size_t OFF_AO = 64 * MiB;
constexpr size_t OFF_U = 128 * MiB;
constexpr size_t OFF_WT = 384 * MiB;
constexpr size_t OFF_MISC = 416 * MiB;
constexpr size_t OFF_BAR = 436 * MiB;
constexpr size_t WS_NEED = 440 * MiB;
constexpr size_t U_PROJ = 0;
constexpr size_t U_VST = 158 * MiB;
constexpr size_t U_VWT = 166 * MiB;
constexpr size_t U_QLAT = 174 * MiB;
constexpr size_t U_IDX = 238 * MiB;
constexpr size_t U_QK = 0;
constexpr size_t U_VT = 128 * MiB;
constexpr size_t WT_IN = 0, WT_OUT = 6 * MiB, WT_M1 = 8 * MiB, WT_M2 = 16 * MiB, WT_CW1 = 24 * MiB, WT_CW2 = 26 * MiB, WT_UK = 27 * MiB, WT_UV = 28 * MiB;
constexpr size_t MS_ADAP = 0;
constexpr size_t MS_ADA = 4 * MiB;
constexpr size_t MS_CB = 5 * MiB;
constexpr size_t MS_KC = 6 * MiB;
constexpr size_t MS_VCT = 7 * MiB;
constexpr size_t MS_HID = 8 * MiB;

struct Params {
  const float* in[24];
  float* out;
  unsigned char* ws;
  int pad0, pad1;
};

__device__ const unsigned short kSpStart[33] = {0, 52, 100, 144, 184, 220, 252, 281, 306, 327, 345, 359, 369, 378, 386, 394, 402, 410, 418, 426, 434, 442, 449, 456, 463, 470, 476, 482, 488, 494, 500, 506, 512};
typedef const __attribute__((address_space(4))) Params* KParamPtr;
__device__ __forceinline__ KParamPtr kparams() { unsigned long long v = (unsigned long long)__builtin_amdgcn_kernarg_segment_ptr(); asm volatile("" : "+s"(v)); return (KParamPtr)v; }
__device__ const unsigned char kBucket[128] = {0, 1, 2, 3, 4, 5, 6, 7, 8, 9, 10, 11, 12, 13, 14, 15, 16, 16, 16, 17, 17, 18, 18, 18, 19, 19, 19, 20, 20, 20, 20, 21, 21, 21, 21, 22, 22, 22, 22, 22, 23, 23, 23, 23, 23, 23, 24, 24, 24, 24, 24, 24, 25, 25, 25, 25, 25, 25, 25, 26, 26, 26, 26, 26, 26, 26, 26, 27, 27, 27, 27, 27, 27, 27, 27, 27, 27, 28, 28, 28, 28, 28, 28, 28, 28, 28, 28, 29, 29, 29, 29, 29, 29, 29, 29, 29, 29, 29, 29, 30, 30, 30, 30, 30, 30, 30, 30, 30, 30, 30, 30, 30, 30, 31, 31, 31, 31, 31, 31, 31, 31, 31, 31, 31, 31, 31, 31, 31};

DI unsigned pk2(float a, float b) { f32x2 v = {a, b}; bfx2 r = __builtin_convertvector(v, bfx2); return __builtin_bit_cast(unsigned, r); }
DI bf16_t f2bf(float a) { return (bf16_t)(pk2(a, 0.f) & 0xffffu); }
DI float bf2f(bf16_t v) { return __uint_as_float(((unsigned)v) << 16); }
DI u32x2 pk4(float a, float b, float c, float d) { u32x2 r; r.x = pk2(a, b); r.y = pk2(c, d); return r; }
DI int opq(int x) { asm volatile("" : "+v"(x)); return x; }
DI float opqf(float x) { asm volatile("" : "+v"(x)); return x; }
template <class T> DI T* opqp(T* p) { unsigned long long v = (unsigned long long)p; asm volatile("" : "+s"(v)); return (T*)v; }
DI int tid_of(int wave_s) { unsigned z = 0; asm volatile("" : "+s"(z)); int l = __builtin_amdgcn_mbcnt_hi(~0u, __builtin_amdgcn_mbcnt_lo(~0u, z)); return wave_s * 64 + l; }
DI float ex2(float x) { return __builtin_amdgcn_exp2f(x); }
DI float bperm_f(int srclane, float v) { return __int_as_float(__builtin_amdgcn_ds_bpermute(srclane << 2, __float_as_int(v))); }
DI int bperm_i(int srclane, int v) { return __builtin_amdgcn_ds_bpermute(srclane << 2, v); }
#define SHXF(v, m) bperm_f(lane ^ (m), (v))
#define SHXI(v, m) bperm_i(lane ^ (m), (v))
DI float red_max32(float x) { auto r = __builtin_amdgcn_permlane32_swap(__float_as_uint(x), __float_as_uint(x), false, false); return fmaxf(__uint_as_float(r[0]), __uint_as_float(r[1])); }
DI float red_max16(float x) { auto r = __builtin_amdgcn_permlane16_swap(__float_as_uint(x), __float_as_uint(x), false, false); return fmaxf(__uint_as_float(r[0]), __uint_as_float(r[1])); }
DI float red_sum32(float x) { auto r = __builtin_amdgcn_permlane32_swap(__float_as_uint(x), __float_as_uint(x), false, false); return __uint_as_float(r[0]) + __uint_as_float(r[1]); }
DI float red_sum16(float x) { auto r = __builtin_amdgcn_permlane16_swap(__float_as_uint(x), __float_as_uint(x), false, false); return __uint_as_float(r[0]) + __uint_as_float(r[1]); }
DI float wave_sum(float v, int lane) {
#pragma unroll
  for (int o = 32; o >= 1; o >>= 1) v += SHXF(v, o);
  return v;
}
DI int pi_row(int r) { return (r & 0x13) | ((r & 4) << 1) | ((r & 8) >> 1); }
DI bf16x8 pack8(const f32x16& x, int s8) {
  u32x4 u; u.x = pk2(x[8 * s8 + 0], x[8 * s8 + 1]); u.y = pk2(x[8 * s8 + 2], x[8 * s8 + 3]); u.z = pk2(x[8 * s8 + 4], x[8 * s8 + 5]); u.w = pk2(x[8 * s8 + 6], x[8 * s8 + 7]);
  return __builtin_bit_cast(bf16x8, u);
}
DI bf16x8 ldg8(const bf16_t* p) { return *(const bf16x8*)p; }
#define GLOAD16(dst, ptr) asm volatile("global_load_dwordx4 %0, %1, off" : "=&v"(dst) : "v"(ptr) : "memory")
DI void lds_barrier() { asm volatile("s_waitcnt lgkmcnt(0)\n\ts_barrier" ::: "memory"); }
DI void vm_wait0() { asm volatile("s_waitcnt vmcnt(0)" ::: "memory"); }
DI bf16x8 zero8() { u32x4 u = {0u, 0u, 0u, 0u}; return __builtin_bit_cast(bf16x8, u); }
DI f32x16 zero16() { f32x16 z;
#pragma unroll
  for (int i = 0; i < 16; ++i) z[i] = 0.f;
  return z; }
DI float sigmoidf_(float x) { return 1.f / (1.f + __expf(-x)); }
DI float gelu_tanh(float x) { float u = 0.7978845608028654f * (x + 0.044715f * x * x * x); float e = __expf(2.f * u); float th = 1.f - 2.f / (e + 1.f); return 0.5f * x * (1.f + th); }

constexpr int LROW = 72;
constexpr int LDS_TAB = 0;
constexpr int LDS_WORK = 8192;

struct APlain { const bf16_t* A; int lda; DI const bf16_t* base() const { return A; } DI unsigned rowoff(int m) const { return (unsigned)(m * lda); } DI unsigned koff(int k) const { return (unsigned)k; } };
struct ACmp {
  const bf16_t* proj; int col0;
  DI const bf16_t* base() const { return proj; }
  DI unsigned rowoff(int m) const { int combo = m >> 9, n = m & 511, b = combo >> 1, g = combo & 1; return (unsigned)((b * SEQ + 16 * n) * EIN + col0 + g * 64); }
  DI unsigned koff(int k) const { return (unsigned)((k >> 6) * EIN + (k & 63)); }
};

typedef __attribute__((address_space(3))) unsigned lds_u32_t;
DI void dma16(const void* g, unsigned char* l) { __builtin_amdgcn_global_load_lds((const unsigned*)g, (lds_u32_t*)(unsigned)(size_t)l, 16, 0, 0); }
constexpr int GST = 65536;
template <class AF, class EF>
DI void gemm_run(unsigned char* lds, int wv, const AF& af, const bf16_t* __restrict__ Bt, int ldb, int M, int N, int K, const EF& ef, int blk_off) {
  unsigned char* sBase = lds + LDS_WORK;
  const int tid = tid_of(wv), lane = tid & 63, wave = tid >> 6;
  const int wn = wave & 3, wm = wave >> 2;
  const int l15 = lane & 15, q4 = lane >> 4;
  const int mtiles = M >> 8, ntiles = (N + 255) >> 8, ntl = mtiles * ntiles;
  const int G = gridDim.x;
  int first = ((int)blockIdx.x - (blk_off % G) + G) % G;
  const int nk = K >> 6;
  const bool xmap = (blk_off == 0) && ((mtiles & 7) == 0) && ((G & 7) == 0);
  int tstep = G;
  if (xmap) { first = (int)blockIdx.x >> 3; tstep = G >> 3; }
  const int ntl_eff = xmap ? (ntl >> 3) : ntl;
  const int crow = tid >> 3;
  const int cch = ((tid & 7) ^ ((tid >> 4) & 7)) * 8;
  const int swz = l15 >> 1;
  for (int tile_ = first; tile_ < ntl_eff; tile_ += tstep) {
    int nt, mt;
    if (xmap) { nt = tile_ % ntiles; mt = (tile_ / ntiles) * 8 + ((int)blockIdx.x & 7); }
    else { nt = tile_ % ntiles; mt = tile_ / ntiles; }
    const int m0 = mt << 8, n0 = nt << 8;
    f32x4 acc[4][8];
#pragma unroll
    for (int i = 0; i < 4; ++i)
#pragma unroll
      for (int j = 0; j < 8; ++j) acc[i][j] = (f32x4){0.f, 0.f, 0.f, 0.f};
    unsigned aoff[4], boff[4];
    const bf16_t* Ab = af.base();
#pragma unroll
    for (int i = 0; i < 4; ++i) {
      int row = crow + 64 * i;
      aoff[i] = af.rowoff(m0 + row);
      int n = n0 + row; n = n < N ? n : N - 1;
      boff[i] = (unsigned)(n * ldb + cch);
    }
    __syncthreads();
#pragma unroll
    for (int i = 0; i < 4; ++i) {
      dma16(Ab + aoff[i] + af.koff(cch), sBase + 32768 + (i * 512 + tid) * 16);
      dma16(Bt + boff[i], sBase + (i * 512 + tid) * 16);
    }
    vm_wait0();
    __syncthreads();
#pragma unroll 1
    for (int kt = 0; kt < nk; ++kt) {
      unsigned char* cur = sBase + (kt & 1) * GST;
      if (kt + 1 < nk) {
        unsigned char* nxt = sBase + ((kt + 1) & 1) * GST;
        const int k0 = (kt + 1) << 6;
#pragma unroll
        for (int i = 0; i < 4; ++i) {
          dma16(Ab + aoff[i] + af.koff(k0 + cch), nxt + 32768 + (i * 512 + tid) * 16);
          dma16(Bt + boff[i] + (unsigned)k0, nxt + (i * 512 + tid) * 16);
        }
      }
#pragma unroll
      for (int ks = 0; ks < 2; ++ks) {
        bf16x8 wf[4], xf[8];
#pragma unroll
        for (int i = 0; i < 4; ++i) wf[i] = *(const bf16x8*)(cur + (wn * 64 + i * 16 + l15) * 128 + (((ks * 4 + q4) ^ swz) * 16));
#pragma unroll
        for (int j = 0; j < 8; ++j) xf[j] = *(const bf16x8*)(cur + 32768 + (wm * 128 + j * 16 + l15) * 128 + (((ks * 4 + q4) ^ swz) * 16));
#pragma unroll
        for (int i = 0; i < 4; ++i)
#pragma unroll
          for (int j = 0; j < 8; ++j) acc[i][j] = MFMA16(wf[i], xf[j], acc[i][j]);
      }
      vm_wait0();
      __syncthreads();
    }
#pragma unroll
    for (int ip = 0; ip < 2; ++ip)
#pragma unroll
      for (int j = 0; j < 8; ++j) {
        float lo[4], hi[4];
#pragma unroll
        for (int k = 0; k < 4; ++k) {
          auto r = __builtin_amdgcn_permlane16_swap(__float_as_uint(acc[2 * ip][j][k]), __float_as_uint(acc[2 * ip + 1][j][k]), false, false);
          lo[k] = __uint_as_float(r[0]); hi[k] = __uint_as_float(r[1]);
        }
        int n = n0 + wn * 64 + (2 * ip + (q4 & 1)) * 16 + (q4 >> 1) * 8;
        int m = m0 + wm * 128 + j * 16 + l15;
        if (n < N) ef.store8(m, n, lo[0], lo[1], lo[2], lo[3], hi[0], hi[1], hi[2], hi[3]);
      }
  }
}

struct EpiRow { bf16_t* C; int ldc; DI void store(int m, int n, float a, float b, float c, float d) const { *(u32x2*)(C + (size_t)m * ldc + n) = pk4(a, b, c, d); }
  DI void store8(int m, int n, float a, float b, float c, float d, float e, float f, float g, float h) const { *(u32x4*)(C + (size_t)m * ldc + n) = (u32x4){pk2(a, b), pk2(c, d), pk2(e, f), pk2(g, h)}; } };
struct EpiSqRelu { bf16_t* C; DI void store(int m, int n, float a, float b, float c, float d) const {
    a = fmaxf(a, 0.f); b = fmaxf(b, 0.f); c = fmaxf(c, 0.f); d = fmaxf(d, 0.f);
    *(u32x2*)(C + (size_t)m * DFF + n) = pk4(a * a, b * b, c * c, d * d); }
  DI void store8(int m, int n, float a, float b, float c, float d, float e, float f, float g, float h) const {
    a = fmaxf(a, 0.f); b = fmaxf(b, 0.f); c = fmaxf(c, 0.f); d = fmaxf(d, 0.f); e = fmaxf(e, 0.f); f = fmaxf(f, 0.f); g = fmaxf(g, 0.f); h = fmaxf(h, 0.f);
    const u32x4 v = (u32x4){pk2(a * a, b * b), pk2(c * c, d * d), pk2(e * e, f * f), pk2(g * g, h * h)};
    __builtin_nontemporal_store(v, (u32x4*)(C + (size_t)m * DFF + n)); } };
struct EpiResid { const float* xin; float* out; const float* gate;
  DI void store(int m, int n, float a, float b, float c, float d) const {
    int bb = m >> 13;
    float4 x = *(const float4*)(xin + (size_t)m * DM + n);
    float4 g = *(const float4*)(gate + bb * 6144 + n);
    const float one = opqf(1.0f);
    float4 r; r.x = ALPHA_C * x.x + (one + g.x) * a; r.y = ALPHA_C * x.y + (one + g.y) * b; r.z = ALPHA_C * x.z + (one + g.z) * c; r.w = ALPHA_C * x.w + (one + g.w) * d;
    *(float4*)(out + (size_t)m * DM + n) = r; }
  DI void store8(int m, int n, float a, float b, float c, float d, float e, float f, float g, float h) const { store(m, n, a, b, c, d); store(m, n + 4, e, f, g, h); } };
struct EpiEvenProj { bf16_t* proj; bf16_t* vsT; bf16_t* vwT;
  DI void store(int m, int n, float a, float b, float c, float d) const {
    int bb = m >> 13, s = m & (SEQ - 1);
    if (n >= C_VS && n < C_KW) { int e = n - C_VS; bf16_t* p = vsT + ((size_t)(bb * 128 + e)) * SEQ + s; p[0] = f2bf(a); p[SEQ] = f2bf(b); p[2 * SEQ] = f2bf(c); p[3 * SEQ] = f2bf(d); }
    else if (n >= C_VW && n < C_GATE) { int e = n - C_VW; bf16_t* p = vwT + ((size_t)(bb * 128 + e)) * SEQ + s; p[0] = f2bf(a); p[SEQ] = f2bf(b); p[2 * SEQ] = f2bf(c); p[3 * SEQ] = f2bf(d); }
    else *(u32x2*)(proj + (size_t)m * EIN + n) = pk4(a, b, c, d); }
  DI void store8(int m, int n, float a, float b, float c, float d, float e, float f, float g, float h) const {
    if ((n >= C_VS && n < C_KW) || (n >= C_VW && n < C_GATE)) { store(m, n, a, b, c, d); store(m, n + 4, e, f, g, h); }
    else *(u32x4*)(proj + (size_t)m * EIN + n) = (u32x4){pk2(a, b), pk2(c, d), pk2(e, f), pk2(g, h)}; } };
struct EpiOddProj { bf16_t* qk; bf16_t* vT;
  DI void store(int m, int n, float a, float b, float c, float d) const {
    if (n < 2048) *(u32x2*)(qk + (size_t)m * 2048 + n) = pk4(a, b, c, d);
    else { int bb = m >> 13, s = m & (SEQ - 1); int e = n - 2048; bf16_t* p = vT + ((size_t)(bb * 1024 + e)) * SEQ + s; p[0] = f2bf(a); p[SEQ] = f2bf(b); p[2 * SEQ] = f2bf(c); p[3 * SEQ] = f2bf(d); } }
  DI void store8(int m, int n, float a, float b, float c, float d, float e, float f, float g, float h) const {
    if (n < 2048) *(u32x4*)(qk + (size_t)m * 2048 + n) = (u32x4){pk2(a, b), pk2(c, d), pk2(e, f), pk2(g, h)};
    else { store(m, n, a, b, c, d); store(m, n + 4, e, f, g, h); } } };
struct EpiCmp1 { const float* bias; bf16_t* hid;
  DI void store(int m, int n, float a, float b, float c, float d) const {
    float4 bv = *(const float4*)(bias + n);
    *(u32x2*)(hid + (size_t)m * 256 + n) = pk4(gelu_tanh(a + bv.x), gelu_tanh(b + bv.y), gelu_tanh(c + bv.z), gelu_tanh(d + bv.w)); }
  DI void store8(int m, int n, float a, float b, float c, float d, float e, float f, float g, float h) const { store(m, n, a, b, c, d); store(m, n + 4, e, f, g, h); } };
struct EpiCmp2 { bf16_t* kc; bf16_t* vcT; int kv; DI void store(int m, int n, float a, float b, float c, float d) const {
    int combo = m >> 9, nn = m & 511;
    if (nn == 511) { a = b = c = d = 0.f; }
    if (kv == 0) *(u32x2*)(kc + (size_t)m * 64 + n) = pk4(a, b, c, d);
    else { bf16_t* p = vcT + ((size_t)(combo * 64 + n)) * 512 + nn; p[0] = f2bf(a); p[512] = f2bf(b); p[1024] = f2bf(c); p[1536] = f2bf(d); } }
  DI void store8(int m, int n, float a, float b, float c, float d, float e, float f, float g, float h) const { store(m, n, a, b, c, d); store(m, n + 4, e, f, g, h); } };

DI void tr_convert(unsigned char* lds, int wv, const float* __restrict__ src, int K, int N, bf16_t* __restrict__ dst, int& tb) {
  bf16_t* sT = (bf16_t*)(lds + LDS_WORK);
  const int tid = tid_of(wv), G = gridDim.x;
  const int nkt = K >> 6, nnt = (N + 63) >> 6, ntl = nkt * nnt;
  int first = ((int)blockIdx.x - (tb % G) + G) % G;
  for (int tl = first; tl < ntl; tl += G) {
    const int k0 = (tl / nnt) << 6, n0 = (tl % nnt) << 6;
    const int kk = tid >> 4, n4 = (tid & 15) * 4;
    __syncthreads();
#pragma unroll
    for (int i = 0; i < 2; ++i) {
      int k = kk + 32 * i;
      float4 v = make_float4(0.f, 0.f, 0.f, 0.f);
      if (n0 + n4 < N) v = *(const float4*)(src + (size_t)(k0 + k) * N + n0 + n4);
      sT[(n4 + 0) * LROW + k] = f2bf(v.x); sT[(n4 + 1) * LROW + k] = f2bf(v.y); sT[(n4 + 2) * LROW + k] = f2bf(v.z); sT[(n4 + 3) * LROW + k] = f2bf(v.w);
    }
    __syncthreads();
    const int n = tid >> 3, k8 = (tid & 7) * 8;
    if (n0 + n < N) *(u32x4*)(dst + (size_t)(n0 + n) * K + k0 + k8) = *(const u32x4*)(sT + n * LROW + k8);
  }
  tb += ntl;
}

DI void wprep_phase(unsigned char* lds, KParamPtr P, int wv, int l) {
  unsigned char* wsq = opqp(P->ws);
  bf16_t* WT = (bf16_t*)(wsq + OFF_WT);
  int tb = 0;
  const int i2 = l >> 1;
  tr_convert(lds, wv, P->in[22] + (size_t)l * DM * DFF, DM, DFF, (bf16_t*)((unsigned char*)WT + WT_M1), tb);
  tr_convert(lds, wv, P->in[23] + (size_t)l * DFF * DM, DFF, DM, (bf16_t*)((unsigned char*)WT + WT_M2), tb);
  if ((l & 1) == 0) {
    tr_convert(lds, wv, P->in[7] + (size_t)i2 * DM * EIN, DM, EIN, (bf16_t*)((unsigned char*)WT + WT_IN), tb);
    tr_convert(lds, wv, P->in[8] + (size_t)i2 * DM * DM, DM, DM, (bf16_t*)((unsigned char*)WT + WT_OUT), tb);
    tr_convert(lds, wv, P->in[11] + (size_t)i2 * 2048 * 256, 2048, 256, (bf16_t*)((unsigned char*)WT + WT_CW1), tb);
    tr_convert(lds, wv, P->in[13] + (size_t)i2 * 2048 * 256, 2048, 256, (bf16_t*)((unsigned char*)WT + WT_CW1) + 256 * 2048, tb);
    tr_convert(lds, wv, P->in[12] + (size_t)i2 * 256 * 64, 256, 64, (bf16_t*)((unsigned char*)WT + WT_CW2), tb);
    tr_convert(lds, wv, P->in[14] + (size_t)i2 * 256 * 64, 256, 64, (bf16_t*)((unsigned char*)WT + WT_CW2) + 64 * 256, tb);
    tr_convert(lds, wv, P->in[17] + (size_t)i2 * 128 * 512, 128, 512, (bf16_t*)((unsigned char*)WT + WT_UV), tb);
    {
      const float* src = P->in[16] + (size_t)i2 * 128 * 512; bf16_t* dst = (bf16_t*)((unsigned char*)WT + WT_UK);
      for (int i = (blockIdx.x * NTHREADS + tid_of(wv)) * 4; i < 128 * 512; i += gridDim.x * NTHREADS * 4) {
        float4 v = *(const float4*)(src + i); *(u32x2*)(dst + i) = pk4(v.x, v.y, v.z, v.w);
      }
    }
    {
      float* red = (float*)(lds + LDS_WORK + 16384);
      float* cb = (float*)(wsq + OFF_MISC + MS_CB);
      const int tid_ = tid_of(wv); const int lane = tid_ & 63, wave = tid_ >> 6;
      for (int it = (int)gridDim.x - 1 - (int)blockIdx.x; it < 8; it += gridDim.x) {
        const int kv = it >> 2, n0 = (it & 3) * 64;
        const float* pe = P->in[kv ? 10 : 9] + (size_t)i2 * 2048;
        const float* w1 = P->in[kv ? 13 : 11] + (size_t)i2 * 2048 * 256;
        float a = 0.f;
        for (int k = wave * 256; k < wave * 256 + 256; ++k) a += pe[k] * w1[(size_t)k * 256 + n0 + lane];
        __syncthreads();
        red[wave * 64 + lane] = a;
        __syncthreads();
        if (wave == 0) { float s = 0.f; for (int w = 0; w < 8; ++w) s += red[w * 64 + lane]; cb[kv * 256 + n0 + lane] = s; }
      }
    }
  } else {
    tr_convert(lds, wv, P->in[18] + (size_t)i2 * DM * OIN, DM, OIN, (bf16_t*)((unsigned char*)WT + WT_IN), tb);
    tr_convert(lds, wv, P->in[19] + (size_t)i2 * DM * DM, DM, DM, (bf16_t*)((unsigned char*)WT + WT_OUT), tb);
  }
}

DI void ada_partial_phase(unsigned char* lds, KParamPtr P, int wv) {
  unsigned char* wsq = opqp(P->ws);
  float* cact = (float*)(lds + LDS_WORK);
  float* part = (float*)(wsq + OFF_MISC + MS_ADAP);
  const int tid = tid_of(wv);
  __syncthreads();
  for (int i = tid; i < 4096; i += NTHREADS) { float v = P->in[1][i]; cact[i] = v / (1.f + __expf(-v)); }
  __syncthreads();
  for (int it = blockIdx.x; it < 384; it += gridDim.x) {
    const int kc = it & 7, jc = (it >> 3) % 12, l = it / 96;
    const int j = jc * 512 + tid;
    const float* w = P->in[3] + ((size_t)l * 1024 + kc * 128) * 6144 + j;
    float a0 = 0.f, a1 = 0.f, a2 = 0.f, a3 = 0.f;
#pragma unroll 8
    for (int k = 0; k < 128; ++k) {
      float wgt = w[(size_t)k * 6144];
      int kk = kc * 128 + k;
      a0 += cact[kk] * wgt; a1 += cact[1024 + kk] * wgt; a2 += cact[2048 + kk] * wgt; a3 += cact[3072 + kk] * wgt;
    }
    float* o = part + ((size_t)(kc * 4 + l) * 4) * 6144 + j;
    o[0] = a0; o[6144] = a1; o[2 * 6144] = a2; o[3 * 6144] = a3;
  }
}
DI void ada_reduce_phase(KParamPtr P, int wv) {
  unsigned char* wsq = opqp(P->ws);
  const float* part = (const float*)(wsq + OFF_MISC + MS_ADAP);
  float* ada = (float*)(wsq + OFF_MISC + MS_ADA);
  for (int i = blockIdx.x * NTHREADS + tid_of(wv); i < 4 * 4 * 6144; i += gridDim.x * NTHREADS) {
    int l = i / (4 * 6144), j = i % 6144;
    float s = P->in[4][l * 6144 + j];
#pragma unroll
    for (int kc = 0; kc < 8; ++kc) s += part[(size_t)kc * 4 * 4 * 6144 + i];
    ada[i] = s;
  }
}

DI void ln_mod_phase(KParamPtr P, int wv, const float* src, float* xdst, const float* lng, const float* lnb, const float* sh, const float* sc, bool do_ln, bool write_hb) {
  unsigned char* wsq = opqp(P->ws);
  bf16_t* hb = (bf16_t*)(wsq + OFF_HB);
  const int tid_ = tid_of(wv); const int lane = tid_ & 63, wave = tid_ >> 6;
  const int nw = gridDim.x * 8, gw = blockIdx.x * 8 + wave;
  const int rpw = (NTOK + nw - 1) / nw;
  int r0 = gw * rpw, r1 = r0 + rpw; if (r1 > NTOK) r1 = NTOK;
  float4 g4[4], b4[4], sh4[4], sc4[4];
#pragma unroll
  for (int i = 0; i < 4; ++i) { int c = lane * 4 + 256 * i; if (do_ln) { g4[i] = *(const float4*)(lng + c); b4[i] = *(const float4*)(lnb + c); } }
  int curb = -1;
  const float one = opqf(1.0f);
  f32x4 vn[4];
  if (r0 < r1) {
#pragma unroll
    for (int i = 0; i < 4; ++i) vn[i] = *(const f32x4*)(src + (size_t)r0 * DM + lane * 4 + 256 * i);
  }
  for (int row = r0; row < r1; ++row) {
    const int bb = row >> 13;
    if (bb != curb && write_hb) {
      curb = bb;
#pragma unroll
      for (int i = 0; i < 4; ++i) { int c = lane * 4 + 256 * i; sh4[i] = *(const float4*)(sh + bb * 6144 + c); sc4[i] = *(const float4*)(sc + bb * 6144 + c); }
    }
    float4 v[4];
#pragma unroll
    for (int i = 0; i < 4; ++i) { v[i].x = vn[i][0]; v[i].y = vn[i][1]; v[i].z = vn[i][2]; v[i].w = vn[i][3]; }
    {
      const int rn = row + 1 < r1 ? row + 1 : row;
#pragma unroll
      for (int i = 0; i < 4; ++i) vn[i] = *(const f32x4*)(src + (size_t)rn * DM + lane * 4 + 256 * i);
    }
    if (do_ln) {
      float s = 0.f;
#pragma unroll
      for (int i = 0; i < 4; ++i) s += v[i].x + v[i].y + v[i].z + v[i].w;
      const float mu = wave_sum(s, lane) * (1.f / 1024.f);
      float q = 0.f;
#pragma unroll
      for (int i = 0; i < 4; ++i) { v[i].x -= mu; v[i].y -= mu; v[i].z -= mu; v[i].w -= mu; q += v[i].x * v[i].x + v[i].y * v[i].y + v[i].z * v[i].z + v[i].w * v[i].w; }
      const float rstd = rsqrtf(wave_sum(q, lane) * (1.f / 1024.f) + 1e-5f);
#pragma unroll
      for (int i = 0; i < 4; ++i) {
        v[i].x = v[i].x * rstd * g4[i].x + b4[i].x; v[i].y = v[i].y * rstd * g4[i].y + b4[i].y; v[i].z = v[i].z * rstd * g4[i].z + b4[i].z; v[i].w = v[i].w * rstd * g4[i].w + b4[i].w;
        *(float4*)(xdst + (size_t)row * DM + lane * 4 + 256 * i) = v[i];
      }
    }
    if (write_hb) {
#pragma unroll
      for (int i = 0; i < 4; ++i) {
        *(u32x2*)(hb + (size_t)row * DM + lane * 4 + 256 * i) = pk4(v[i].x * (one + sc4[i].x) + sh4[i].x, v[i].y * (one + sc4[i].y) + sh4[i].y, v[i].z * (one + sc4[i].z) + sh4[i].z, v[i].w * (one + sc4[i].w) + sh4[i].w);
      }
    }
  }
}

DI void diff_attn_phase(unsigned char* lds, KParamPtr P, int wv, int l) {
  unsigned char* wsq = opqp(P->ws);
  const float* tab = (const float*)(lds + LDS_TAB);
  bf16_t* sK = (bf16_t*)(lds + LDS_WORK);
  bf16_t* sV = sK + 64 * LROW;
  const bf16_t* qk = (const bf16_t*)(wsq + OFF_U + U_QK);
  const bf16_t* vT = (const bf16_t*)(wsq + OFF_U + U_VT);
  bf16_t* ao = (bf16_t*)(wsq + OFF_AO);
  const int i2 = l >> 1;
  const int tid = tid_of(wv), lane = tid & 63, wave = tid >> 6, l31 = lane & 31, hh = lane >> 5;
  const float lambda_init = 0.8f - 0.6f * __expf(-0.3f * (float)l);
  float lam_full;
  {
    const float* lam = P->in[20] + (size_t)i2 * 256;
    float s1 = 0.f, s2 = 0.f;
    for (int d = 0; d < 64; ++d) { s1 += lam[d] * lam[64 + d]; s2 += lam[128 + d] * lam[192 + d]; }
    lam_full = __expf(s1) - __expf(s2) + lambda_init;
  }
  const float* subln = P->in[21] + (size_t)i2 * 128;
  const int pr = pi_row(l31);
  for (int it = blockIdx.x; it < 1024; it += gridDim.x) {
    const int rr = it >> 8, kk = it & 255, bh = (kk & 7) * 4 + rr, jq = kk >> 3;
    const int qt = (rr & 1) ? 31 - jq : jq;
    const int b = bh >> 3, h = bh & 7;
    const int Q0 = qt * 256, q0w = Q0 + wave * 32, t = q0w + l31;
    const int nkt = 4 * (qt + 1);
    unsigned* O1L = (unsigned*)(lds + LDS_WORK + 32768) + tid;
#pragma unroll 1
    for (int pass = 0; pass < 2; ++pass) {
      const int col = h * 2 + pass;
      bf16x8 qf[4];
      const bf16_t* qp = qk + (size_t)(b * SEQ + t) * 2048 + h * 128 + pass * 64 + hh * 8;
#pragma unroll
      for (int ks = 0; ks < 4; ++ks) qf[ks] = ldg8(qp + ks * 16);
      f32x16 O[4];
#pragma unroll
      for (int e = 0; e < 4; ++e) O[e] = zero16();
      float m_run = NEGB, l_run = 0.f;
      const float bfar = tab[col * 128 + 127];
      const unsigned kgo = (unsigned)((b * SEQ + (tid >> 3)) * 2048 + 1024 + h * 128 + pass * 64 + (tid & 7) * 8);
      const unsigned vgo = (unsigned)(((b * 8 + h) * 128 + (tid >> 3)) * SEQ + (tid & 7) * 8);
      u32x4 rk = *(const u32x4*)(qk + kgo), rv0 = *(const u32x4*)(vT + vgo), rv1 = *(const u32x4*)(vT + vgo + 64 * SEQ);
      __syncthreads();
      *(u32x4*)(sK + (tid >> 3) * LROW + (tid & 7) * 8) = rk;
      *(u32x4*)(sV + (tid >> 3) * LROW + (tid & 7) * 8) = rv0;
      *(u32x4*)(sV + ((tid >> 3) + 64) * LROW + (tid & 7) * 8) = rv1;
      __syncthreads();
#pragma unroll 1
      for (int kt = 0; kt < nkt; ++kt) {
        if (kt + 1 < nkt) {
          const int kn = kt + 1;
          GLOAD16(rk, qk + kgo + (unsigned)(kn * 64 * 2048));
          GLOAD16(rv0, vT + vgo + (unsigned)(kn * 64));
          GLOAD16(rv1, vT + vgo + (unsigned)(kn * 64 + 64 * SEQ));
        }
#pragma unroll
        for (int sub = 0; sub < 2; ++sub) {
          const int s0 = kt * 64 + sub * 32;
          if (s0 <= q0w + 31) {
            f32x16 s = zero16();
            bf16x8 kf[4], vf[8];
#pragma unroll
            for (int ks = 0; ks < 4; ++ks) kf[ks] = *(const bf16x8*)(sK + (sub * 32 + pr) * LROW + ks * 16 + hh * 8);
#pragma unroll
            for (int st = 0; st < 2; ++st)
#pragma unroll
              for (int e = 0; e < 4; ++e) vf[st * 4 + e] = *(const bf16x8*)(sV + (e * 32 + l31) * LROW + sub * 32 + st * 16 + hh * 8);
            __builtin_amdgcn_sched_barrier(0);
#pragma unroll
            for (int ks = 0; ks < 4; ++ks) s = MFMA32(kf[ks], qf[ks], s);
            float mloc = NEGB;
            const bool far = (q0w - (s0 + 31) >= 127);
            if (far) {
#pragma unroll
              for (int i = 0; i < 16; ++i) mloc = fmaxf(mloc, s[i]);
              mloc = fmaf(mloc, C1, bfar);
            } else {
#pragma unroll
              for (int i = 0; i < 16; ++i) {
                int key = s0 + (i & 7) + 8 * hh + 16 * (i >> 3);
                int dist = t - key; int dd = dist < 0 ? 0 : (dist > 127 ? 127 : dist);
                const float tb = tab[col * 128 + dd];
                float z = fmaf(s[i], C1, tb); z = dist < 0 ? NEGB : z;
                s[i] = z; mloc = fmaxf(mloc, z);
              }
            }
            mloc = red_max32(mloc);
            const float m_new = (mloc > m_run + 16.f) ? mloc : m_run;
            const float alpha = ex2(m_run - m_new);
            float ls = 0.f;
            if (far) {
              const float boff_ = bfar - m_new;
#pragma unroll
              for (int i = 0; i < 16; ++i) { float p = ex2(fmaf(s[i], C1, boff_)); s[i] = p; ls += p; }
            } else {
#pragma unroll
              for (int i = 0; i < 16; ++i) { float p = ex2(s[i] - m_new); s[i] = p; ls += p; }
            }
            l_run = l_run * alpha + ls; m_run = m_new;
            if (__any(alpha != 1.0f)) {
#pragma unroll
              for (int e = 0; e < 4; ++e)
#pragma unroll
                for (int i = 0; i < 16; ++i) O[e][i] *= alpha;
            }
#pragma unroll
            for (int st = 0; st < 2; ++st) {
              bf16x8 pf = pack8(s, st);
#pragma unroll
              for (int e = 0; e < 4; ++e) O[e] = MFMA32(vf[st * 4 + e], pf, O[e]);
            }
          }
        }
        __syncthreads();
        vm_wait0();
        if (kt + 1 < nkt) {
          *(u32x4*)(sK + (tid >> 3) * LROW + (tid & 7) * 8) = rk;
          *(u32x4*)(sV + (tid >> 3) * LROW + (tid & 7) * 8) = rv0;
          *(u32x4*)(sV + ((tid >> 3) + 64) * LROW + (tid & 7) * 8) = rv1;
        }
        __syncthreads();
      }
      const float lt = red_sum32(l_run);
      const float inv = 1.f / lt;
      if (pass == 0) {
#pragma unroll
        for (int e = 0; e < 4; ++e)
#pragma unroll
          for (int i = 0; i < 8; ++i) O1L[(e * 8 + i) * 512] = pk2(O[e][2 * i] * inv, O[e][2 * i + 1] * inv);
      } else {
        float ss = 0.f;
#pragma unroll
        for (int e = 0; e < 4; ++e)
#pragma unroll
          for (int i = 0; i < 16; ++i) {
            const unsigned pw = O1L[(e * 8 + (i >> 1)) * 512];
            float o1 = (i & 1) ? __uint_as_float(pw & 0xffff0000u) : __uint_as_float(pw << 16);
            float o = o1 - lam_full * (O[e][i] * inv); O[e][i] = o; ss += o * o; }
        ss = red_sum32(ss);
        const float rs = rsqrtf(ss * (1.f / 128.f) + 1e-5f) * (1.f - lambda_init);
        bf16_t* op = ao + (size_t)(b * SEQ + t) * DM + h * 128;
#pragma unroll
        for (int e = 0; e < 4; ++e)
#pragma unroll
          for (int g = 0; g < 4; ++g) {
            int ee = e * 32 + 8 * g + 4 * hh;
            float4 sl = *(const float4*)(subln + ee);
            *(u32x2*)(op + ee) = pk4(O[e][4 * g] * rs * sl.x, O[e][4 * g + 1] * rs * sl.y, O[e][4 * g + 2] * rs * sl.z, O[e][4 * g + 3] * rs * sl.w);
          }
      }
    }
  }
}

DI void cmp_z(f32x16& s, int kt, int t, int t0, int hh, const float* tabh, float& mloc) {
  const int nb = kt * 32;
  if (t0 - (16 * (nb + 31) + 31) >= 127) {
    const float bf = tabh[127];
#pragma unroll
    for (int i = 0; i < 16; ++i) { float z = fmaf(s[i], C1, bf); s[i] = z; mloc = fmaxf(mloc, z); }
  } else {
#pragma unroll
    for (int i = 0; i < 16; ++i) {
      int n = nb + (i & 7) + 8 * hh + 16 * (i >> 3);
      int dc = t - (16 * n + 31); int dd = dc < 0 ? 0 : (dc > 127 ? 127 : dc);
      float z = dc < 0 ? NEGB : fmaf(s[i], C1, tabh[dd]);
      s[i] = z; mloc = fmaxf(mloc, z);
    }
  }
}

DI void nsa_phase(unsigned char* lds, KParamPtr P, int wv) {
  unsigned char* wsq = opqp(P->ws);
  const float* tab = (const float*)(lds + LDS_TAB);
  const int tid = tid_of(wv), lane = tid & 63, wave = tid >> 6, l31 = lane & 31, hh = lane >> 5;
  unsigned char* selL = lds + LDS_WORK + wave * 512;
  float* scw = (float*)(lds + LDS_WORK + 4096 + wave * 16384);
  const bf16_t* proj = (const bf16_t*)(wsq + OFF_U + U_PROJ);
  const bf16_t* vsT = (const bf16_t*)(wsq + OFF_U + U_VST);
  const bf16_t* vwT = (const bf16_t*)(wsq + OFF_U + U_VWT);
  const bf16_t* kc = (const bf16_t*)(wsq + OFF_MISC + MS_KC);
  const bf16_t* vcT = (const bf16_t*)(wsq + OFF_MISC + MS_VCT);
  float* part = (float*)(wsq + OFF_HB);
  bf16_t* ao = (bf16_t*)(wsq + OFF_AO);
  const int nw = gridDim.x * 8, gw = blockIdx.x * 8 + wave;
  const int pr = pi_row(l31);
  for (int it = gw; it < 2048; it += nw) {
    const int blk_ = it >> 3, combo_ = blk_ & 7;
    const int b = combo_ >> 1, g = combo_ & 1, tile = ((blk_ >> 3) << 3) + (it & 7), t0 = tile * 32, t = t0 + l31;
    const size_t tok = (size_t)b * SEQ + t;
    const bf16_t* kcb = kc + (size_t)((b * 2 + g) * 512) * 64;
    const bf16_t* vcb = vcT + (size_t)((b * 2 + g) * 64) * 512;
#pragma unroll 1
    for (int x = 0; x < 64; ++x) scw[x * 64 + lane] = 0.f;
    const int nkt = (2 * tile + 1 + 31) >> 5;
#pragma unroll 1
    for (int hp = 0; hp < 4; ++hp) {
      const int head = g * 4 + hp;
      const float* tabh = tab + head * 128;
      bf16x8 qf[4];
#pragma unroll
      for (int ks = 0; ks < 4; ++ks) qf[ks] = ldg8(proj + tok * EIN + C_NQ + head * 64 + ks * 16 + hh * 8);
      float m = NEGB, l = 0.f;
      bf16x8 kf[4];
      const unsigned kco = (unsigned)(pr * 64 + hh * 8);
#pragma unroll
      for (int ks = 0; ks < 4; ++ks) kf[ks] = ldg8(kcb + kco + ks * 16);
#pragma unroll 1
      for (int kt = 0; kt < nkt; ++kt) {
        f32x16 s = zero16();
#pragma unroll
        for (int ks = 0; ks < 4; ++ks) s = MFMA32(kf[ks], qf[ks], s);
        {
          const int kn = kt + 1 < nkt ? kt + 1 : kt;
#pragma unroll
          for (int ks = 0; ks < 4; ++ks) kf[ks] = ldg8(kcb + kco + (unsigned)(kn * 32 * 64 + ks * 16));
        }
        float mloc = NEGB;
        cmp_z(s, kt, t, t0, hh, tabh, mloc);
        mloc = red_max32(mloc);
        const float mn = fmaxf(m, mloc);
        float ls = 0.f;
#pragma unroll
        for (int i = 0; i < 16; ++i) ls += (s[i] > -1e29f) ? ex2(s[i] - mn) : 0.f;
        l = l * ex2(m - mn) + ls; m = mn;
      }
      const float lt = red_sum32(l);
      const float inv = lt > 0.f ? 1.f / lt : 0.f;
      f32x16 O[2]; O[0] = zero16(); O[1] = zero16();
      float carry = 0.f;
#pragma unroll
      for (int ks = 0; ks < 4; ++ks) kf[ks] = ldg8(kcb + kco + ks * 16);
#pragma unroll 1
      for (int kt = 0; kt < nkt; ++kt) {
        {
          bf16x8 vf[4];
#pragma unroll
          for (int st = 0; st < 2; ++st)
#pragma unroll
            for (int et = 0; et < 2; ++et) vf[st * 2 + et] = ldg8(vcb + (unsigned)((et * 32 + l31) * 512 + kt * 32 + st * 16 + hh * 8));
          f32x16 s = zero16();
#pragma unroll
          for (int ks = 0; ks < 4; ++ks) s = MFMA32(kf[ks], qf[ks], s);
          {
            const int kn = kt + 1 < nkt ? kt + 1 : kt;
#pragma unroll
            for (int ks = 0; ks < 4; ++ks) kf[ks] = ldg8(kcb + kco + (unsigned)(kn * 32 * 64 + ks * 16));
          }
          float mloc = NEGB;
          cmp_z(s, kt, t, t0, hh, tabh, mloc);
#pragma unroll
          for (int i = 0; i < 16; ++i) s[i] = (s[i] > -1e29f) ? ex2(s[i] - m) * inv : 0.f;
          const float G00 = s[0] + s[1] + s[2] + s[3], G01 = s[4] + s[5] + s[6] + s[7];
          const float G10 = s[8] + s[9] + s[10] + s[11], G11 = s[12] + s[13] + s[14] + s[15];
          const float pe0 = SHXF(s[7], 32), pe1 = SHXF(s[15], 32);
          const float X0 = hh ? pe0 : carry;
          const float X1 = hh ? pe1 : pe0;
          float* sp = scw + (8 * kt + 2 * hh) * 32 + l31;
          sp[0] += 2.f * G00 - s[3] + X0;
          sp[32] += 2.f * G01 - s[7] + s[3];
          sp[4 * 32] += 2.f * G10 - s[11] + X1;
          sp[5 * 32] += 2.f * G11 - s[15] + s[11];
          carry = pe1;
#pragma unroll
          for (int st = 0; st < 2; ++st) {
            bf16x8 pf = pack8(s, st);
#pragma unroll
            for (int et = 0; et < 2; ++et) O[et] = MFMA32(vf[st * 2 + et], pf, O[et]);
          }
        }
      }
      const float g0 = sigmoidf_(bf2f(proj[tok * EIN + C_GATE + head * 3 + 0]));
      float* pp = part + (tok * 8 + head) * 64;
#pragma unroll
      for (int et = 0; et < 2; ++et)
#pragma unroll
        for (int gq = 0; gq < 4; ++gq) {
          float4 r; r.x = g0 * O[et][4 * gq]; r.y = g0 * O[et][4 * gq + 1]; r.z = g0 * O[et][4 * gq + 2]; r.w = g0 * O[et][4 * gq + 3];
          *(float4*)(pp + et * 32 + 8 * gq + 4 * hh) = r;
        }
    }
    {
      const int cb = t >> 6;
#pragma unroll 1
      for (int r = 0; r < 64; ++r) {
        const int j = 4 * (r >> 1) + (r & 1) + 2 * hh;
        const bool forced = (j == 0) | (j == cb) | (j == cb - 1);
        const float v = scw[j * 32 + l31];
        scw[j * 32 + l31] = forced ? 1e9f : (j <= cb ? v : -1e9f);
      }
      unsigned mk0 = 0u, mk1 = 0u, mk2 = 0u, mk3 = 0u;
#pragma unroll 1
      for (int rd = 0; rd < 16; ++rd) {
        float bv = -INFINITY; int bj = 255;
#pragma unroll 4
        for (int r = 0; r < 64; ++r) {
          const int j = 4 * (r >> 1) + (r & 1) + 2 * hh;
          const float v = scw[j * 32 + l31];
          if (v > bv) { bv = v; bj = j; }
        }
        const float ov = SHXF(bv, 32); const int oj = SHXI(bj, 32);
        const bool other = (ov > bv) || (ov == bv && oj < bj);
        const int wj = other ? oj : bj;
        if (((wj >> 1) & 1) == hh) scw[wj * 32 + l31] = -3e38f;
        const unsigned bit = 1u << (wj & 31); const int wd = wj >> 5;
        mk0 |= wd == 0 ? bit : 0u; mk1 |= wd == 1 ? bit : 0u; mk2 |= wd == 2 ? bit : 0u; mk3 |= wd == 3 ? bit : 0u;
      }
      if (hh == 0) *(u32x4*)(selL + l31 * 16) = (u32x4){mk0, mk1, mk2, mk3};
    }
    {
      const int s_lo = t0 >= 512 ? t0 - 512 : 0;
      const int nwt = (t0 + 32 - s_lo) >> 5;
#pragma unroll 1
      for (int hp = 0; hp < 4; ++hp) {
        const int head = g * 4 + hp;
        const float* tabh = tab + head * 128;
        bf16x8 qf[4];
#pragma unroll
        for (int ks = 0; ks < 4; ++ks) qf[ks] = ldg8(proj + tok * EIN + C_NQ + head * 64 + ks * 16 + hh * 8);
        f32x16 O[2]; O[0] = zero16(); O[1] = zero16();
        float m = NEGB, l = 0.f;
        bf16x8 kf[4];
        const unsigned kwo = (unsigned)((b * SEQ + s_lo + pr) * EIN + C_KW + g * 64 + hh * 8);
        const unsigned vwo = (unsigned)(((b * 2 + g) * 64 + l31) * SEQ + s_lo + hh * 8);
#pragma unroll
        for (int ks = 0; ks < 4; ++ks) kf[ks] = ldg8(proj + kwo + ks * 16);
#pragma unroll 1
        for (int wt = 0; wt < nwt; ++wt) {
          const int s0 = s_lo + wt * 32;
          bf16x8 vf[4];
#pragma unroll
          for (int st = 0; st < 2; ++st)
#pragma unroll
            for (int et = 0; et < 2; ++et) vf[st * 2 + et] = ldg8(vwT + vwo + (unsigned)(et * 32 * SEQ + wt * 32 + st * 16));
          f32x16 s = zero16();
#pragma unroll
          for (int ks = 0; ks < 4; ++ks) s = MFMA32(kf[ks], qf[ks], s);
          {
            const int wn_ = wt + 1 < nwt ? wt + 1 : wt;
#pragma unroll
            for (int ks = 0; ks < 4; ++ks) kf[ks] = ldg8(proj + kwo + (unsigned)(wn_ * 32 * EIN + ks * 16));
          }
          float mloc = NEGB;
          const bool full = (s0 + 31 <= t0) && (t0 + 31 - s0 < 512);
          if (full && (t0 - (s0 + 31) >= 127)) {
            const float bf = tabh[127];
#pragma unroll
            for (int i = 0; i < 16; ++i) { float z = fmaf(s[i], C1, bf); s[i] = z; mloc = fmaxf(mloc, z); }
          } else {
#pragma unroll
            for (int i = 0; i < 16; ++i) {
              int key = s0 + (i & 7) + 8 * hh + 16 * (i >> 3);
              int dw = t - key; int dd = dw < 0 ? 0 : (dw > 127 ? 127 : dw);
              float z = (dw >= 0 && dw < 512) ? fmaf(s[i], C1, tabh[dd]) : NEGB;
              s[i] = z; mloc = fmaxf(mloc, z);
            }
          }
          mloc = red_max32(mloc);
          const float mn = fmaxf(m, mloc);
          const float alpha = ex2(m - mn);
          float ls = 0.f;
#pragma unroll
          for (int i = 0; i < 16; ++i) { float p = (s[i] > -1e29f) ? ex2(s[i] - mn) : 0.f; s[i] = p; ls += p; }
          l = l * alpha + ls; m = mn;
#pragma unroll
          for (int et = 0; et < 2; ++et)
#pragma unroll
            for (int i = 0; i < 16; ++i) O[et][i] *= alpha;
#pragma unroll
          for (int st = 0; st < 2; ++st) {
            bf16x8 pf = pack8(s, st);
#pragma unroll
            for (int et = 0; et < 2; ++et) O[et] = MFMA32(vf[st * 2 + et], pf, O[et]);
          }
        }
        const float lt = red_sum32(l);
        const float g2 = sigmoidf_(bf2f(proj[tok * EIN + C_GATE + head * 3 + 2])) / lt;
        float* pp = part + (tok * 8 + head) * 64;
#pragma unroll
        for (int et = 0; et < 2; ++et)
#pragma unroll
          for (int gq = 0; gq < 4; ++gq) {
            float4 r = *(float4*)(pp + et * 32 + 8 * gq + 4 * hh);
            r.x += g2 * O[et][4 * gq]; r.y += g2 * O[et][4 * gq + 1]; r.z += g2 * O[et][4 * gq + 2]; r.w += g2 * O[et][4 * gq + 3];
            *(float4*)(pp + et * 32 + 8 * gq + 4 * hh) = r;
          }
      }
    }
    __builtin_amdgcn_fence(__ATOMIC_SEQ_CST, "workgroup");
    {
      const int col = lane & 15, q4 = lane >> 4;
      const int qq = col >> 2, hcol = g * 4 + (col & 3);
      const float* tabc = tab + hcol * 128;
      const int rk = 8 * (col >> 2) + (col & 3);
      const unsigned kbase = (unsigned)((b * SEQ + rk) * EIN + C_KS + g * 64 + q4 * 8);
      const unsigned vbase = (unsigned)(((b * 2 + g) * 64 + col) * SEQ + q4 * 8);
#pragma unroll 1
      for (int grp_ = 0; grp_ < 8 * REP_C; ++grp_) {
        const int grp = grp_ & 7;
        const int tq = t0 + grp * 4 + qq;
        const int tmin = t0 + grp * 4, tmax = tmin + 3;
        const size_t tokq = (size_t)b * SEQ + tq;
        const u32x4 mym = *(const u32x4*)(selL + (grp * 4 + qq) * 16);
        unsigned u0, u1, u2, u3;
        {
          const u32x4 a0 = *(const u32x4*)(selL + (grp * 4 + 0) * 16), a1 = *(const u32x4*)(selL + (grp * 4 + 1) * 16);
          const u32x4 a2 = *(const u32x4*)(selL + (grp * 4 + 2) * 16), a3 = *(const u32x4*)(selL + (grp * 4 + 3) * 16);
          const u32x4 uu = a0 | a1 | a2 | a3;
          u0 = __builtin_amdgcn_readfirstlane(uu.x); u1 = __builtin_amdgcn_readfirstlane(uu.y);
          u2 = __builtin_amdgcn_readfirstlane(uu.z); u3 = __builtin_amdgcn_readfirstlane(uu.w);
          const int cbm = tmax >> 6;
          if (cbm < 31) { u0 &= (2u << cbm) - 1u; u1 = 0u; u2 = 0u; u3 = 0u; }
          else if (cbm < 63) { u1 &= (2u << (cbm - 32)) - 1u; u2 = 0u; u3 = 0u; }
          else if (cbm < 95) { u2 &= (2u << (cbm - 64)) - 1u; u3 = 0u; }
          else if (cbm < 127) { u3 &= (2u << (cbm - 96)) - 1u; }
        }
        auto next_blk = [&]() -> int {
          if (u0) { int bq = __builtin_ctz(u0); u0 &= u0 - 1u; return bq; }
          if (u1) { int bq = __builtin_ctz(u1); u1 &= u1 - 1u; return 32 + bq; }
          if (u2) { int bq = __builtin_ctz(u2); u2 &= u2 - 1u; return 64 + bq; }
          if (u3) { int bq = __builtin_ctz(u3); u3 &= u3 - 1u; return 96 + bq; }
          return -1;
        };
        bf16x8 qf[2];
#pragma unroll
        for (int st = 0; st < 2; ++st) qf[st] = ldg8(proj + tokq * EIN + C_NQ + hcol * 64 + st * 32 + q4 * 8);
        f32x4 O[4];
#pragma unroll
        for (int e = 0; e < 4; ++e) O[e] = (f32x4){0.f, 0.f, 0.f, 0.f};
        float m = NEGB, l = 0.f;
        bf16x8 kf[8], vf[8];
        auto load_k = [&](int jb) {
          const unsigned ko = kbase + (unsigned)(jb * 64 * EIN);
#pragma unroll
          for (int hf = 0; hf < 2; ++hf)
#pragma unroll
            for (int tl = 0; tl < 2; ++tl) {
              kf[(hf * 2 + tl) * 2 + 0] = ldg8(proj + ko + (unsigned)((hf * 32 + 4 * tl) * EIN));
              kf[(hf * 2 + tl) * 2 + 1] = ldg8(proj + ko + (unsigned)((hf * 32 + 4 * tl) * EIN + 32));
            }
        };
        auto load_v = [&](int jb) {
          const unsigned vo = vbase + (unsigned)(jb * 64);
#pragma unroll
          for (int hf = 0; hf < 2; ++hf)
#pragma unroll
            for (int e = 0; e < 4; ++e) vf[hf * 4 + e] = ldg8(vsT + vo + (unsigned)(e * 16 * SEQ + hf * 32));
        };
        int jb = next_blk();
        if (jb >= 0) { load_k(jb); load_v(jb); }
        while (jb >= 0) {
          const int base = jb * 64;
          const unsigned mw = jb < 32 ? mym.x : (jb < 64 ? mym.y : (jb < 96 ? mym.z : mym.w));
          const bool member = (mw >> (jb & 31)) & 1u;
          f32x4 a[2][2];
#pragma unroll
          for (int hf = 0; hf < 2; ++hf)
#pragma unroll
            for (int tl = 0; tl < 2; ++tl) {
              f32x4 acc = (f32x4){0.f, 0.f, 0.f, 0.f};
              acc = MFMA16(kf[(hf * 2 + tl) * 2 + 0], qf[0], acc);
              acc = MFMA16(kf[(hf * 2 + tl) * 2 + 1], qf[1], acc);
              a[hf][tl] = acc;
            }
          const int jn = next_blk();
          if (jn >= 0) load_k(jn);
          float mloc = NEGB;
          if (tmin - (base + 63) >= 127) {
            const float bf = tabc[127];
#pragma unroll
            for (int hf = 0; hf < 2; ++hf)
#pragma unroll
              for (int tl = 0; tl < 2; ++tl)
#pragma unroll
                for (int j = 0; j < 4; ++j) { float z = member ? fmaf(a[hf][tl][j], C1, bf) : NEGB; a[hf][tl][j] = z; mloc = fmaxf(mloc, z); }
          } else {
#pragma unroll
            for (int hf = 0; hf < 2; ++hf)
#pragma unroll
              for (int tl = 0; tl < 2; ++tl)
#pragma unroll
                for (int j = 0; j < 4; ++j) {
                  int key = base + hf * 32 + 8 * q4 + 4 * tl + j;
                  int dist = tq - key; int dd = dist < 0 ? 0 : (dist > 127 ? 127 : dist);
                  float z = (dist < 0 || !member) ? NEGB : fmaf(a[hf][tl][j], C1, tabc[dd]);
                  a[hf][tl][j] = z; mloc = fmaxf(mloc, z);
                }
          }
          mloc = red_max16(mloc);
          mloc = red_max32(mloc);
          const float mn = fmaxf(m, mloc);
          const float alpha = ex2(m - mn);
          float ls = 0.f;
#pragma unroll
          for (int hf = 0; hf < 2; ++hf)
#pragma unroll
            for (int tl = 0; tl < 2; ++tl)
#pragma unroll
              for (int j = 0; j < 4; ++j) { float p = (a[hf][tl][j] > -1e29f) ? ex2(a[hf][tl][j] - mn) : 0.f; a[hf][tl][j] = p; ls += p; }
          l = l * alpha + ls; m = mn;
#pragma unroll
          for (int e = 0; e < 4; ++e) O[e] *= alpha;
#pragma unroll
          for (int hf = 0; hf < 2; ++hf) {
            u32x4 u; u.x = pk2(a[hf][0][0], a[hf][0][1]); u.y = pk2(a[hf][0][2], a[hf][0][3]); u.z = pk2(a[hf][1][0], a[hf][1][1]); u.w = pk2(a[hf][1][2], a[hf][1][3]);
            const bf16x8 pf = __builtin_bit_cast(bf16x8, u);
#pragma unroll
            for (int e = 0; e < 4; ++e) O[e] = MFMA16(vf[hf * 4 + e], pf, O[e]);
          }
          if (jn >= 0) load_v(jn);
          jb = jn;
        }
        l = red_sum16(l);
        l = red_sum32(l);
        {
          const float g1 = sigmoidf_(bf2f(proj[tokq * EIN + C_GATE + hcol * 3 + 1])) / l;
          const float* pp = part + (tokq * 8 + hcol) * 64;
          bf16_t* op = ao + tokq * DM + hcol * 64;
#pragma unroll
          for (int e = 0; e < 4; ++e) {
            float4 pv = *(const float4*)(pp + e * 16 + 4 * q4);
            *(u32x2*)(op + e * 16 + 4 * q4) = pk4(pv.x + g1 * O[e][0], pv.y + g1 * O[e][1], pv.z + g1 * O[e][2], pv.w + g1 * O[e][3]);
          }
        }
      }
    }
  }
}

DI void ckv_norm_phase(KParamPtr P, int wv, int i2) {
  unsigned char* wsq = opqp(P->ws);
  const bf16_t* proj = (const bf16_t*)(wsq + OFF_U + U_PROJ);
  bf16_t* ckv = (bf16_t*)(wsq + OFF_MISC + 12 * MiB);
  const float* gn = P->in[15] + (size_t)i2 * 128;
  const int tid_ = tid_of(wv); const int lane = tid_ & 63, wave = tid_ >> 6;
  const int nw = gridDim.x * 8, gw = blockIdx.x * 8 + wave;
  const float g0 = gn[2 * lane], g1 = gn[2 * lane + 1];
  for (int tk = gw; tk < NTOK; tk += nw) {
    unsigned u = *(const unsigned*)(proj + (size_t)tk * EIN + C_DKV + 2 * lane);
    float a = __uint_as_float(u << 16), c = __uint_as_float(u & 0xffff0000u);
    float ss = wave_sum(a * a + c * c, lane);
    float rs = rsqrtf(ss * (1.f / 128.f) + 1e-5f);
    *(unsigned*)(ckv + (size_t)tk * 128 + 2 * lane) = pk2(a * rs * g0, c * rs * g1);
  }
}

DI unsigned fkey(float f) { unsigned u = __float_as_uint(f); return (u & 0x80000000u) ? ~u : (u | 0x80000000u); }

DI void dsa_index_phase(unsigned char* lds, KParamPtr P, int wv) {
  unsigned char* wsq = opqp(P->ws);
  float* sc = (float*)(lds + LDS_WORK);
  unsigned* hist = (unsigned*)(lds + LDS_WORK + 131072);
  const bf16_t* proj = (const bf16_t*)(wsq + OFF_U + U_PROJ);
  unsigned short* idx = (unsigned short*)(wsq + OFF_U + U_IDX);
  const int tid = tid_of(wv), lane = tid & 63, wave = tid >> 6, l31 = lane & 31, hh = lane >> 5;
  const int rhead = (l31 & 3) + 4 * ((l31 >> 3) & 1), ru = 2 * ((l31 >> 2) & 1) + (l31 >> 4);
  const unsigned long long lt_mask = (lane == 0) ? 0ull : (~0ull >> (64 - lane));
  __syncthreads();
  if (wave < 4) { const unsigned z0 = (unsigned)opq(0); unsigned* hz = hist + wave * 256 + lane * 4; hz[0] = z0; hz[1] = z0; hz[2] = z0; hz[3] = z0; }
  lds_barrier();
  for (int item = blockIdx.x; item < 8192; item += gridDim.x) {
    const int b = (item & 7) >> 1, t0 = (((item >> 3) << 1) + (item & 1)) * 4;
    const int ntile = (t0 + 4 + 31) >> 5;
    bf16x8 af[4];
    const bf16_t* iqp = proj + (size_t)(b * SEQ + t0 + ru) * EIN + C_IQ + rhead * 64 + hh * 8;
#pragma unroll
    for (int ks = 0; ks < 4; ++ks) af[ks] = ldg8(iqp + ks * 16);
    float w[16];
#pragma unroll
    for (int i = 0; i < 16; ++i) {
      const int uq = 2 * hh + (i >> 3), hd = (i & 3) + 4 * ((i >> 2) & 1);
      w[i] = bf2f(proj[(size_t)(b * SEQ + t0 + uq) * EIN + C_IW + hd]) * 0.04419417382415922f;
    }
#pragma unroll 1
    for (int kt0 = wave * 4; kt0 < ntile; kt0 += 32) {
      bf16x8 kf[4][4];
      const unsigned ko = (unsigned)((b * SEQ + kt0 * 32 + l31) * EIN + C_IK + hh * 8);
#pragma unroll
      for (int u = 0; u < 4; ++u)
#pragma unroll
        for (int ks = 0; ks < 4; ++ks) kf[u][ks] = ldg8(proj + ko + (unsigned)(u * 32 * EIN + ks * 16));
#pragma unroll
      for (int u = 0; u < 4; ++u) {
        f32x16 acc = zero16();
#pragma unroll
        for (int ks = 0; ks < 4; ++ks) acc = MFMA32(af[ks], kf[u][ks], acc);
        float s0 = 0.f, s1 = 0.f;
#pragma unroll
        for (int i = 0; i < 8; ++i) { s0 += w[i] * fmaxf(acc[i], 0.f); s1 += w[8 + i] * fmaxf(acc[8 + i], 0.f); }
        const int key = (kt0 + u) * 32 + l31;
        s0 += 0.f; s1 += 0.f;
        sc[(2 * hh) * 8192 + key] = s0;
        sc[(2 * hh + 1) * 8192 + key] = s1;
        if (key <= t0 + 2 * hh) atomicAdd(hist + (2 * hh) * 256 + (fkey(s0) >> 24), 1u);
        if (key <= t0 + 2 * hh + 1) atomicAdd(hist + (2 * hh + 1) * 256 + (fkey(s1) >> 24), 1u);
      }
    }
    const int qs = wave & 3, half = wave >> 2;
    const int n = t0 + qs + 1;
    const float* scq = sc + qs * 8192;
    unsigned short* out = idx + (size_t)(b * SEQ + t0 + qs) * 256;
    unsigned* H0 = hist + qs * 256;
    unsigned* H1 = hist + 1024 + qs * 256;
    const bool big = n > 256;
    if (!big && half == 0) { for (int i = lane; i < 256; i += 64) out[i] = (unsigned short)(i < n ? i : 0xFFFF); }
    lds_barrier();
    unsigned prefix = 0; int Kr = 256;
#pragma unroll 1
    for (int pass = 0; pass < 4; ++pass) {
      unsigned* Hc = (pass & 1) ? H1 : H0;
      unsigned* Hn = (pass & 1) ? H0 : H1;
      const int shift = 24 - 8 * pass;
      if (big && pass > 0) {
        f32x4 vnx = *(const f32x4*)(scq + half * 256 + lane * 4);
        for (int c = half; c * 256 < n; c += 2) {
          const int i0 = c * 256 + lane * 4;
          const f32x4 v = vnx;
          { const int cn = (c + 2) * 256 < n ? c + 2 : c; vnx = *(const f32x4*)(scq + cn * 256 + lane * 4); }
#pragma unroll
          for (int e = 0; e < 4; ++e) {
            const unsigned u = fkey(v[e]);
            const bool match = (i0 + e < n) && ((pass == 0) || ((u >> ((shift + 8) & 31)) == prefix));
            if (match) atomicAdd(Hc + ((u >> shift) & 255u), 1u);
          }
        }
      }
      lds_barrier();
      if (half == 0) { const unsigned z0 = (unsigned)opq(0); Hn[lane * 4] = z0; Hn[lane * 4 + 1] = z0; Hn[lane * 4 + 2] = z0; Hn[lane * 4 + 3] = z0; }
      if (big) {
        const u32x4 hv = *(const u32x4*)(Hc + lane * 4);
        const int sloc = (int)(hv.x + hv.y + hv.z + hv.w);
        int incl = sloc;
#pragma unroll
        for (int off = 1; off < 64; off <<= 1) { int v = bperm_i(lane + off, incl); if (lane + off < 64) incl += v; }
        int cum = incl - sloc;
        bool found = false; int d = 0, nK = 0;
#pragma unroll
        for (int bq = 3; bq >= 0; --bq) {
          const int hbq = (int)hv[bq];
          if (!found && cum < Kr && Kr <= cum + hbq) { found = true; d = lane * 4 + bq; nK = Kr - cum; }
          cum += hbq;
        }
        const unsigned long long mk = __ballot(found);
        const int src = __ffsll((long long)mk) - 1;
        d = bperm_i(src, d); Kr = bperm_i(src, nK);
        prefix = (prefix << 8) | (unsigned)d;
      }
      lds_barrier();
    }
    if (big && half == 0) {
      const unsigned T = prefix;
      int cg_ = 0, ce_ = 0;
      f32x4 vnx = *(const f32x4*)(scq + lane * 4);
      for (int c = 0; c * 256 < n; ++c) {
        const int i0 = c * 256 + lane * 4;
        const f32x4 v = vnx;
        { const int cn = (c + 1) * 256 < n ? c + 1 : c; vnx = *(const f32x4*)(scq + cn * 256 + lane * 4); }
        bool gt[4], eq[4]; unsigned long long mg[4], me[4];
#pragma unroll
        for (int e = 0; e < 4; ++e) {
          const unsigned u = fkey(v[e]);
          gt[e] = (i0 + e < n) && (u > T); eq[e] = (i0 + e < n) && (u == T);
          mg[e] = __ballot(gt[e]); me[e] = __ballot(eq[e]);
        }
        int pg = cg_;
#pragma unroll
        for (int e = 0; e < 4; ++e) {
          if (gt[e]) out[pg + __popcll(mg[e] & lt_mask)] = (unsigned short)(i0 + e);
          pg += __popcll(mg[e]);
        }
        cg_ = pg;
        if ((me[0] | me[1] | me[2] | me[3]) != 0ull) {
          int below = ce_;
#pragma unroll
          for (int e = 0; e < 4; ++e) below += __popcll(me[e] & lt_mask);
          int own = 0;
#pragma unroll
          for (int e = 0; e < 4; ++e) {
            const int rank = below + own;
            if (eq[e] && rank < Kr) out[(256 - Kr) + rank] = (unsigned short)(i0 + e);
            own += eq[e] ? 1 : 0;
          }
#pragma unroll
          for (int e = 0; e < 4; ++e) ce_ += __popcll(me[e]);
        }
      }
    }
    lds_barrier();
  }
}

DI void dsa_sparse_phase(unsigned char* lds, KParamPtr P, int wv) {
  unsigned char* wsq = opqp(P->ws);
  const float* tab = (const float*)(lds + LDS_TAB);
  const int tid = tid_of(wv), lane = tid & 63, wave = tid >> 6;
  bf16_t* gbuf = (bf16_t*)(lds + LDS_WORK + 4096 + wave * 9216);
  unsigned short* idL = (unsigned short*)(lds + LDS_WORK + 4096 + wave * 9216 + 8704);
  __syncthreads();
  bf16_t* qlat = (bf16_t*)(wsq + OFF_U + U_QLAT);
  const bf16_t* ckv = (const bf16_t*)(wsq + OFF_MISC + 12 * MiB);
  const unsigned short* idx = (const unsigned short*)(wsq + OFF_U + U_IDX);
  const int nw = gridDim.x * 8, gw = blockIdx.x * 8 + wave;
  const int col = lane & 15, q4 = lane >> 4;
  const float* tabc = tab + (8 + (col & 7)) * 128;
  const int rk = 8 * (col >> 2) + (col & 3);
  const int grow = lane >> 4, gc16 = lane & 15;
  const bool dealt = (gridDim.x == 256);
  const int g_lo = dealt ? (int)kSpStart[blockIdx.x >> 3] : 0, g_n = dealt ? (int)kSpStart[(blockIdx.x >> 3) + 1] - g_lo : 0;
  auto qmap = [&](int qi) -> int {
    const int w8 = qi & 7, blk = (qi >> 3) & 255, rnd = qi >> 11, x = blk & 7;
    const int gidx = dealt ? g_lo + rnd : rnd * 32 + (blk >> 3);
    return ((x >> 1) << 13) + (((gidx << 1) + (x & 1)) << 3) + w8;
  };
  const int qi_end = dealt ? gw + g_n * nw : NTOK;
  u32x2 idn = (gw < qi_end) ? *(const u32x2*)(idx + (size_t)qmap(gw) * 256 + lane * 4) : (u32x2){0u, 0u};
  for (int qi = gw; qi < qi_end; qi += nw) {
    const int q = qmap(qi);
    const int b = q >> 13, tq = q & (SEQ - 1);
    asm volatile("" ::: "memory");
    *(u32x2*)(idL + lane * 4) = idn;
    asm volatile("" ::: "memory");
    {
      const int qn = qmap(qi + nw < qi_end ? qi + nw : qi);
      idn = *(const u32x2*)(idx + (size_t)qn * 256 + lane * 4);
    }
    bf16x8 qf[4];
#pragma unroll
    for (int st = 0; st < 4; ++st) qf[st] = (col < 8) ? ldg8(qlat + (size_t)q * DM + col * 128 + st * 32 + q4 * 8) : zero8();
    f32x4 O[8];
#pragma unroll
    for (int e = 0; e < 8; ++e) O[e] = (f32x4){0.f, 0.f, 0.f, 0.f};
    float m = NEGB, l = 0.f;
    u32x4 gr[8];
    const unsigned cb = (unsigned)(b * SEQ) * 128u + (unsigned)gc16 * 8u;
#pragma unroll
    for (int i = 0; i < 8; ++i) {
      int id = idL[grow + 4 * i]; id = id > SEQ - 1 ? SEQ - 1 : id;
      gr[i] = *(const u32x4*)(ckv + cb + (unsigned)id * 128u);
    }
#pragma unroll 1
    for (int ch = 0; ch < 8; ++ch) {
#pragma unroll
      for (int i = 0; i < 8; ++i) *(u32x4*)(gbuf + (grow + 4 * i) * 136 + gc16 * 8) = gr[i];
      asm volatile("" ::: "memory");
      {
        const int cn = ch < 7 ? ch + 1 : ch;
#pragma unroll
        for (int i = 0; i < 8; ++i) {
          int id = idL[cn * 32 + grow + 4 * i]; id = id > SEQ - 1 ? SEQ - 1 : id;
          gr[i] = *(const u32x4*)(ckv + cb + (unsigned)id * 128u);
        }
      }
      f32x4 a[2];
#pragma unroll
      for (int tl = 0; tl < 2; ++tl) {
        f32x4 acc = (f32x4){0.f, 0.f, 0.f, 0.f};
#pragma unroll
        for (int st = 0; st < 4; ++st) acc = MFMA16(*(const bf16x8*)(gbuf + (rk + 4 * tl) * 136 + st * 32 + q4 * 8), qf[st], acc);
        a[tl] = acc;
      }
      float mloc = NEGB;
#pragma unroll
      for (int tl = 0; tl < 2; ++tl)
#pragma unroll
        for (int j = 0; j < 4; ++j) {
          const int id = idL[ch * 32 + 8 * q4 + 4 * tl + j];
          const int dist = tq - id; const int dd = dist < 0 ? 0 : (dist > 127 ? 127 : dist);
          const float tb = tabc[dd];
          float z = fmaf(a[tl][j], C1, tb); z = dist < 0 ? NEGB : z;
          a[tl][j] = z; mloc = fmaxf(mloc, z);
        }
      mloc = red_max16(mloc);
      mloc = red_max32(mloc);
      const float mn = fmaxf(m, mloc);
      const float alpha = ex2(m - mn);
      float ls = 0.f;
#pragma unroll
      for (int tl = 0; tl < 2; ++tl)
#pragma unroll
        for (int j = 0; j < 4; ++j) { float p = (a[tl][j] > -1e29f) ? ex2(a[tl][j] - mn) : 0.f; a[tl][j] = p; ls += p; }
      l = l * alpha + ls; m = mn;
#pragma unroll
      for (int e = 0; e < 8; ++e) O[e] *= alpha;
      u32x4 u; u.x = pk2(a[0][0], a[0][1]); u.y = pk2(a[0][2], a[0][3]); u.z = pk2(a[1][0], a[1][1]); u.w = pk2(a[1][2], a[1][3]);
      const bf16x8 pf = __builtin_bit_cast(bf16x8, u);
#pragma unroll
      for (int rt = 0; rt < 8; ++rt) {
        const bf16_t* gp = gbuf + (8 * q4) * 136 + rt * 16 + col;
        u32x4 v;
        v.x = (unsigned)gp[0] | ((unsigned)gp[136] << 16); v.y = (unsigned)gp[2 * 136] | ((unsigned)gp[3 * 136] << 16);
        v.z = (unsigned)gp[4 * 136] | ((unsigned)gp[5 * 136] << 16); v.w = (unsigned)gp[6 * 136] | ((unsigned)gp[7 * 136] << 16);
        O[rt] = MFMA16(__builtin_bit_cast(bf16x8, v), pf, O[rt]);
      }
      asm volatile("" ::: "memory");
    }
    l = red_sum16(l);
    l = red_sum32(l);
    if (col < 8) {
      const float inv = 1.f / l;
      bf16_t* op = qlat + (size_t)q * DM + col * 128;
#pragma unroll
      for (int rt = 0; rt < 8; ++rt) *(u32x2*)(op + rt * 16 + 4 * q4) = pk4(O[rt][0] * inv, O[rt][1] * inv, O[rt][2] * inv, O[rt][3] * inv);
    }
  }
}

DI void gbar(unsigned* cnt, unsigned& target, int tid) {
  asm volatile("s_waitcnt vmcnt(0)" ::: "memory");
  __syncthreads();
  target += gridDim.x;
  if (tid == 0) {
    __builtin_amdgcn_fence(__ATOMIC_RELEASE, "agent");
    asm volatile("s_waitcnt vmcnt(0)" ::: "memory");
    __hip_atomic_fetch_add(cnt, 1u, __ATOMIC_RELAXED, __HIP_MEMORY_SCOPE_AGENT);
    while (__hip_atomic_load(cnt, __ATOMIC_RELAXED, __HIP_MEMORY_SCOPE_AGENT) < target) __builtin_amdgcn_s_sleep(1);
    __builtin_amdgcn_fence(__ATOMIC_ACQUIRE, "agent");
    asm volatile("s_waitcnt vmcnt(0)" ::: "memory");
  }
  __syncthreads();
}

__global__ void __launch_bounds__(NTHREADS) mega(Params P0) {
  extern __shared__ __attribute__((aligned(16))) unsigned char lds[];
  cg::grid_group grid = cg::this_grid();
#define P kparams()
  const int wv = __builtin_amdgcn_readfirstlane((int)(threadIdx.x >> 6));
  const int tid = tid_of(wv);
  {
    float* tab = (float*)(lds + LDS_TAB);
    for (int i = tid; i < 16 * 128; i += NTHREADS) { int col = i >> 7, d = i & 127; tab[i] = P->in[2][(int)kBucket[d] * 16 + col] * LOG2E; }
    __syncthreads();
  }
  const float* ada = (const float*)(opqp(P->ws) + OFF_MISC + MS_ADA);

  unsigned* barp = (unsigned*)(opqp(P->ws) + OFF_BAR);
  unsigned bar_target = 0;
  ada_partial_phase(lds, P, wv);
  wprep_phase(lds, P, wv, 0);
  grid.sync();
  ada_reduce_phase(P, wv);
  gbar(barp, bar_target, tid_of(wv));
  for (int rp = 0; rp < REP_SYNC; ++rp) gbar(barp, bar_target, tid_of(wv));
  ln_mod_phase(P, wv, P->in[0], nullptr, nullptr, nullptr, ada, ada + 1024, false, true);
  gbar(barp, bar_target, tid_of(wv));

#pragma unroll 1
  for (int l = 0; l < 4; ++l) {
    const int i2 = l >> 1;
    unsigned char* ws = opqp(P->ws);
    bf16_t* hb = (bf16_t*)(ws + OFF_HB);
    bf16_t* ao = (bf16_t*)(ws + OFF_AO);
    unsigned char* U = ws + OFF_U;
    unsigned char* WT = ws + OFF_WT;
    const float* ada = (const float*)(ws + OFF_MISC + MS_ADA);
    const float* adal = ada + (size_t)l * 4 * 6144;
    const float* xin = (l == 0) ? P->in[0] : P->out;
    if ((l & 1) == 0) {
      bf16_t* proj = (bf16_t*)(U + U_PROJ);
      bf16_t* qlat = (bf16_t*)(U + U_QLAT);
      bf16_t* hid = (bf16_t*)(ws + OFF_MISC + MS_HID);
      const float* cbias = (const float*)(ws + OFF_MISC + MS_CB);
      for (int rp = 0; rp < REP_GEMM; ++rp) {
      gemm_run(lds, wv, APlain{hb, DM}, (const bf16_t*)(WT + WT_IN), DM, NTOK, EIN, DM, EpiEvenProj{proj, (bf16_t*)(U + U_VST), (bf16_t*)(U + U_VWT)}, 0);
      gbar(barp, bar_target, tid_of(wv)); }
#pragma unroll 1
      for (int kv = 0; kv < 2; ++kv)
        gemm_run(lds, wv, ACmp{proj, kv ? C_VC : C_KC}, (const bf16_t*)(WT + WT_CW1) + kv * 256 * 2048, 2048, 4096, 256, 2048, EpiCmp1{cbias + kv * 256, hid + kv * 4096 * 256}, 16 * kv);
#pragma unroll 1
      for (int h = 0; h < 8; ++h)
        gemm_run(lds, wv, APlain{proj + C_DQ + h * 64, EIN}, (const bf16_t*)(WT + WT_UK) + h * 64, 512, NTOK, 128, 64, EpiRow{qlat + h * 128, DM}, 32 + h * 128);
      ckv_norm_phase(P, wv, i2);
      gbar(barp, bar_target, tid_of(wv));
#pragma unroll 1
      for (int kv = 0; kv < 2; ++kv)
        gemm_run(lds, wv, APlain{hid + kv * 4096 * 256, 256}, (const bf16_t*)(WT + WT_CW2) + kv * 64 * 256, 256, 4096, 64, 256, EpiCmp2{(bf16_t*)(ws + OFF_MISC + MS_KC), (bf16_t*)(ws + OFF_MISC + MS_VCT), kv}, 16 * kv);
      for (int rp = 0; rp < REP_IDX; ++rp) dsa_index_phase(lds, P, wv);
      gbar(barp, bar_target, tid_of(wv));
      for (int rp = 0; rp < REP_NSA; ++rp) nsa_phase(lds, P, wv);
      dsa_sparse_phase(lds, P, wv);
      gbar(barp, bar_target, tid_of(wv));
#pragma unroll 1
      for (int h = 0; h < 8; ++h)
        gemm_run(lds, wv, APlain{qlat + h * 128, DM}, (const bf16_t*)(WT + WT_UV) + h * 64 * 128, 128, NTOK, 64, 128, EpiRow{ao + 512 + h * 64, DM}, h * 128);
      gbar(barp, bar_target, tid_of(wv));
    } else {
      for (int rp = 0; rp < REP_GEMM; ++rp) {
      gemm_run(lds, wv, APlain{hb, DM}, (const bf16_t*)(WT + WT_IN), DM, NTOK, OIN, DM, EpiOddProj{(bf16_t*)(U + U_QK), (bf16_t*)(U + U_VT)}, 0);
      gbar(barp, bar_target, tid_of(wv)); }
      for (int rp = 0; rp < REP_DIFF; ++rp) {
      diff_attn_phase(lds, P, wv, l);
      gbar(barp, bar_target, tid_of(wv)); }
    }
    gemm_run(lds, wv, APlain{ao, DM}, (const bf16_t*)(WT + WT_OUT), DM, NTOK, DM, DM, EpiResid{xin, P->out, adal + 2048}, 0);
    gbar(barp, bar_target, tid_of(wv));
    ln_mod_phase(P, wv, P->out, P->out, P->in[5] + (size_t)(l * 2) * DM, P->in[6] + (size_t)(l * 2) * DM, adal + 3072, adal + 4096, true, true);
    gbar(barp, bar_target, tid_of(wv));
    for (int rp = 0; rp < REP_GEMM; ++rp) {
    gemm_run(lds, wv, APlain{hb, DM}, (const bf16_t*)(WT + WT_M1), DM, NTOK, DFF, DM, EpiSqRelu{(bf16_t*)U}, 0);
    gbar(barp, bar_target, tid_of(wv)); }
    gemm_run(lds, wv, APlain{(const bf16_t*)U, DFF}, (const bf16_t*)(WT + WT_M2), DFF, NTOK, DM, DFF, EpiResid{P->out, P->out, adal + 5120}, 0);
    gbar(barp, bar_target, tid_of(wv));
    ln_mod_phase(P, wv, P->out, P->out, P->in[5] + (size_t)(l * 2 + 1) * DM, P->in[6] + (size_t)(l * 2 + 1) * DM, adal + 4 * 6144, adal + 4 * 6144 + 1024, true, l < 3);
    if (l < 3) { wprep_phase(lds, P, wv, l + 1); gbar(barp, bar_target, tid_of(wv)); }
  }
}

#undef P
extern "C" void kernel_launch(void* const* d_in, const int* in_sizes, int n_in, void* d_out, int out_size, void* d_ws, size_t ws_size, hipStream_t stream) {
  static int grid_blocks = 0;
  if (grid_blocks == 0) {
    int dev = 0, cus = 0, per_cu = 0;
    (void)hipGetDevice(&dev);
    (void)hipDeviceGetAttribute(&cus, hipDeviceAttributeMultiprocessorCount, dev);
    if (hipFuncSetAttribute((const void*)mega, hipFuncAttributeMaxDynamicSharedMemorySize, LDS_BYTES) != hipSuccess) fprintf(stderr, "setattr failed\n");
    (void)hipOccupancyMaxActiveBlocksPerMultiprocessor(&per_cu, (const void*)mega, NTHREADS, LDS_BYTES);
    fprintf(stderr, "cus %d per_cu %d ws_size %zu n_in %d\n", cus, per_cu, ws_size, n_in);
    if (per_cu < 1 || n_in != 24 || ws_size < WS_NEED + 8 * MiB) { fprintf(stderr, "cannot launch\n"); grid_blocks = -1; }
    else grid_blocks = cus;
  }
  if (grid_blocks < 0) return;
  Params p{};
  for (int i = 0; i < 24; ++i) p.in[i] = (const float*)d_in[i];
  p.out = (float*)d_out; p.ws = (unsigned char*)d_ws;
  void* args[] = {&p};
  if (hipMemsetAsync((unsigned char*)d_ws + OFF_BAR, 0, 256, stream) != hipSuccess) fprintf(stderr, "memset failed\n");
  hipError_t e = hipLaunchCooperativeKernel((const void*)mega, dim3(grid_blocks), dim3(NTHREADS), args, LDS_BYTES, stream);
  if (e != hipSuccess) fprintf(stderr, "coop launch failed: %s\n", hipGetErrorString(e));
}
```

```cpp
#include <hip/hip_runtime.h>
#include <hip/hip_bf16.h>
#include <hip/hip_cooperative_groups.h>
#include <cstdio>
namespace cg = cooperative_groups;

#define DI __device__ __forceinline__
#define NTHREADS 512
#ifndef REP_C
#define REP_C 1
#endif
#ifndef REP_SYNC
#define REP_SYNC 0
#endif
#ifndef REP_GEMM
#define REP_GEMM 1
#endif
#ifndef REP_DIFF
#define REP_DIFF 1
#endif
#ifndef REP_NSA
#define REP_NSA 1
#endif
#ifndef REP_IDX
#define REP_IDX 1
#endif
#define LDS_BYTES (144 * 1024)

typedef unsigned short bf16_t;
typedef __attribute__((ext_vector_type(8))) short bf16x8;
typedef __attribute__((ext_vector_type(16))) float f32x16;
typedef __attribute__((ext_vector_type(4))) float f32x4;
typedef __attribute__((ext_vector_type(2))) float f32x2;
typedef __attribute__((ext_vector_type(2))) __bf16 bfx2;
typedef __attribute__((ext_vector_type(4))) unsigned u32x4;
typedef __attribute__((ext_vector_type(2))) unsigned u32x2;

#define MFMA32(a, b, c) __builtin_amdgcn_mfma_f32_32x32x16_bf16((a), (b), (c), 0, 0, 0)
#define MFMA16(a, b, c) __builtin_amdgcn_mfma_f32_16x16x32_bf16((a), (b), (c), 0, 0, 0)

constexpr int SEQ = 8192, NB = 4, DM = 1024, NTOK = NB * SEQ, DFF = 4096;
constexpr int EIN = 2528, OIN = 3072;
constexpr float ALPHA_C = 1.681792830507429f;
constexpr float LOG2E = 1.4426950408889634f;
constexpr float C1 = 0.125f * LOG2E;
constexpr float NEGB = -1e30f;
constexpr int C_NQ = 0, C_KC = 512, C_VC = 640, C_KS = 768, C_VS = 896, C_KW = 1024, C_VW = 1152, C_GATE = 1280, C_DQ = 1304, C_DKV = 1816, C_IQ = 1944, C_IK = 2456, C_IW = 2520;

constexpr size_t MiB = 1024 * 1024;
constexpr size_t OFF_HB = 0;
constexpr size_t OFF_AO = 64 * MiB;
constexpr size_t OFF_U = 128 * MiB;
constexpr size_t OFF_WT = 384 * MiB;
constexpr size_t OFF_MISC = 416 * MiB;
constexpr size_t OFF_BAR = 436 * MiB;
constexpr size_t WS_NEED = 440 * MiB;
constexpr size_t U_PROJ = 0;
constexpr size_t U_VST = 158 * MiB;
constexpr size_t U_VWT = 166 * MiB;
constexpr size_t U_QLAT = 174 * MiB;
constexpr size_t U_IDX = 238 * MiB;
constexpr size_t U_QK = 0;
constexpr size_t U_VT = 128 * MiB;
constexpr size_t WT_IN = 0, WT_OUT = 6 * MiB, WT_M1 = 8 * MiB, WT_M2 = 16 * MiB, WT_CW1 = 24 * MiB, WT_CW2 = 26 * MiB, WT_UK = 27 * MiB, WT_UV = 28 * MiB;
constexpr size_t MS_ADAP = 0;
constexpr size_t MS_ADA = 4 * MiB;
constexpr size_t MS_CB = 5 * MiB;
constexpr size_t MS_KC = 6 * MiB;
constexpr size_t MS_VCT = 7 * MiB;
constexpr size_t MS_HID = 8 * MiB;

struct Params {
  const float* in[24];
  float* out;
  unsigned char* ws;
  int pad0, pad1;
};

__device__ const unsigned short kSpStart[33] = {0, 52, 100, 144, 184, 220, 252, 281, 306, 327, 345, 359, 369, 378, 386, 394, 402, 410, 418, 426, 434, 442, 449, 456, 463, 470, 476, 482, 488, 494, 500, 506, 512};
typedef const __attribute__((address_space(4))) Params* KParamPtr;
__device__ __forceinline__ KParamPtr kparams() { unsigned long long v = (unsigned long long)__builtin_amdgcn_kernarg_segment_ptr(); asm volatile("" : "+s"(v)); return (KParamPtr)v; }
__device__ const unsigned char kBucket[128] = {0, 1, 2, 3, 4, 5, 6, 7, 8, 9, 10, 11, 12, 13, 14, 15, 16, 16, 16, 17, 17, 18, 18, 18, 19, 19, 19, 20, 20, 20, 20, 21, 21, 21, 21, 22, 22, 22, 22, 22, 23, 23, 23, 23, 23, 23, 24, 24, 24, 24, 24, 24, 25, 25, 25, 25, 25, 25, 25, 26, 26, 26, 26, 26, 26, 26, 26, 27, 27, 27, 27, 27, 27, 27, 27, 27, 27, 28, 28, 28, 28, 28, 28, 28, 28, 28, 28, 29, 29, 29, 29, 29, 29, 29, 29, 29, 29, 29, 29, 30, 30, 30, 30, 30, 30, 30, 30, 30, 30, 30, 30, 30, 30, 31, 31, 31, 31, 31, 31, 31, 31, 31, 31, 31, 31, 31, 31, 31};

DI unsigned pk2(float a, float b) { f32x2 v = {a, b}; bfx2 r = __builtin_convertvector(v, bfx2); return __builtin_bit_cast(unsigned, r); }
DI bf16_t f2bf(float a) { return (bf16_t)(pk2(a, 0.f) & 0xffffu); }
DI float bf2f(bf16_t v) { return __uint_as_float(((unsigned)v) << 16); }
DI u32x2 pk4(float a, float b, float c, float d) { u32x2 r; r.x = pk2(a, b); r.y = pk2(c, d); return r; }
DI int opq(int x) { asm volatile("" : "+v"(x)); return x; }
DI float opqf(float x) { asm volatile("" : "+v"(x)); return x; }
template <class T> DI T* opqp(T* p) { unsigned long long v = (unsigned long long)p; asm volatile("" : "+s"(v)); return (T*)v; }
DI int tid_of(int wave_s) { unsigned z = 0; asm volatile("" : "+s"(z)); int l = __builtin_amdgcn_mbcnt_hi(~0u, __builtin_amdgcn_mbcnt_lo(~0u, z)); return wave_s * 64 + l; }
DI float ex2(float x) { return __builtin_amdgcn_exp2f(x); }
DI float bperm_f(int srclane, float v) { return __int_as_float(__builtin_amdgcn_ds_bpermute(srclane << 2, __float_as_int(v))); }
DI int bperm_i(int srclane, int v) { return __builtin_amdgcn_ds_bpermute(srclane << 2, v); }
#define SHXF(v, m) bperm_f(lane ^ (m), (v))
#define SHXI(v, m) bperm_i(lane ^ (m), (v))
DI float red_max32(float x) { auto r = __builtin_amdgcn_permlane32_swap(__float_as_uint(x), __float_as_uint(x), false, false); return fmaxf(__uint_as_float(r[0]), __uint_as_float(r[1])); }
DI float red_max16(float x) { auto r = __builtin_amdgcn_permlane16_swap(__float_as_uint(x), __float_as_uint(x), false, false); return fmaxf(__uint_as_float(r[0]), __uint_as_float(r[1])); }
DI float red_sum32(float x) { auto r = __builtin_amdgcn_permlane32_swap(__float_as_uint(x), __float_as_uint(x), false, false); return __uint_as_float(r[0]) + __uint_as_float(r[1]); }
DI float red_sum16(float x) { auto r = __builtin_amdgcn_permlane16_swap(__float_as_uint(x), __float_as_uint(x), false, false); return __uint_as_float(r[0]) + __uint_as_float(r[1]); }
DI float wave_sum(float v, int lane) {
#pragma unroll
  for (int o = 32; o >= 1; o >>= 1) v += SHXF(v, o);
  return v;
}
DI int pi_row(int r) { return (r & 0x13) | ((r & 4) << 1) | ((r & 8) >> 1); }
DI bf16x8 pack8(const f32x16& x, int s8) {
  u32x4 u; u.x = pk2(x[8 * s8 + 0], x[8 * s8 + 1]); u.y = pk2(x[8 * s8 + 2], x[8 * s8 + 3]); u.z = pk2(x[8 * s8 + 4], x[8 * s8 + 5]); u.w = pk2(x[8 * s8 + 6], x[8 * s8 + 7]);
  return __builtin_bit_cast(bf16x8, u);
}
DI bf16x8 ldg8(const bf16_t* p) { return *(const bf16x8*)p; }
#define GLOAD16(dst, ptr) asm volatile("global_load_dwordx4 %0, %1, off" : "=&v"(dst) : "v"(ptr) : "memory")
DI void lds_barrier() { asm volatile("s_waitcnt lgkmcnt(0)\n\ts_barrier" ::: "memory"); }
DI void vm_wait0() { asm volatile("s_waitcnt vmcnt(0)" ::: "memory"); }
DI bf16x8 zero8() { u32x4 u = {0u, 0u, 0u, 0u}; return __builtin_bit_cast(bf16x8, u); }
DI f32x16 zero16() { f32x16 z;
#pragma unroll
  for (int i = 0; i < 16; ++i) z[i] = 0.f;
  return z; }
DI float sigmoidf_(float x) { return 1.f / (1.f + __expf(-x)); }
DI float gelu_tanh(float x) { float u = 0.7978845608028654f * (x + 0.044715f * x * x * x); float e = __expf(2.f * u); float th = 1.f - 2.f / (e + 1.f); return 0.5f * x * (1.f + th); }

constexpr int LROW = 72;
constexpr int LDS_TAB = 0;
constexpr int LDS_WORK = 8192;

struct APlain { const bf16_t* A; int lda; DI const bf16_t* base() const { return A; } DI unsigned rowoff(int m) const { return (unsigned)(m * lda); } DI unsigned koff(int k) const { return (unsigned)k; } };
struct ACmp {
  const bf16_t* proj; int col0;
  DI const bf16_t* base() const { return proj; }
  DI unsigned rowoff(int m) const { int combo = m >> 9, n = m & 511, b = combo >> 1, g = combo & 1; return (unsigned)((b * SEQ + 16 * n) * EIN + col0 + g * 64); }
  DI unsigned koff(int k) const { return (unsigned)((k >> 6) * EIN + (k & 63)); }
};

typedef __attribute__((address_space(3))) unsigned lds_u32_t;
DI void dma16(const void* g, unsigned char* l) { __builtin_amdgcn_global_load_lds((const unsigned*)g, (lds_u32_t*)(unsigned)(size_t)l, 16, 0, 0); }
constexpr int GST = 65536;
template <class AF, class EF>
DI void gemm_run(unsigned char* lds, int wv, const AF& af, const bf16_t* __restrict__ Bt, int ldb, int M, int N, int K, const EF& ef, int blk_off) {
  unsigned char* sBase = lds + LDS_WORK;
  const int tid = tid_of(wv), lane = tid & 63, wave = tid >> 6;
  const int wn = wave & 3, wm = wave >> 2;
  const int l15 = lane & 15, q4 = lane >> 4;
  const int mtiles = M >> 8, ntiles = (N + 255) >> 8, ntl = mtiles * ntiles;
  const int G = gridDim.x;
  int first = ((int)blockIdx.x - (blk_off % G) + G) % G;
  const int nk = K >> 6;
  const bool xmap = (blk_off == 0) && ((mtiles & 7) == 0) && ((G & 7) == 0);
  int tstep = G;
  if (xmap) { first = (int)blockIdx.x >> 3; tstep = G >> 3; }
  const int ntl_eff = xmap ? (ntl >> 3) : ntl;
  const int crow = tid >> 3;
  const int cch = ((tid & 7) ^ ((tid >> 4) & 7)) * 8;
  const int swz = l15 >> 1;
  for (int tile_ = first; tile_ < ntl_eff; tile_ += tstep) {
    int nt, mt;
    if (xmap) { nt = tile_ % ntiles; mt = (tile_ / ntiles) * 8 + ((int)blockIdx.x & 7); }
    else { nt = tile_ % ntiles; mt = tile_ / ntiles; }
    const int m0 = mt << 8, n0 = nt << 8;
    f32x4 acc[4][8];
#pragma unroll
    for (int i = 0; i < 4; ++i)
#pragma unroll
      for (int j = 0; j < 8; ++j) acc[i][j] = (f32x4){0.f, 0.f, 0.f, 0.f};
    unsigned aoff[4], boff[4];
    const bf16_t* Ab = af.base();
#pragma unroll
    for (int i = 0; i < 4; ++i) {
      int row = crow + 64 * i;
      aoff[i] = af.rowoff(m0 + row);
      int n = n0 + row; n = n < N ? n : N - 1;
      boff[i] = (unsigned)(n * ldb + cch);
    }
    __syncthreads();
#pragma unroll
    for (int i = 0; i < 4; ++i) {
      dma16(Ab + aoff[i] + af.koff(cch), sBase + 32768 + (i * 512 + tid) * 16);
      dma16(Bt + boff[i], sBase + (i * 512 + tid) * 16);
    }
    vm_wait0();
    __syncthreads();
#pragma unroll 1
    for (int kt = 0; kt < nk; ++kt) {
      unsigned char* cur = sBase + (kt & 1) * GST;
      if (kt + 1 < nk) {
        unsigned char* nxt = sBase + ((kt + 1) & 1) * GST;
        const int k0 = (kt + 1) << 6;
#pragma unroll
        for (int i = 0; i < 4; ++i) {
          dma16(Ab + aoff[i] + af.koff(k0 + cch), nxt + 32768 + (i * 512 + tid) * 16);
          dma16(Bt + boff[i] + (unsigned)k0, nxt + (i * 512 + tid) * 16);
        }
      }
#pragma unroll
      for (int ks = 0; ks < 2; ++ks) {
        bf16x8 wf[4], xf[8];
#pragma unroll
        for (int i = 0; i < 4; ++i) wf[i] = *(const bf16x8*)(cur + (wn * 64 + i * 16 + l15) * 128 + (((ks * 4 + q4) ^ swz) * 16));
#pragma unroll
        for (int j = 0; j < 8; ++j) xf[j] = *(const bf16x8*)(cur + 32768 + (wm * 128 + j * 16 + l15) * 128 + (((ks * 4 + q4) ^ swz) * 16));
#pragma unroll
        for (int i = 0; i < 4; ++i)
#pragma unroll
          for (int j = 0; j < 8; ++j) acc[i][j] = MFMA16(wf[i], xf[j], acc[i][j]);
      }
      vm_wait0();
      __syncthreads();
    }
#pragma unroll
    for (int ip = 0; ip < 2; ++ip)
#pragma unroll
      for (int j = 0; j < 8; ++j) {
        float lo[4], hi[4];
#pragma unroll
        for (int k = 0; k < 4; ++k) {
          auto r = __builtin_amdgcn_permlane16_swap(__float_as_uint(acc[2 * ip][j][k]), __float_as_uint(acc[2 * ip + 1][j][k]), false, false);
          lo[k] = __uint_as_float(r[0]); hi[k] = __uint_as_float(r[1]);
        }
        int n = n0 + wn * 64 + (2 * ip + (q4 & 1)) * 16 + (q4 >> 1) * 8;
        int m = m0 + wm * 128 + j * 16 + l15;
        if (n < N) ef.store8(m, n, lo[0], lo[1], lo[2], lo[3], hi[0], hi[1], hi[2], hi[3]);
      }
  }
}

struct EpiRow { bf16_t* C; int ldc; DI void store(int m, int n, float a, float b, float c, float d) const { *(u32x2*)(C + (size_t)m * ldc + n) = pk4(a, b, c, d); }
  DI void store8(int m, int n, float a, float b, float c, float d, float e, float f, float g, float h) const { *(u32x4*)(C + (size_t)m * ldc + n) = (u32x4){pk2(a, b), pk2(c, d), pk2(e, f), pk2(g, h)}; } };
struct EpiSqRelu { bf16_t* C; DI void store(int m, int n, float a, float b, float c, float d) const {
    a = fmaxf(a, 0.f); b = fmaxf(b, 0.f); c = fmaxf(c, 0.f); d = fmaxf(d, 0.f);
    *(u32x2*)(C + (size_t)m * DFF + n) = pk4(a * a, b * b, c * c, d * d); }
  DI void store8(int m, int n, float a, float b, float c, float d, float e, float f, float g, float h) const {
    a = fmaxf(a, 0.f); b = fmaxf(b, 0.f); c = fmaxf(c, 0.f); d = fmaxf(d, 0.f); e = fmaxf(e, 0.f); f = fmaxf(f, 0.f); g = fmaxf(g, 0.f); h = fmaxf(h, 0.f);
    const u32x4 v = (u32x4){pk2(a * a, b * b), pk2(c * c, d * d), pk2(e * e, f * f), pk2(g * g, h * h)};
    __builtin_nontemporal_store(v, (u32x4*)(C + (size_t)m * DFF + n)); } };
struct EpiResid { const float* xin; float* out; const float* gate;
  DI void store(int m, int n, float a, float b, float c, float d) const {
    int bb = m >> 13;
    float4 x = *(const float4*)(xin + (size_t)m * DM + n);
    float4 g = *(const float4*)(gate + bb * 6144 + n);
    const float one = opqf(1.0f);
    float4 r; r.x = ALPHA_C * x.x + (one + g.x) * a; r.y = ALPHA_C * x.y + (one + g.y) * b; r.z = ALPHA_C * x.z + (one + g.z) * c; r.w = ALPHA_C * x.w + (one + g.w) * d;
    *(float4*)(out + (size_t)m * DM + n) = r; }
  DI void store8(int m, int n, float a, float b, float c, float d, float e, float f, float g, float h) const { store(m, n, a, b, c, d); store(m, n + 4, e, f, g, h); } };
struct EpiEvenProj { bf16_t* proj; bf16_t* vsT; bf16_t* vwT;
  DI void store(int m, int n, float a, float b, float c, float d) const {
    int bb = m >> 13, s = m & (SEQ - 1);
    if (n >= C_VS && n < C_KW) { int e = n - C_VS; bf16_t* p = vsT + ((size_t)(bb * 128 + e)) * SEQ + s; p[0] = f2bf(a); p[SEQ] = f2bf(b); p[2 * SEQ] = f2bf(c); p[3 * SEQ] = f2bf(d); }
    else if (n >= C_VW && n < C_GATE) { int e = n - C_VW; bf16_t* p = vwT + ((size_t)(bb * 128 + e)) * SEQ + s; p[0] = f2bf(a); p[SEQ] = f2bf(b); p[2 * SEQ] = f2bf(c); p[3 * SEQ] = f2bf(d); }
    else *(u32x2*)(proj + (size_t)m * EIN + n) = pk4(a, b, c, d); }
  DI void store8(int m, int n, float a, float b, float c, float d, float e, float f, float g, float h) const {
    if ((n >= C_VS && n < C_KW) || (n >= C_VW && n < C_GATE)) { store(m, n, a, b, c, d); store(m, n + 4, e, f, g, h); }
    else *(u32x4*)(proj + (size_t)m * EIN + n) = (u32x4){pk2(a, b), pk2(c, d), pk2(e, f), pk2(g, h)}; } };
struct EpiOddProj { bf16_t* qk; bf16_t* vT;
  DI void store(int m, int n, float a, float b, float c, float d) const {
    if (n < 2048) *(u32x2*)(qk + (size_t)m * 2048 + n) = pk4(a, b, c, d);
    else { int bb = m >> 13, s = m & (SEQ - 1); int e = n - 2048; bf16_t* p = vT + ((size_t)(bb * 1024 + e)) * SEQ + s; p[0] = f2bf(a); p[SEQ] = f2bf(b); p[2 * SEQ] = f2bf(c); p[3 * SEQ] = f2bf(d); } }
  DI void store8(int m, int n, float a, float b, float c, float d, float e, float f, float g, float h) const {
    if (n < 2048) *(u32x4*)(qk + (size_t)m * 2048 + n) = (u32x4){pk2(a, b), pk2(c, d), pk2(e, f), pk2(g, h)};
    else { store(m, n, a, b, c, d); store(m, n + 4, e, f, g, h); } } };
struct EpiCmp1 { const float* bias; bf16_t* hid;
  DI void store(int m, int n, float a, float b, float c, float d) const {
    float4 bv = *(const float4*)(bias + n);
    *(u32x2*)(hid + (size_t)m * 256 + n) = pk4(gelu_tanh(a + bv.x), gelu_tanh(b + bv.y), gelu_tanh(c + bv.z), gelu_tanh(d + bv.w)); }
  DI void store8(int m, int n, float a, float b, float c, float d, float e, float f, float g, float h) const { store(m, n, a, b, c, d); store(m, n + 4, e, f, g, h); } };
struct EpiCmp2 { bf16_t* kc; bf16_t* vcT; int kv; DI void store(int m, int n, float a, float b, float c, float d) const {
    int combo = m >> 9, nn = m & 511;
    if (nn == 511) { a = b = c = d = 0.f; }
    if (kv == 0) *(u32x2*)(kc + (size_t)m * 64 + n) = pk4(a, b, c, d);
    else { bf16_t* p = vcT + ((size_t)(combo * 64 + n)) * 512 + nn; p[0] = f2bf(a); p[512] = f2bf(b); p[1024] = f2bf(c); p[1536] = f2bf(d); } }
  DI void store8(int m, int n, float a, float b, float c, float d, float e, float f, float g, float h) const { store(m, n, a, b, c, d); store(m, n + 4, e, f, g, h); } };

DI void tr_convert(unsigned char* lds, int wv, const float* __restrict__ src, int K, int N, bf16_t* __restrict__ dst, int& tb) {
  bf16_t* sT = (bf16_t*)(lds + LDS_WORK);
  const int tid = tid_of(wv), G = gridDim.x;
  const int nkt = K >> 6, nnt = (N + 63) >> 6, ntl = nkt * nnt;
  int first = ((int)blockIdx.x - (tb % G) + G) % G;
  for (int tl = first; tl < ntl; tl += G) {
    const int k0 = (tl / nnt) << 6, n0 = (tl % nnt) << 6;
    const int kk = tid >> 4, n4 = (tid & 15) * 4;
    __syncthreads();
#pragma unroll
    for (int i = 0; i < 2; ++i) {
      int k = kk + 32 * i;
      float4 v = make_float4(0.f, 0.f, 0.f, 0.f);
      if (n0 + n4 < N) v = *(const float4*)(src + (size_t)(k0 + k) * N + n0 + n4);
      sT[(n4 + 0) * LROW + k] = f2bf(v.x); sT[(n4 + 1) * LROW + k] = f2bf(v.y); sT[(n4 + 2) * LROW + k] = f2bf(v.z); sT[(n4 + 3) * LROW + k] = f2bf(v.w);
    }
    __syncthreads();
    const int n = tid >> 3, k8 = (tid & 7) * 8;
    if (n0 + n < N) *(u32x4*)(dst + (size_t)(n0 + n) * K + k0 + k8) = *(const u32x4*)(sT + n * LROW + k8);
  }
  tb += ntl;
}

DI void wprep_phase(unsigned char* lds, KParamPtr P, int wv, int l) {
  unsigned char* wsq = opqp(P->ws);
  bf16_t* WT = (bf16_t*)(wsq + OFF_WT);
  int tb = 0;
  const int i2 = l >> 1;
  tr_convert(lds, wv, P->in[22] + (size_t)l * DM * DFF, DM, DFF, (bf16_t*)((unsigned char*)WT + WT_M1), tb);
  tr_convert(lds, wv, P->in[23] + (size_t)l * DFF * DM, DFF, DM, (bf16_t*)((unsigned char*)WT + WT_M2), tb);
  if ((l & 1) == 0) {
    tr_convert(lds, wv, P->in[7] + (size_t)i2 * DM * EIN, DM, EIN, (bf16_t*)((unsigned char*)WT + WT_IN), tb);
    tr_convert(lds, wv, P->in[8] + (size_t)i2 * DM * DM, DM, DM, (bf16_t*)((unsigned char*)WT + WT_OUT), tb);
    tr_convert(lds, wv, P->in[11] + (size_t)i2 * 2048 * 256, 2048, 256, (bf16_t*)((unsigned char*)WT + WT_CW1), tb);
    tr_convert(lds, wv, P->in[13] + (size_t)i2 * 2048 * 256, 2048, 256, (bf16_t*)((unsigned char*)WT + WT_CW1) + 256 * 2048, tb);
    tr_convert(lds, wv, P->in[12] + (size_t)i2 * 256 * 64, 256, 64, (bf16_t*)((unsigned char*)WT + WT_CW2), tb);
    tr_convert(lds, wv, P->in[14] + (size_t)i2 * 256 * 64, 256, 64, (bf16_t*)((unsigned char*)WT + WT_CW2) + 64 * 256, tb);
    tr_convert(lds, wv, P->in[17] + (size_t)i2 * 128 * 512, 128, 512, (bf16_t*)((unsigned char*)WT + WT_UV), tb);
    {
      const float* src = P->in[16] + (size_t)i2 * 128 * 512; bf16_t* dst = (bf16_t*)((unsigned char*)WT + WT_UK);
      for (int i = (blockIdx.x * NTHREADS + tid_of(wv)) * 4; i < 128 * 512; i += gridDim.x * NTHREADS * 4) {
        float4 v = *(const float4*)(src + i); *(u32x2*)(dst + i) = pk4(v.x, v.y, v.z, v.w);
      }
    }
    {
      float* red = (float*)(lds + LDS_WORK + 16384);
      float* cb = (float*)(wsq + OFF_MISC + MS_CB);
      const int tid_ = tid_of(wv); const int lane = tid_ & 63, wave = tid_ >> 6;
      for (int it = (int)gridDim.x - 1 - (int)blockIdx.x; it < 8; it += gridDim.x) {
        const int kv = it >> 2, n0 = (it & 3) * 64;
        const float* pe = P->in[kv ? 10 : 9] + (size_t)i2 * 2048;
        const float* w1 = P->in[kv ? 13 : 11] + (size_t)i2 * 2048 * 256;
        float a = 0.f;
        for (int k = wave * 256; k < wave * 256 + 256; ++k) a += pe[k] * w1[(size_t)k * 256 + n0 + lane];
        __syncthreads();
        red[wave * 64 + lane] = a;
        __syncthreads();
        if (wave == 0) { float s = 0.f; for (int w = 0; w < 8; ++w) s += red[w * 64 + lane]; cb[kv * 256 + n0 + lane] = s; }
      }
    }
  } else {
    tr_convert(lds, wv, P->in[18] + (size_t)i2 * DM * OIN, DM, OIN, (bf16_t*)((unsigned char*)WT + WT_IN), tb);
    tr_convert(lds, wv, P->in[19] + (size_t)i2 * DM * DM, DM, DM, (bf16_t*)((unsigned char*)WT + WT_OUT), tb);
  }
}

DI void ada_partial_phase(unsigned char* lds, KParamPtr P, int wv) {
  unsigned char* wsq = opqp(P->ws);
  float* cact = (float*)(lds + LDS_WORK);
  float* part = (float*)(wsq + OFF_MISC + MS_ADAP);
  const int tid = tid_of(wv);
  __syncthreads();
  for (int i = tid; i < 4096; i += NTHREADS) { float v = P->in[1][i]; cact[i] = v / (1.f + __expf(-v)); }
  __syncthreads();
  for (int it = blockIdx.x; it < 384; it += gridDim.x) {
    const int kc = it & 7, jc = (it >> 3) % 12, l = it / 96;
    const int j = jc * 512 + tid;
    const float* w = P->in[3] + ((size_t)l * 1024 + kc * 128) * 6144 + j;
    float a0 = 0.f, a1 = 0.f, a2 = 0.f, a3 = 0.f;
#pragma unroll 8
    for (int k = 0; k < 128; ++k) {
      float wgt = w[(size_t)k * 6144];
      int kk = kc * 128 + k;
      a0 += cact[kk] * wgt; a1 += cact[1024 + kk] * wgt; a2 += cact[2048 + kk] * wgt; a3 += cact[3072 + kk] * wgt;
    }
    float* o = part + ((size_t)(kc * 4 + l) * 4) * 6144 + j;
    o[0] = a0; o[6144] = a1; o[2 * 6144] = a2; o[3 * 6144] = a3;
  }
}
DI void ada_reduce_phase(KParamPtr P, int wv) {
  unsigned char* wsq = opqp(P->ws);
  const float* part = (const float*)(wsq + OFF_MISC + MS_ADAP);
  float* ada = (float*)(wsq + OFF_MISC + MS_ADA);
  for (int i = blockIdx.x * NTHREADS + tid_of(wv); i < 4 * 4 * 6144; i += gridDim.x * NTHREADS) {
    int l = i / (4 * 6144), j = i % 6144;
    float s = P->in[4][l * 6144 + j];
#pragma unroll
    for (int kc = 0; kc < 8; ++kc) s += part[(size_t)kc * 4 * 4 * 6144 + i];
    ada[i] = s;
  }
}

DI void ln_mod_phase(KParamPtr P, int wv, const float* src, float* xdst, const float* lng, const float* lnb, const float* sh, const float* sc, bool do_ln, bool write_hb) {
  unsigned char* wsq = opqp(P->ws);
  bf16_t* hb = (bf16_t*)(wsq + OFF_HB);
  const int tid_ = tid_of(wv); const int lane = tid_ & 63, wave = tid_ >> 6;
  const int nw = gridDim.x * 8, gw = blockIdx.x * 8 + wave;
  const int rpw = (NTOK + nw - 1) / nw;
  int r0 = gw * rpw, r1 = r0 + rpw; if (r1 > NTOK) r1 = NTOK;
  float4 g4[4], b4[4], sh4[4], sc4[4];
#pragma unroll
  for (int i = 0; i < 4; ++i) { int c = lane * 4 + 256 * i; if (do_ln) { g4[i] = *(const float4*)(lng + c); b4[i] = *(const float4*)(lnb + c); } }
  int curb = -1;
  const float one = opqf(1.0f);
  f32x4 vn[4];
  if (r0 < r1) {
#pragma unroll
    for (int i = 0; i < 4; ++i) vn[i] = *(const f32x4*)(src + (size_t)r0 * DM + lane * 4 + 256 * i);
  }
  for (int row = r0; row < r1; ++row) {
    const int bb = row >> 13;
    if (bb != curb && write_hb) {
      curb = bb;
#pragma unroll
      for (int i = 0; i < 4; ++i) { int c = lane * 4 + 256 * i; sh4[i] = *(const float4*)(sh + bb * 6144 + c); sc4[i] = *(const float4*)(sc + bb * 6144 + c); }
    }
    float4 v[4];
#pragma unroll
    for (int i = 0; i < 4; ++i) { v[i].x = vn[i][0]; v[i].y = vn[i][1]; v[i].z = vn[i][2]; v[i].w = vn[i][3]; }
    {
      const int rn = row + 1 < r1 ? row + 1 : row;
#pragma unroll
      for (int i = 0; i < 4; ++i) vn[i] = *(const f32x4*)(src + (size_t)rn * DM + lane * 4 + 256 * i);
    }
    if (do_ln) {
      float s = 0.f;
#pragma unroll
      for (int i = 0; i < 4; ++i) s += v[i].x + v[i].y + v[i].z + v[i].w;
      const float mu = wave_sum(s, lane) * (1.f / 1024.f);
      float q = 0.f;
#pragma unroll
      for (int i = 0; i < 4; ++i) { v[i].x -= mu; v[i].y -= mu; v[i].z -= mu; v[i].w -= mu; q += v[i].x * v[i].x + v[i].y * v[i].y + v[i].z * v[i].z + v[i].w * v[i].w; }
      const float rstd = rsqrtf(wave_sum(q, lane) * (1.f / 1024.f) + 1e-5f);
#pragma unroll
      for (int i = 0; i < 4; ++i) {
        v[i].x = v[i].x * rstd * g4[i].x + b4[i].x; v[i].y = v[i].y * rstd * g4[i].y + b4[i].y; v[i].z = v[i].z * rstd * g4[i].z + b4[i].z; v[i].w = v[i].w * rstd * g4[i].w + b4[i].w;
        __builtin_nontemporal_store((f32x4){v[i].x, v[i].y, v[i].z, v[i].w}, (f32x4*)(xdst + (size_t)row * DM + lane * 4 + 256 * i));
      }
    }
    if (write_hb) {
#pragma unroll
      for (int i = 0; i < 4; ++i) {
        *(u32x2*)(hb + (size_t)row * DM + lane * 4 + 256 * i) = pk4(v[i].x * (one + sc4[i].x) + sh4[i].x, v[i].y * (one + sc4[i].y) + sh4[i].y, v[i].z * (one + sc4[i].z) + sh4[i].z, v[i].w * (one + sc4[i].w) + sh4[i].w);
      }
    }
  }
}

DI void diff_attn_phase(unsigned char* lds, KParamPtr P, int wv, int l) {
  unsigned char* wsq = opqp(P->ws);
  const float* tab = (const float*)(lds + LDS_TAB);
  bf16_t* sK = (bf16_t*)(lds + LDS_WORK);
  bf16_t* sV = sK + 64 * LROW;
  const bf16_t* qk = (const bf16_t*)(wsq + OFF_U + U_QK);
  const bf16_t* vT = (const bf16_t*)(wsq + OFF_U + U_VT);
  bf16_t* ao = (bf16_t*)(wsq + OFF_AO);
  const int i2 = l >> 1;
  const int tid = tid_of(wv), lane = tid & 63, wave = tid >> 6, l31 = lane & 31, hh = lane >> 5;
  const float lambda_init = 0.8f - 0.6f * __expf(-0.3f * (float)l);
  float lam_full;
  {
    const float* lam = P->in[20] + (size_t)i2 * 256;
    float s1 = 0.f, s2 = 0.f;
    for (int d = 0; d < 64; ++d) { s1 += lam[d] * lam[64 + d]; s2 += lam[128 + d] * lam[192 + d]; }
    lam_full = __expf(s1) - __expf(s2) + lambda_init;
  }
  const float* subln = P->in[21] + (size_t)i2 * 128;
  const int pr = pi_row(l31);
  for (int it = blockIdx.x; it < 1024; it += gridDim.x) {
    const int rr = it >> 8, kk = it & 255, bh = (kk & 7) * 4 + rr, jq = kk >> 3;
    const int qt = (rr & 1) ? 31 - jq : jq;
    const int b = bh >> 3, h = bh & 7;
    const int Q0 = qt * 256, q0w = Q0 + wave * 32, t = q0w + l31;
    const int nkt = 4 * (qt + 1);
    unsigned* O1L = (unsigned*)(lds + LDS_WORK + 32768) + tid;
#pragma unroll 1
    for (int pass = 0; pass < 2; ++pass) {
      const int col = h * 2 + pass;
      bf16x8 qf[4];
      const bf16_t* qp = qk + (size_t)(b * SEQ + t) * 2048 + h * 128 + pass * 64 + hh * 8;
#pragma unroll
      for (int ks = 0; ks < 4; ++ks) qf[ks] = ldg8(qp + ks * 16);
      f32x16 O[4];
#pragma unroll
      for (int e = 0; e < 4; ++e) O[e] = zero16();
      float m_run = NEGB, l_run = 0.f;
      const float bfar = tab[col * 128 + 127];
      const unsigned kgo = (unsigned)((b * SEQ + (tid >> 3)) * 2048 + 1024 + h * 128 + pass * 64 + (tid & 7) * 8);
      const unsigned vgo = (unsigned)(((b * 8 + h) * 128 + (tid >> 3)) * SEQ + (tid & 7) * 8);
      u32x4 rk = *(const u32x4*)(qk + kgo), rv0 = *(const u32x4*)(vT + vgo), rv1 = *(const u32x4*)(vT + vgo + 64 * SEQ);
      __syncthreads();
      *(u32x4*)(sK + (tid >> 3) * LROW + (tid & 7) * 8) = rk;
      *(u32x4*)(sV + (tid >> 3) * LROW + (tid & 7) * 8) = rv0;
      *(u32x4*)(sV + ((tid >> 3) + 64) * LROW + (tid & 7) * 8) = rv1;
      __syncthreads();
#pragma unroll 1
      for (int kt = 0; kt < nkt; ++kt) {
        if (kt + 1 < nkt) {
          const int kn = kt + 1;
          GLOAD16(rk, qk + kgo + (unsigned)(kn * 64 * 2048));
          GLOAD16(rv0, vT + vgo + (unsigned)(kn * 64));
          GLOAD16(rv1, vT + vgo + (unsigned)(kn * 64 + 64 * SEQ));
        }
#pragma unroll
        for (int sub = 0; sub < 2; ++sub) {
          const int s0 = kt * 64 + sub * 32;
          if (s0 <= q0w + 31) {
            f32x16 s = zero16();
            bf16x8 kf[4], vf[8];
#pragma unroll
            for (int ks = 0; ks < 4; ++ks) kf[ks] = *(const bf16x8*)(sK + (sub * 32 + pr) * LROW + ks * 16 + hh * 8);
#pragma unroll
            for (int st = 0; st < 2; ++st)
#pragma unroll
              for (int e = 0; e < 4; ++e) vf[st * 4 + e] = *(const bf16x8*)(sV + (e * 32 + l31) * LROW + sub * 32 + st * 16 + hh * 8);
            __builtin_amdgcn_sched_barrier(0);
#pragma unroll
            for (int ks = 0; ks < 4; ++ks) s = MFMA32(kf[ks], qf[ks], s);
            float mloc = NEGB;
            const bool far = (q0w - (s0 + 31) >= 127);
            if (far) {
#pragma unroll
              for (int i = 0; i < 16; ++i) mloc = fmaxf(mloc, s[i]);
              mloc = fmaf(mloc, C1, bfar);
            } else {
#pragma unroll
              for (int i = 0; i < 16; ++i) {
                int key = s0 + (i & 7) + 8 * hh + 16 * (i >> 3);
                int dist = t - key; int dd = dist < 0 ? 0 : (dist > 127 ? 127 : dist);
                const float tb = tab[col * 128 + dd];
                float z = fmaf(s[i], C1, tb); z = dist < 0 ? NEGB : z;
                s[i] = z; mloc = fmaxf(mloc, z);
              }
            }
            mloc = red_max32(mloc);
            const float m_new = (mloc > m_run + 16.f) ? mloc : m_run;
            const float alpha = ex2(m_run - m_new);
            float ls = 0.f;
            if (far) {
              const float boff_ = bfar - m_new;
#pragma unroll
              for (int i = 0; i < 16; ++i) { float p = ex2(fmaf(s[i], C1, boff_)); s[i] = p; ls += p; }
            } else {
#pragma unroll
              for (int i = 0; i < 16; ++i) { float p = ex2(s[i] - m_new); s[i] = p; ls += p; }
            }
            l_run = l_run * alpha + ls; m_run = m_new;
            if (__any(alpha != 1.0f)) {
#pragma unroll
              for (int e = 0; e < 4; ++e)
#pragma unroll
                for (int i = 0; i < 16; ++i) O[e][i] *= alpha;
            }
#pragma unroll
            for (int st = 0; st < 2; ++st) {
              bf16x8 pf = pack8(s, st);
#pragma unroll
              for (int e = 0; e < 4; ++e) O[e] = MFMA32(vf[st * 4 + e], pf, O[e]);
            }
          }
        }
        __syncthreads();
        vm_wait0();
        if (kt + 1 < nkt) {
          *(u32x4*)(sK + (tid >> 3) * LROW + (tid & 7) * 8) = rk;
          *(u32x4*)(sV + (tid >> 3) * LROW + (tid & 7) * 8) = rv0;
          *(u32x4*)(sV + ((tid >> 3) + 64) * LROW + (tid & 7) * 8) = rv1;
        }
        __syncthreads();
      }
      const float lt = red_sum32(l_run);
      const float inv = 1.f / lt;
      if (pass == 0) {
#pragma unroll
        for (int e = 0; e < 4; ++e)
#pragma unroll
          for (int i = 0; i < 8; ++i) O1L[(e * 8 + i) * 512] = pk2(O[e][2 * i] * inv, O[e][2 * i + 1] * inv);
      } else {
        float ss = 0.f;
#pragma unroll
        for (int e = 0; e < 4; ++e)
#pragma unroll
          for (int i = 0; i < 16; ++i) {
            const unsigned pw = O1L[(e * 8 + (i >> 1)) * 512];
            float o1 = (i & 1) ? __uint_as_float(pw & 0xffff0000u) : __uint_as_float(pw << 16);
            float o = o1 - lam_full * (O[e][i] * inv); O[e][i] = o; ss += o * o; }
        ss = red_sum32(ss);
        const float rs = rsqrtf(ss * (1.f / 128.f) + 1e-5f) * (1.f - lambda_init);
        bf16_t* op = ao + (size_t)(b * SEQ + t) * DM + h * 128;
#pragma unroll
        for (int e = 0; e < 4; ++e)
#pragma unroll
          for (int g = 0; g < 4; ++g) {
            int ee = e * 32 + 8 * g + 4 * hh;
            float4 sl = *(const float4*)(subln + ee);
            *(u32x2*)(op + ee) = pk4(O[e][4 * g] * rs * sl.x, O[e][4 * g + 1] * rs * sl.y, O[e][4 * g + 2] * rs * sl.z, O[e][4 * g + 3] * rs * sl.w);
          }
      }
    }
  }
}

DI void cmp_z(f32x16& s, int kt, int t, int t0, int hh, const float* tabh, float& mloc) {
  const int nb = kt * 32;
  if (t0 - (16 * (nb + 31) + 31) >= 127) {
    const float bf = tabh[127];
#pragma unroll
    for (int i = 0; i < 16; ++i) { float z = fmaf(s[i], C1, bf); s[i] = z; mloc = fmaxf(mloc, z); }
  } else {
#pragma unroll
    for (int i = 0; i < 16; ++i) {
      int n = nb + (i & 7) + 8 * hh + 16 * (i >> 3);
      int dc = t - (16 * n + 31); int dd = dc < 0 ? 0 : (dc > 127 ? 127 : dc);
      float z = dc < 0 ? NEGB : fmaf(s[i], C1, tabh[dd]);
      s[i] = z; mloc = fmaxf(mloc, z);
    }
  }
}

DI void nsa_phase(unsigned char* lds, KParamPtr P, int wv) {
  unsigned char* wsq = opqp(P->ws);
  const float* tab = (const float*)(lds + LDS_TAB);
  const int tid = tid_of(wv), lane = tid & 63, wave = tid >> 6, l31 = lane & 31, hh = lane >> 5;
  unsigned char* selL = lds + LDS_WORK + wave * 512;
  float* scw = (float*)(lds + LDS_WORK + 4096 + wave * 16384);
  const bf16_t* proj = (const bf16_t*)(wsq + OFF_U + U_PROJ);
  const bf16_t* vsT = (const bf16_t*)(wsq + OFF_U + U_VST);
  const bf16_t* vwT = (const bf16_t*)(wsq + OFF_U + U_VWT);
  const bf16_t* kc = (const bf16_t*)(wsq + OFF_MISC + MS_KC);
  const bf16_t* vcT = (const bf16_t*)(wsq + OFF_MISC + MS_VCT);
  float* part = (float*)(wsq + OFF_HB);
  bf16_t* ao = (bf16_t*)(wsq + OFF_AO);
  const int nw = gridDim.x * 8, gw = blockIdx.x * 8 + wave;
  const int pr = pi_row(l31);
  for (int it = gw; it < 2048; it += nw) {
    const int blk_ = it >> 3, combo_ = blk_ & 7;
    const int b = combo_ >> 1, g = combo_ & 1, tile = ((blk_ >> 3) << 3) + (it & 7), t0 = tile * 32, t = t0 + l31;
    const size_t tok = (size_t)b * SEQ + t;
    const bf16_t* kcb = kc + (size_t)((b * 2 + g) * 512) * 64;
    const bf16_t* vcb = vcT + (size_t)((b * 2 + g) * 64) * 512;
#pragma unroll 1
    for (int x = 0; x < 64; ++x) scw[x * 64 + lane] = 0.f;
    const int nkt = (2 * tile + 1 + 31) >> 5;
#pragma unroll 1
    for (int hp = 0; hp < 4; ++hp) {
      const int head = g * 4 + hp;
      const float* tabh = tab + head * 128;
      bf16x8 qf[4];
#pragma unroll
      for (int ks = 0; ks < 4; ++ks) qf[ks] = ldg8(proj + tok * EIN + C_NQ + head * 64 + ks * 16 + hh * 8);
      float m = NEGB, l = 0.f;
      bf16x8 kf[4];
      const unsigned kco = (unsigned)(pr * 64 + hh * 8);
#pragma unroll
      for (int ks = 0; ks < 4; ++ks) kf[ks] = ldg8(kcb + kco + ks * 16);
#pragma unroll 1
      for (int kt = 0; kt < nkt; ++kt) {
        f32x16 s = zero16();
#pragma unroll
        for (int ks = 0; ks < 4; ++ks) s = MFMA32(kf[ks], qf[ks], s);
        {
          const int kn = kt + 1 < nkt ? kt + 1 : kt;
#pragma unroll
          for (int ks = 0; ks < 4; ++ks) kf[ks] = ldg8(kcb + kco + (unsigned)(kn * 32 * 64 + ks * 16));
        }
        float mloc = NEGB;
        cmp_z(s, kt, t, t0, hh, tabh, mloc);
        mloc = red_max32(mloc);
        const float mn = fmaxf(m, mloc);
        float ls = 0.f;
#pragma unroll
        for (int i = 0; i < 16; ++i) ls += (s[i] > -1e29f) ? ex2(s[i] - mn) : 0.f;
        l = l * ex2(m - mn) + ls; m = mn;
      }
      const float lt = red_sum32(l);
      const float inv = lt > 0.f ? 1.f / lt : 0.f;
      f32x16 O[2]; O[0] = zero16(); O[1] = zero16();
      float carry = 0.f;
#pragma unroll
      for (int ks = 0; ks < 4; ++ks) kf[ks] = ldg8(kcb + kco + ks * 16);
#pragma unroll 1
      for (int kt = 0; kt < nkt; ++kt) {
        {
          bf16x8 vf[4];
#pragma unroll
          for (int st = 0; st < 2; ++st)
#pragma unroll
            for (int et = 0; et < 2; ++et) vf[st * 2 + et] = ldg8(vcb + (unsigned)((et * 32 + l31) * 512 + kt * 32 + st * 16 + hh * 8));
          f32x16 s = zero16();
#pragma unroll
          for (int ks = 0; ks < 4; ++ks) s = MFMA32(kf[ks], qf[ks], s);
          {
            const int kn = kt + 1 < nkt ? kt + 1 : kt;
#pragma unroll
            for (int ks = 0; ks < 4; ++ks) kf[ks] = ldg8(kcb + kco + (unsigned)(kn * 32 * 64 + ks * 16));
          }
          float mloc = NEGB;
          cmp_z(s, kt, t, t0, hh, tabh, mloc);
#pragma unroll
          for (int i = 0; i < 16; ++i) s[i] = (s[i] > -1e29f) ? ex2(s[i] - m) * inv : 0.f;
          const float G00 = s[0] + s[1] + s[2] + s[3], G01 = s[4] + s[5] + s[6] + s[7];
          const float G10 = s[8] + s[9] + s[10] + s[11], G11 = s[12] + s[13] + s[14] + s[15];
          const float pe0 = SHXF(s[7], 32), pe1 = SHXF(s[15], 32);
          const float X0 = hh ? pe0 : carry;
          const float X1 = hh ? pe1 : pe0;
          float* sp = scw + (8 * kt + 2 * hh) * 32 + l31;
          sp[0] += 2.f * G00 - s[3] + X0;
          sp[32] += 2.f * G01 - s[7] + s[3];
          sp[4 * 32] += 2.f * G10 - s[11] + X1;
          sp[5 * 32] += 2.f * G11 - s[15] + s[11];
          carry = pe1;
#pragma unroll
          for (int st = 0; st < 2; ++st) {
            bf16x8 pf = pack8(s, st);
#pragma unroll
            for (int et = 0; et < 2; ++et) O[et] = MFMA32(vf[st * 2 + et], pf, O[et]);
          }
        }
      }
      const float g0 = sigmoidf_(bf2f(proj[tok * EIN + C_GATE + head * 3 + 0]));
      float* pp = part + (tok * 8 + head) * 64;
#pragma unroll
      for (int et = 0; et < 2; ++et)
#pragma unroll
        for (int gq = 0; gq < 4; ++gq) {
          float4 r; r.x = g0 * O[et][4 * gq]; r.y = g0 * O[et][4 * gq + 1]; r.z = g0 * O[et][4 * gq + 2]; r.w = g0 * O[et][4 * gq + 3];
          *(float4*)(pp + et * 32 + 8 * gq + 4 * hh) = r;
        }
    }
    {
      const int cb = t >> 6;
#pragma unroll 1
      for (int r = 0; r < 64; ++r) {
        const int j = 4 * (r >> 1) + (r & 1) + 2 * hh;
        const bool forced = (j == 0) | (j == cb) | (j == cb - 1);
        const float v = scw[j * 32 + l31];
        scw[j * 32 + l31] = forced ? 1e9f : (j <= cb ? v : -1e9f);
      }
      unsigned mk0 = 0u, mk1 = 0u, mk2 = 0u, mk3 = 0u;
#pragma unroll 1
      for (int rd = 0; rd < 16; ++rd) {
        float bv = -INFINITY; int bj = 255;
#pragma unroll 4
        for (int r = 0; r < 64; ++r) {
          const int j = 4 * (r >> 1) + (r & 1) + 2 * hh;
          const float v = scw[j * 32 + l31];
          if (v > bv) { bv = v; bj = j; }
        }
        const float ov = SHXF(bv, 32); const int oj = SHXI(bj, 32);
        const bool other = (ov > bv) || (ov == bv && oj < bj);
        const int wj = other ? oj : bj;
        if (((wj >> 1) & 1) == hh) scw[wj * 32 + l31] = -3e38f;
        const unsigned bit = 1u << (wj & 31); const int wd = wj >> 5;
        mk0 |= wd == 0 ? bit : 0u; mk1 |= wd == 1 ? bit : 0u; mk2 |= wd == 2 ? bit : 0u; mk3 |= wd == 3 ? bit : 0u;
      }
      if (hh == 0) *(u32x4*)(selL + l31 * 16) = (u32x4){mk0, mk1, mk2, mk3};
    }
    {
      const int s_lo = t0 >= 512 ? t0 - 512 : 0;
      const int nwt = (t0 + 32 - s_lo) >> 5;
#pragma unroll 1
      for (int hp = 0; hp < 4; ++hp) {
        const int head = g * 4 + hp;
        const float* tabh = tab + head * 128;
        bf16x8 qf[4];
#pragma unroll
        for (int ks = 0; ks < 4; ++ks) qf[ks] = ldg8(proj + tok * EIN + C_NQ + head * 64 + ks * 16 + hh * 8);
        f32x16 O[2]; O[0] = zero16(); O[1] = zero16();
        float m = NEGB, l = 0.f;
        bf16x8 kf[4];
        const unsigned kwo = (unsigned)((b * SEQ + s_lo + pr) * EIN + C_KW + g * 64 + hh * 8);
        const unsigned vwo = (unsigned)(((b * 2 + g) * 64 + l31) * SEQ + s_lo + hh * 8);
#pragma unroll
        for (int ks = 0; ks < 4; ++ks) kf[ks] = ldg8(proj + kwo + ks * 16);
#pragma unroll 1
        for (int wt = 0; wt < nwt; ++wt) {
          const int s0 = s_lo + wt * 32;
          bf16x8 vf[4];
#pragma unroll
          for (int st = 0; st < 2; ++st)
#pragma unroll
            for (int et = 0; et < 2; ++et) vf[st * 2 + et] = ldg8(vwT + vwo + (unsigned)(et * 32 * SEQ + wt * 32 + st * 16));
          f32x16 s = zero16();
#pragma unroll
          for (int ks = 0; ks < 4; ++ks) s = MFMA32(kf[ks], qf[ks], s);
          {
            const int wn_ = wt + 1 < nwt ? wt + 1 : wt;
#pragma unroll
            for (int ks = 0; ks < 4; ++ks) kf[ks] = ldg8(proj + kwo + (unsigned)(wn_ * 32 * EIN + ks * 16));
          }
          float mloc = NEGB;
          const bool full = (s0 + 31 <= t0) && (t0 + 31 - s0 < 512);
          if (full && (t0 - (s0 + 31) >= 127)) {
            const float bf = tabh[127];
#pragma unroll
            for (int i = 0; i < 16; ++i) { float z = fmaf(s[i], C1, bf); s[i] = z; mloc = fmaxf(mloc, z); }
          } else {
#pragma unroll
            for (int i = 0; i < 16; ++i) {
              int key = s0 + (i & 7) + 8 * hh + 16 * (i >> 3);
              int dw = t - key; int dd = dw < 0 ? 0 : (dw > 127 ? 127 : dw);
              float z = (dw >= 0 && dw < 512) ? fmaf(s[i], C1, tabh[dd]) : NEGB;
              s[i] = z; mloc = fmaxf(mloc, z);
            }
          }
          mloc = red_max32(mloc);
          const float mn = fmaxf(m, mloc);
          const float alpha = ex2(m - mn);
          float ls = 0.f;
#pragma unroll
          for (int i = 0; i < 16; ++i) { float p = (s[i] > -1e29f) ? ex2(s[i] - mn) : 0.f; s[i] = p; ls += p; }
          l = l * alpha + ls; m = mn;
#pragma unroll
          for (int et = 0; et < 2; ++et)
#pragma unroll
            for (int i = 0; i < 16; ++i) O[et][i] *= alpha;
#pragma unroll
          for (int st = 0; st < 2; ++st) {
            bf16x8 pf = pack8(s, st);
#pragma unroll
            for (int et = 0; et < 2; ++et) O[et] = MFMA32(vf[st * 2 + et], pf, O[et]);
          }
        }
        const float lt = red_sum32(l);
        const float g2 = sigmoidf_(bf2f(proj[tok * EIN + C_GATE + head * 3 + 2])) / lt;
        float* pp = part + (tok * 8 + head) * 64;
#pragma unroll
        for (int et = 0; et < 2; ++et)
#pragma unroll
          for (int gq = 0; gq < 4; ++gq) {
            float4 r = *(float4*)(pp + et * 32 + 8 * gq + 4 * hh);
            r.x += g2 * O[et][4 * gq]; r.y += g2 * O[et][4 * gq + 1]; r.z += g2 * O[et][4 * gq + 2]; r.w += g2 * O[et][4 * gq + 3];
            *(float4*)(pp + et * 32 + 8 * gq + 4 * hh) = r;
          }
      }
    }
    __builtin_amdgcn_fence(__ATOMIC_SEQ_CST, "workgroup");
    {
      const int col = lane & 15, q4 = lane >> 4;
      const int qq = col >> 2, hcol = g * 4 + (col & 3);
      const float* tabc = tab + hcol * 128;
      const int rk = 8 * (col >> 2) + (col & 3);
      const unsigned kbase = (unsigned)((b * SEQ + rk) * EIN + C_KS + g * 64 + q4 * 8);
      const unsigned vbase = (unsigned)(((b * 2 + g) * 64 + col) * SEQ + q4 * 8);
#pragma unroll 1
      for (int grp_ = 0; grp_ < 8 * REP_C; ++grp_) {
        const int grp = grp_ & 7;
        const int tq = t0 + grp * 4 + qq;
        const int tmin = t0 + grp * 4, tmax = tmin + 3;
        const size_t tokq = (size_t)b * SEQ + tq;
        const u32x4 mym = *(const u32x4*)(selL + (grp * 4 + qq) * 16);
        unsigned u0, u1, u2, u3;
        {
          const u32x4 a0 = *(const u32x4*)(selL + (grp * 4 + 0) * 16), a1 = *(const u32x4*)(selL + (grp * 4 + 1) * 16);
          const u32x4 a2 = *(const u32x4*)(selL + (grp * 4 + 2) * 16), a3 = *(const u32x4*)(selL + (grp * 4 + 3) * 16);
          const u32x4 uu = a0 | a1 | a2 | a3;
          u0 = __builtin_amdgcn_readfirstlane(uu.x); u1 = __builtin_amdgcn_readfirstlane(uu.y);
          u2 = __builtin_amdgcn_readfirstlane(uu.z); u3 = __builtin_amdgcn_readfirstlane(uu.w);
          const int cbm = tmax >> 6;
          if (cbm < 31) { u0 &= (2u << cbm) - 1u; u1 = 0u; u2 = 0u; u3 = 0u; }
          else if (cbm < 63) { u1 &= (2u << (cbm - 32)) - 1u; u2 = 0u; u3 = 0u; }
          else if (cbm < 95) { u2 &= (2u << (cbm - 64)) - 1u; u3 = 0u; }
          else if (cbm < 127) { u3 &= (2u << (cbm - 96)) - 1u; }
        }
        auto next_blk = [&]() -> int {
          if (u0) { int bq = __builtin_ctz(u0); u0 &= u0 - 1u; return bq; }
          if (u1) { int bq = __builtin_ctz(u1); u1 &= u1 - 1u; return 32 + bq; }
          if (u2) { int bq = __builtin_ctz(u2); u2 &= u2 - 1u; return 64 + bq; }
          if (u3) { int bq = __builtin_ctz(u3); u3 &= u3 - 1u; return 96 + bq; }
          return -1;
        };
        bf16x8 qf[2];
#pragma unroll
        for (int st = 0; st < 2; ++st) qf[st] = ldg8(proj + tokq * EIN + C_NQ + hcol * 64 + st * 32 + q4 * 8);
        f32x4 O[4];
#pragma unroll
        for (int e = 0; e < 4; ++e) O[e] = (f32x4){0.f, 0.f, 0.f, 0.f};
        float m = NEGB, l = 0.f;
        bf16x8 kf[8], vf[8];
        auto load_k = [&](int jb) {
          const unsigned ko = kbase + (unsigned)(jb * 64 * EIN);
#pragma unroll
          for (int hf = 0; hf < 2; ++hf)
#pragma unroll
            for (int tl = 0; tl < 2; ++tl) {
              kf[(hf * 2 + tl) * 2 + 0] = ldg8(proj + ko + (unsigned)((hf * 32 + 4 * tl) * EIN));
              kf[(hf * 2 + tl) * 2 + 1] = ldg8(proj + ko + (unsigned)((hf * 32 + 4 * tl) * EIN + 32));
            }
        };
        auto load_v = [&](int jb) {
          const unsigned vo = vbase + (unsigned)(jb * 64);
#pragma unroll
          for (int hf = 0; hf < 2; ++hf)
#pragma unroll
            for (int e = 0; e < 4; ++e) vf[hf * 4 + e] = ldg8(vsT + vo + (unsigned)(e * 16 * SEQ + hf * 32));
        };
        int jb = next_blk();
        if (jb >= 0) { load_k(jb); load_v(jb); }
        while (jb >= 0) {
          const int base = jb * 64;
          const unsigned mw = jb < 32 ? mym.x : (jb < 64 ? mym.y : (jb < 96 ? mym.z : mym.w));
          const bool member = (mw >> (jb & 31)) & 1u;
          f32x4 a[2][2];
#pragma unroll
          for (int hf = 0; hf < 2; ++hf)
#pragma unroll
            for (int tl = 0; tl < 2; ++tl) {
              f32x4 acc = (f32x4){0.f, 0.f, 0.f, 0.f};
              acc = MFMA16(kf[(hf * 2 + tl) * 2 + 0], qf[0], acc);
              acc = MFMA16(kf[(hf * 2 + tl) * 2 + 1], qf[1], acc);
              a[hf][tl] = acc;
            }
          const int jn = next_blk();
          if (jn >= 0) load_k(jn);
          float mloc = NEGB;
          if (tmin - (base + 63) >= 127) {
            const float bf = tabc[127];
#pragma unroll
            for (int hf = 0; hf < 2; ++hf)
#pragma unroll
              for (int tl = 0; tl < 2; ++tl)
#pragma unroll
                for (int j = 0; j < 4; ++j) { float z = member ? fmaf(a[hf][tl][j], C1, bf) : NEGB; a[hf][tl][j] = z; mloc = fmaxf(mloc, z); }
          } else {
#pragma unroll
            for (int hf = 0; hf < 2; ++hf)
#pragma unroll
              for (int tl = 0; tl < 2; ++tl)
#pragma unroll
                for (int j = 0; j < 4; ++j) {
                  int key = base + hf * 32 + 8 * q4 + 4 * tl + j;
                  int dist = tq - key; int dd = dist < 0 ? 0 : (dist > 127 ? 127 : dist);
                  float z = (dist < 0 || !member) ? NEGB : fmaf(a[hf][tl][j], C1, tabc[dd]);
                  a[hf][tl][j] = z; mloc = fmaxf(mloc, z);
                }
          }
          mloc = red_max16(mloc);
          mloc = red_max32(mloc);
          const float mn = fmaxf(m, mloc);
          const float alpha = ex2(m - mn);
          float ls = 0.f;
#pragma unroll
          for (int hf = 0; hf < 2; ++hf)
#pragma unroll
            for (int tl = 0; tl < 2; ++tl)
#pragma unroll
              for (int j = 0; j < 4; ++j) { float p = (a[hf][tl][j] > -1e29f) ? ex2(a[hf][tl][j] - mn) : 0.f; a[hf][tl][j] = p; ls += p; }
          l = l * alpha + ls; m = mn;
#pragma unroll
          for (int e = 0; e < 4; ++e) O[e] *= alpha;
#pragma unroll
          for (int hf = 0; hf < 2; ++hf) {
            u32x4 u; u.x = pk2(a[hf][0][0], a[hf][0][1]); u.y = pk2(a[hf][0][2], a[hf][0][3]); u.z = pk2(a[hf][1][0], a[hf][1][1]); u.w = pk2(a[hf][1][2], a[hf][1][3]);
            const bf16x8 pf = __builtin_bit_cast(bf16x8, u);
#pragma unroll
            for (int e = 0; e < 4; ++e) O[e] = MFMA16(vf[hf * 4 + e], pf, O[e]);
          }
          if (jn >= 0) load_v(jn);
          jb = jn;
        }
        l = red_sum16(l);
        l = red_sum32(l);
        {
          const float g1 = sigmoidf_(bf2f(proj[tokq * EIN + C_GATE + hcol * 3 + 1])) / l;
          const float* pp = part + (tokq * 8 + hcol) * 64;
          bf16_t* op = ao + tokq * DM + hcol * 64;
#pragma unroll
          for (int e = 0; e < 4; ++e) {
            float4 pv = *(const float4*)(pp + e * 16 + 4 * q4);
            *(u32x2*)(op + e * 16 + 4 * q4) = pk4(pv.x + g1 * O[e][0], pv.y + g1 * O[e][1], pv.z + g1 * O[e][2], pv.w + g1 * O[e][3]);
          }
        }
      }
    }
  }
}

DI void ckv_norm_phase(KParamPtr P, int wv, int i2) {
  unsigned char* wsq = opqp(P->ws);
  const bf16_t* proj = (const bf16_t*)(wsq + OFF_U + U_PROJ);
  bf16_t* ckv = (bf16_t*)(wsq + OFF_MISC + 12 * MiB);
  const float* gn = P->in[15] + (size_t)i2 * 128;
  const int tid_ = tid_of(wv); const int lane = tid_ & 63, wave = tid_ >> 6;
  const int nw = gridDim.x * 8, gw = blockIdx.x * 8 + wave;
  const float g0 = gn[2 * lane], g1 = gn[2 * lane + 1];
  for (int tk = gw; tk < NTOK; tk += nw) {
    unsigned u = *(const unsigned*)(proj + (size_t)tk * EIN + C_DKV + 2 * lane);
    float a = __uint_as_float(u << 16), c = __uint_as_float(u & 0xffff0000u);
    float ss = wave_sum(a * a + c * c, lane);
    float rs = rsqrtf(ss * (1.f / 128.f) + 1e-5f);
    *(unsigned*)(ckv + (size_t)tk * 128 + 2 * lane) = pk2(a * rs * g0, c * rs * g1);
  }
}

DI unsigned fkey(float f) { unsigned u = __float_as_uint(f); return (u & 0x80000000u) ? ~u : (u | 0x80000000u); }

DI void dsa_index_phase(unsigned char* lds, KParamPtr P, int wv) {
  unsigned char* wsq = opqp(P->ws);
  float* sc = (float*)(lds + LDS_WORK);
  unsigned* hist = (unsigned*)(lds + LDS_WORK + 131072);
  const bf16_t* proj = (const bf16_t*)(wsq + OFF_U + U_PROJ);
  unsigned short* idx = (unsigned short*)(wsq + OFF_U + U_IDX);
  const int tid = tid_of(wv), lane = tid & 63, wave = tid >> 6, l31 = lane & 31, hh = lane >> 5;
  const int rhead = (l31 & 3) + 4 * ((l31 >> 3) & 1), ru = 2 * ((l31 >> 2) & 1) + (l31 >> 4);
  const unsigned long long lt_mask = (lane == 0) ? 0ull : (~0ull >> (64 - lane));
  __syncthreads();
  if (wave < 4) { const unsigned z0 = (unsigned)opq(0); unsigned* hz = hist + wave * 256 + lane * 4; hz[0] = z0; hz[1] = z0; hz[2] = z0; hz[3] = z0; }
  lds_barrier();
  for (int item = blockIdx.x; item < 8192; item += gridDim.x) {
    const int b = (item & 7) >> 1, t0 = (((item >> 3) << 1) + (item & 1)) * 4;
    const int ntile = (t0 + 4 + 31) >> 5;
    bf16x8 af[4];
    const bf16_t* iqp = proj + (size_t)(b * SEQ + t0 + ru) * EIN + C_IQ + rhead * 64 + hh * 8;
#pragma unroll
    for (int ks = 0; ks < 4; ++ks) af[ks] = ldg8(iqp + ks * 16);
    float w[16];
#pragma unroll
    for (int i = 0; i < 16; ++i) {
      const int uq = 2 * hh + (i >> 3), hd = (i & 3) + 4 * ((i >> 2) & 1);
      w[i] = bf2f(proj[(size_t)(b * SEQ + t0 + uq) * EIN + C_IW + hd]) * 0.04419417382415922f;
    }
#pragma unroll 1
    for (int kt0 = wave * 4; kt0 < ntile; kt0 += 32) {
      bf16x8 kf[4][4];
      const unsigned ko = (unsigned)((b * SEQ + kt0 * 32 + l31) * EIN + C_IK + hh * 8);
#pragma unroll
      for (int u = 0; u < 4; ++u)
#pragma unroll
        for (int ks = 0; ks < 4; ++ks) kf[u][ks] = ldg8(proj + ko + (unsigned)(u * 32 * EIN + ks * 16));
#pragma unroll
      for (int u = 0; u < 4; ++u) {
        f32x16 acc = zero16();
#pragma unroll
        for (int ks = 0; ks < 4; ++ks) acc = MFMA32(af[ks], kf[u][ks], acc);
        float s0 = 0.f, s1 = 0.f;
#pragma unroll
        for (int i = 0; i < 8; ++i) { s0 += w[i] * fmaxf(acc[i], 0.f); s1 += w[8 + i] * fmaxf(acc[8 + i], 0.f); }
        const int key = (kt0 + u) * 32 + l31;
        s0 += 0.f; s1 += 0.f;
        sc[(2 * hh) * 8192 + key] = s0;
        sc[(2 * hh + 1) * 8192 + key] = s1;
        if (key <= t0 + 2 * hh) atomicAdd(hist + (2 * hh) * 256 + (fkey(s0) >> 24), 1u);
        if (key <= t0 + 2 * hh + 1) atomicAdd(hist + (2 * hh + 1) * 256 + (fkey(s1) >> 24), 1u);
      }
    }
    const int qs = wave & 3, half = wave >> 2;
    const int n = t0 + qs + 1;
    const float* scq = sc + qs * 8192;
    unsigned short* out = idx + (size_t)(b * SEQ + t0 + qs) * 256;
    unsigned* H0 = hist + qs * 256;
    unsigned* H1 = hist + 1024 + qs * 256;
    const bool big = n > 256;
    if (!big && half == 0) { for (int i = lane; i < 256; i += 64) out[i] = (unsigned short)(i < n ? i : 0xFFFF); }
    lds_barrier();
    unsigned prefix = 0; int Kr = 256;
#pragma unroll 1
    for (int pass = 0; pass < 4; ++pass) {
      unsigned* Hc = (pass & 1) ? H1 : H0;
      unsigned* Hn = (pass & 1) ? H0 : H1;
      const int shift = 24 - 8 * pass;
      if (big && pass > 0) {
        f32x4 vnx = *(const f32x4*)(scq + half * 256 + lane * 4);
        for (int c = half; c * 256 < n; c += 2) {
          const int i0 = c * 256 + lane * 4;
          const f32x4 v = vnx;
          { const int cn = (c + 2) * 256 < n ? c + 2 : c; vnx = *(const f32x4*)(scq + cn * 256 + lane * 4); }
#pragma unroll
          for (int e = 0; e < 4; ++e) {
            const unsigned u = fkey(v[e]);
            const bool match = (i0 + e < n) && ((pass == 0) || ((u >> ((shift + 8) & 31)) == prefix));
            if (match) atomicAdd(Hc + ((u >> shift) & 255u), 1u);
          }
        }
      }
      lds_barrier();
      if (half == 0) { const unsigned z0 = (unsigned)opq(0); Hn[lane * 4] = z0; Hn[lane * 4 + 1] = z0; Hn[lane * 4 + 2] = z0; Hn[lane * 4 + 3] = z0; }
      if (big) {
        const u32x4 hv = *(const u32x4*)(Hc + lane * 4);
        const int sloc = (int)(hv.x + hv.y + hv.z + hv.w);
        int incl = sloc;
#pragma unroll
        for (int off = 1; off < 64; off <<= 1) { int v = bperm_i(lane + off, incl); if (lane + off < 64) incl += v; }
        int cum = incl - sloc;
        bool found = false; int d = 0, nK = 0;
#pragma unroll
        for (int bq = 3; bq >= 0; --bq) {
          const int hbq = (int)hv[bq];
          if (!found && cum < Kr && Kr <= cum + hbq) { found = true; d = lane * 4 + bq; nK = Kr - cum; }
          cum += hbq;
        }
        const unsigned long long mk = __ballot(found);
        const int src = __ffsll((long long)mk) - 1;
        d = bperm_i(src, d); Kr = bperm_i(src, nK);
        prefix = (prefix << 8) | (unsigned)d;
      }
      lds_barrier();
    }
    if (big && half == 0) {
      const unsigned T = prefix;
      int cg_ = 0, ce_ = 0;
      f32x4 vnx = *(const f32x4*)(scq + lane * 4);
      for (int c = 0; c * 256 < n; ++c) {
        const int i0 = c * 256 + lane * 4;
        const f32x4 v = vnx;
        { const int cn = (c + 1) * 256 < n ? c + 1 : c; vnx = *(const f32x4*)(scq + cn * 256 + lane * 4); }
        bool gt[4], eq[4]; unsigned long long mg[4], me[4];
#pragma unroll
        for (int e = 0; e < 4; ++e) {
          const unsigned u = fkey(v[e]);
          gt[e] = (i0 + e < n) && (u > T); eq[e] = (i0 + e < n) && (u == T);
          mg[e] = __ballot(gt[e]); me[e] = __ballot(eq[e]);
        }
        int pg = cg_;
#pragma unroll
        for (int e = 0; e < 4; ++e) {
          if (gt[e]) out[pg + __popcll(mg[e] & lt_mask)] = (unsigned short)(i0 + e);
          pg += __popcll(mg[e]);
        }
        cg_ = pg;
        if ((me[0] | me[1] | me[2] | me[3]) != 0ull) {
          int below = ce_;
#pragma unroll
          for (int e = 0; e < 4; ++e) below += __popcll(me[e] & lt_mask);
          int own = 0;
#pragma unroll
          for (int e = 0; e < 4; ++e) {
            const int rank = below + own;
            if (eq[e] && rank < Kr) out[(256 - Kr) + rank] = (unsigned short)(i0 + e);
            own += eq[e] ? 1 : 0;
          }
#pragma unroll
          for (int e = 0; e < 4; ++e) ce_ += __popcll(me[e]);
        }
      }
    }
    lds_barrier();
  }
}

DI void dsa_sparse_phase(unsigned char* lds, KParamPtr P, int wv) {
  unsigned char* wsq = opqp(P->ws);
  const float* tab = (const float*)(lds + LDS_TAB);
  const int tid = tid_of(wv), lane = tid & 63, wave = tid >> 6;
  bf16_t* gbuf = (bf16_t*)(lds + LDS_WORK + 4096 + wave * 9216);
  unsigned short* idL = (unsigned short*)(lds + LDS_WORK + 4096 + wave * 9216 + 8704);
  __syncthreads();
  bf16_t* qlat = (bf16_t*)(wsq + OFF_U + U_QLAT);
  const bf16_t* ckv = (const bf16_t*)(wsq + OFF_MISC + 12 * MiB);
  const unsigned short* idx = (const unsigned short*)(wsq + OFF_U + U_IDX);
  const int nw = gridDim.x * 8, gw = blockIdx.x * 8 + wave;
  const int col = lane & 15, q4 = lane >> 4;
  const float* tabc = tab + (8 + (col & 7)) * 128;
  const int rk = 8 * (col >> 2) + (col & 3);
  const int grow = lane >> 4, gc16 = lane & 15;
  const bool dealt = (gridDim.x == 256);
  const int g_lo = dealt ? (int)kSpStart[blockIdx.x >> 3] : 0, g_n = dealt ? (int)kSpStart[(blockIdx.x >> 3) + 1] - g_lo : 0;
  auto qmap = [&](int qi) -> int {
    const int w8 = qi & 7, blk = (qi >> 3) & 255, rnd = qi >> 11, x = blk & 7;
    const int gidx = dealt ? g_lo + rnd : rnd * 32 + (blk >> 3);
    return ((x >> 1) << 13) + (((gidx << 1) + (x & 1)) << 3) + w8;
  };
  const int qi_end = dealt ? gw + g_n * nw : NTOK;
  u32x2 idn = (gw < qi_end) ? *(const u32x2*)(idx + (size_t)qmap(gw) * 256 + lane * 4) : (u32x2){0u, 0u};
  for (int qi = gw; qi < qi_end; qi += nw) {
    const int q = qmap(qi);
    const int b = q >> 13, tq = q & (SEQ - 1);
    asm volatile("" ::: "memory");
    *(u32x2*)(idL + lane * 4) = idn;
    asm volatile("" ::: "memory");
    {
      const int qn = qmap(qi + nw < qi_end ? qi + nw : qi);
      idn = *(const u32x2*)(idx + (size_t)qn * 256 + lane * 4);
    }
    bf16x8 qf[4];
#pragma unroll
    for (int st = 0; st < 4; ++st) qf[st] = (col < 8) ? ldg8(qlat + (size_t)q * DM + col * 128 + st * 32 + q4 * 8) : zero8();
    f32x4 O[8];
#pragma unroll
    for (int e = 0; e < 8; ++e) O[e] = (f32x4){0.f, 0.f, 0.f, 0.f};
    float m = NEGB, l = 0.f;
    u32x4 gr[8];
    const unsigned cb = (unsigned)(b * SEQ) * 128u + (unsigned)gc16 * 8u;
#pragma unroll
    for (int i = 0; i < 8; ++i) {
      int id = idL[grow + 4 * i]; id = id > SEQ - 1 ? SEQ - 1 : id;
      gr[i] = *(const u32x4*)(ckv + cb + (unsigned)id * 128u);
    }
#pragma unroll 1
    for (int ch = 0; ch < 8; ++ch) {
#pragma unroll
      for (int i = 0; i < 8; ++i) *(u32x4*)(gbuf + (grow + 4 * i) * 136 + gc16 * 8) = gr[i];
      asm volatile("" ::: "memory");
      {
        const int cn = ch < 7 ? ch + 1 : ch;
#pragma unroll
        for (int i = 0; i < 8; ++i) {
          int id = idL[cn * 32 + grow + 4 * i]; id = id > SEQ - 1 ? SEQ - 1 : id;
          gr[i] = *(const u32x4*)(ckv + cb + (unsigned)id * 128u);
        }
      }
      f32x4 a[2];
#pragma unroll
      for (int tl = 0; tl < 2; ++tl) {
        f32x4 acc = (f32x4){0.f, 0.f, 0.f, 0.f};
#pragma unroll
        for (int st = 0; st < 4; ++st) acc = MFMA16(*(const bf16x8*)(gbuf + (rk + 4 * tl) * 136 + st * 32 + q4 * 8), qf[st], acc);
        a[tl] = acc;
      }
      float mloc = NEGB;
#pragma unroll
      for (int tl = 0; tl < 2; ++tl)
#pragma unroll
        for (int j = 0; j < 4; ++j) {
          const int id = idL[ch * 32 + 8 * q4 + 4 * tl + j];
          const int dist = tq - id; const int dd = dist < 0 ? 0 : (dist > 127 ? 127 : dist);
          const float tb = tabc[dd];
          float z = fmaf(a[tl][j], C1, tb); z = dist < 0 ? NEGB : z;
          a[tl][j] = z; mloc = fmaxf(mloc, z);
        }
      mloc = red_max16(mloc);
      mloc = red_max32(mloc);
      const float mn = fmaxf(m, mloc);
      const float alpha = ex2(m - mn);
      float ls = 0.f;
#pragma unroll
      for (int tl = 0; tl < 2; ++tl)
#pragma unroll
        for (int j = 0; j < 4; ++j) { float p = (a[tl][j] > -1e29f) ? ex2(a[tl][j] - mn) : 0.f; a[tl][j] = p; ls += p; }
      l = l * alpha + ls; m = mn;
#pragma unroll
      for (int e = 0; e < 8; ++e) O[e] *= alpha;
      u32x4 u; u.x = pk2(a[0][0], a[0][1]); u.y = pk2(a[0][2], a[0][3]); u.z = pk2(a[1][0], a[1][1]); u.w = pk2(a[1][2], a[1][3]);
      const bf16x8 pf = __builtin_bit_cast(bf16x8, u);
#pragma unroll
      for (int rt = 0; rt < 8; ++rt) {
        const bf16_t* gp = gbuf + (8 * q4) * 136 + rt * 16 + col;
        u32x4 v;
        v.x = (unsigned)gp[0] | ((unsigned)gp[136] << 16); v.y = (unsigned)gp[2 * 136] | ((unsigned)gp[3 * 136] << 16);
        v.z = (unsigned)gp[4 * 136] | ((unsigned)gp[5 * 136] << 16); v.w = (unsigned)gp[6 * 136] | ((unsigned)gp[7 * 136] << 16);
        O[rt] = MFMA16(__builtin_bit_cast(bf16x8, v), pf, O[rt]);
      }
      asm volatile("" ::: "memory");
    }
    l = red_sum16(l);
    l = red_sum32(l);
    if (col < 8) {
      const float inv = 1.f / l;
      bf16_t* op = qlat + (size_t)q * DM + col * 128;
#pragma unroll
      for (int rt = 0; rt < 8; ++rt) *(u32x2*)(op + rt * 16 + 4 * q4) = pk4(O[rt][0] * inv, O[rt][1] * inv, O[rt][2] * inv, O[rt][3] * inv);
    }
  }
}

DI void gbar(unsigned* cnt, unsigned& target, int tid) {
  asm volatile("s_waitcnt vmcnt(0)" ::: "memory");
  __syncthreads();
  target += gridDim.x;
  if (tid == 0) {
    __builtin_amdgcn_fence(__ATOMIC_RELEASE, "agent");
    asm volatile("s_waitcnt vmcnt(0)" ::: "memory");
    __hip_atomic_fetch_add(cnt, 1u, __ATOMIC_RELAXED, __HIP_MEMORY_SCOPE_AGENT);
    while (__hip_atomic_load(cnt, __ATOMIC_RELAXED, __HIP_MEMORY_SCOPE_AGENT) < target) __builtin_amdgcn_s_sleep(1);
    __builtin_amdgcn_fence(__ATOMIC_ACQUIRE, "agent");
    asm volatile("s_waitcnt vmcnt(0)" ::: "memory");
  }
  __syncthreads();
}

__global__ void __launch_bounds__(NTHREADS) mega(Params P0) {
  extern __shared__ __attribute__((aligned(16))) unsigned char lds[];
  cg::grid_group grid = cg::this_grid();
#define P kparams()
  const int wv = __builtin_amdgcn_readfirstlane((int)(threadIdx.x >> 6));
  const int tid = tid_of(wv);
  {
    float* tab = (float*)(lds + LDS_TAB);
    for (int i = tid; i < 16 * 128; i += NTHREADS) { int col = i >> 7, d = i & 127; tab[i] = P->in[2][(int)kBucket[d] * 16 + col] * LOG2E; }
    __syncthreads();
  }
  const float* ada = (const float*)(opqp(P->ws) + OFF_MISC + MS_ADA);

  unsigned* barp = (unsigned*)(opqp(P->ws) + OFF_BAR);
  unsigned bar_target = 0;
  ada_partial_phase(lds, P, wv);
  wprep_phase(lds, P, wv, 0);
  grid.sync();
  ada_reduce_phase(P, wv);
  gbar(barp, bar_target, tid_of(wv));
  for (int rp = 0; rp < REP_SYNC; ++rp) gbar(barp, bar_target, tid_of(wv));
  ln_mod_phase(P, wv, P->in[0], nullptr, nullptr, nullptr, ada, ada + 1024, false, true);
  gbar(barp, bar_target, tid_of(wv));

#pragma unroll 1
  for (int l = 0; l < 4; ++l) {
    const int i2 = l >> 1;
    unsigned char* ws = opqp(P->ws);
    bf16_t* hb = (bf16_t*)(ws + OFF_HB);
    bf16_t* ao = (bf16_t*)(ws + OFF_AO);
    unsigned char* U = ws + OFF_U;
    unsigned char* WT = ws + OFF_WT;
    const float* ada = (const float*)(ws + OFF_MISC + MS_ADA);
    const float* adal = ada + (size_t)l * 4 * 6144;
    const float* xin = (l == 0) ? P->in[0] : P->out;
    if ((l & 1) == 0) {
      bf16_t* proj = (bf16_t*)(U + U_PROJ);
      bf16_t* qlat = (bf16_t*)(U + U_QLAT);
      bf16_t* hid = (bf16_t*)(ws + OFF_MISC + MS_HID);
      const float* cbias = (const float*)(ws + OFF_MISC + MS_CB);
      for (int rp = 0; rp < REP_GEMM; ++rp) {
      gemm_run(lds, wv, APlain{hb, DM}, (const bf16_t*)(WT + WT_IN), DM, NTOK, EIN, DM, EpiEvenProj{proj, (bf16_t*)(U + U_VST), (bf16_t*)(U + U_VWT)}, 0);
      gbar(barp, bar_target, tid_of(wv)); }
#pragma unroll 1
      for (int kv = 0; kv < 2; ++kv)
        gemm_run(lds, wv, ACmp{proj, kv ? C_VC : C_KC}, (const bf16_t*)(WT + WT_CW1) + kv * 256 * 2048, 2048, 4096, 256, 2048, EpiCmp1{cbias + kv * 256, hid + kv * 4096 * 256}, 16 * kv);
#pragma unroll 1
      for (int h = 0; h < 8; ++h)
        gemm_run(lds, wv, APlain{proj + C_DQ + h * 64, EIN}, (const bf16_t*)(WT + WT_UK) + h * 64, 512, NTOK, 128, 64, EpiRow{qlat + h * 128, DM}, 32 + h * 128);
      ckv_norm_phase(P, wv, i2);
      gbar(barp, bar_target, tid_of(wv));
#pragma unroll 1
      for (int kv = 0; kv < 2; ++kv)
        gemm_run(lds, wv, APlain{hid + kv * 4096 * 256, 256}, (const bf16_t*)(WT + WT_CW2) + kv * 64 * 256, 256, 4096, 64, 256, EpiCmp2{(bf16_t*)(ws + OFF_MISC + MS_KC), (bf16_t*)(ws + OFF_MISC + MS_VCT), kv}, 16 * kv);
      for (int rp = 0; rp < REP_IDX; ++rp) dsa_index_phase(lds, P, wv);
      gbar(barp, bar_target, tid_of(wv));
      for (int rp = 0; rp < REP_NSA; ++rp) nsa_phase(lds, P, wv);
      dsa_sparse_phase(lds, P, wv);
      gbar(barp, bar_target, tid_of(wv));
#pragma unroll 1
      for (int h = 0; h < 8; ++h)
        gemm_run(lds, wv, APlain{qlat + h * 128, DM}, (const bf16_t*)(WT + WT_UV) + h * 64 * 128, 128, NTOK, 64, 128, EpiRow{ao + 512 + h * 64, DM}, h * 128);
      gbar(barp, bar_target, tid_of(wv));
    } else {
      for (int rp = 0; rp < REP_GEMM; ++rp) {
      gemm_run(lds, wv, APlain{hb, DM}, (const bf16_t*)(WT + WT_IN), DM, NTOK, OIN, DM, EpiOddProj{(bf16_t*)(U + U_QK), (bf16_t*)(U + U_VT)}, 0);
      gbar(barp, bar_target, tid_of(wv)); }
      for (int rp = 0; rp < REP_DIFF; ++rp) {
      diff_attn_phase(lds, P, wv, l);
      gbar(barp, bar_target, tid_of(wv)); }
    }
    gemm_run(lds, wv, APlain{ao, DM}, (const bf16_t*)(WT + WT_OUT), DM, NTOK, DM, DM, EpiResid{xin, P->out, adal + 2048}, 0);
    gbar(barp, bar_target, tid_of(wv));
    ln_mod_phase(P, wv, P->out, P->out, P->in[5] + (size_t)(l * 2) * DM, P->in[6] + (size_t)(l * 2) * DM, adal + 3072, adal + 4096, true, true);
    gbar(barp, bar_target, tid_of(wv));
    for (int rp = 0; rp < REP_GEMM; ++rp) {
    gemm_run(lds, wv, APlain{hb, DM}, (const bf16_t*)(WT + WT_M1), DM, NTOK, DFF, DM, EpiSqRelu{(bf16_t*)U}, 0);
    gbar(barp, bar_target, tid_of(wv)); }
    gemm_run(lds, wv, APlain{(const bf16_t*)U, DFF}, (const bf16_t*)(WT + WT_M2), DFF, NTOK, DM, DFF, EpiResid{P->out, P->out, adal + 5120}, 0);
    gbar(barp, bar_target, tid_of(wv));
    ln_mod_phase(P, wv, P->out, P->out, P->in[5] + (size_t)(l * 2 + 1) * DM, P->in[6] + (size_t)(l * 2 + 1) * DM, adal + 4 * 6144, adal + 4 * 6144 + 1024, true, l < 3);
    if (l < 3) { wprep_phase(lds, P, wv, l + 1); gbar(barp, bar_target, tid_of(wv)); }
  }
}

#undef P
extern "C" void kernel_launch(void* const* d_in, const int* in_sizes, int n_in, void* d_out, int out_size, void* d_ws, size_t ws_size, hipStream_t stream) {
  static int grid_blocks = 0;
  if (grid_blocks == 0) {
    int dev = 0, cus = 0, per_cu = 0;
    (void)hipGetDevice(&dev);
    (void)hipDeviceGetAttribute(&cus, hipDeviceAttributeMultiprocessorCount, dev);
    if (hipFuncSetAttribute((const void*)mega, hipFuncAttributeMaxDynamicSharedMemorySize, LDS_BYTES) != hipSuccess) fprintf(stderr, "setattr failed\n");
    (void)hipOccupancyMaxActiveBlocksPerMultiprocessor(&per_cu, (const void*)mega, NTHREADS, LDS_BYTES);
    fprintf(stderr, "cus %d per_cu %d ws_size %zu n_in %d\n", cus, per_cu, ws_size, n_in);
    if (per_cu < 1 || n_in != 24 || ws_size < WS_NEED + 8 * MiB) { fprintf(stderr, "cannot launch\n"); grid_blocks = -1; }
    else grid_blocks = cus;
  }
  if (grid_blocks < 0) return;
  Params p{};
  for (int i = 0; i < 24; ++i) p.in[i] = (const float*)d_in[i];
  p.out = (float*)d_out; p.ws = (unsigned char*)d_ws;
  void* args[] = {&p};
  if (hipMemsetAsync((unsigned char*)d_ws + OFF_BAR, 0, 256, stream) != hipSuccess) fprintf(stderr, "memset failed\n");
  hipError_t e = hipLaunchCooperativeKernel((const void*)mega, dim3(grid_blocks), dim3(NTHREADS), args, LDS_BYTES, stream);
  if (e != hipSuccess) fprintf(stderr, "coop launch failed: %s\n", hipGetErrorString(e));
}
```
